# Optimizing an MI355X kernel written in HIP

```python
import jax, jax.numpy as jnp
from jax import lax
import numpy as np

D_MODEL = 1024
BATCH = 32
SEQ = 256
DEPTH = 1
DEC_BATCH = 4
DEC_SEQ = 4096
PAST_LEN = 512

GRID_W = 64
N_RET_HEADS = 4
RET_DK = 128
RET_DV = 128
RET_QK_WIDTH = N_RET_HEADS * RET_DK
RET_WIDTH = N_RET_HEADS * RET_DV
POOL_WINDOWS = (2, 4, 8, 16)
N_POOL_GROUPS = 4
POOL_GROUP = 128
POOL_WIDTH = N_POOL_GROUPS * POOL_GROUP
MIX_WIDTH = RET_WIDTH + POOL_WIDTH
IN_WIDTH = 2 * RET_QK_WIDTH + 2 * RET_WIDTH + POOL_WIDTH
D_FF = 2816
CHUNK = 128
ROPE_BASE = 10000.0
N_MOD = 9
EPS = 1e-6

kernel_name = "hybrid_retention_pool_macaron_dit_step"


def _rmsnorm(x, g):
    xf = x.astype(jnp.float32)
    y = xf * lax.rsqrt(jnp.mean(xf * xf, axis=-1, keepdims=True) + EPS) * g.astype(jnp.float32)
    return y.astype(x.dtype)


def _modulate(h, shift, scale):
    return h * (1.0 + scale[:, None, :]) + shift[:, None, :]


def _swiglu(h, w1, w3, w2):
    return (jax.nn.silu(h @ w1) * (h @ w3)) @ w2


def _rotary_2d(x):
    L = x.shape[1]
    rows = L // GRID_W
    row = jnp.repeat(jnp.arange(rows, dtype=jnp.float32), GRID_W)
    col = jnp.tile(jnp.arange(GRID_W, dtype=jnp.float32), rows)
    n_half = RET_DK // 4
    freqs = ROPE_BASE ** (-jnp.arange(n_half, dtype=jnp.float32) / n_half)
    ang = jnp.concatenate([row[:, None] * freqs, col[:, None] * freqs], axis=-1)
    cos = jnp.cos(ang)[None, :, None, :]
    sin = jnp.sin(ang)[None, :, None, :]
    xf = x.astype(jnp.float32)
    x1, x2 = xf[..., : RET_DK // 2], xf[..., RET_DK // 2:]
    out = jnp.concatenate([x1 * cos - x2 * sin, x1 * sin + x2 * cos], axis=-1)
    return out.astype(x.dtype)


def _retention_dir(q, k, v, log_gamma, s0):
    q = q.astype(jnp.float32)
    k = k.astype(jnp.float32)
    v = v.astype(jnp.float32)
    B, H, L, dk = q.shape
    dv = v.shape[-1]
    nc = L // CHUNK
    qc = q.reshape(B, H, nc, CHUNK, dk)
    kc = k.reshape(B, H, nc, CHUNK, dk)
    vc = v.reshape(B, H, nc, CHUNK, dv)
    idx = jnp.arange(CHUNK, dtype=jnp.float32)
    lg = log_gamma.astype(jnp.float32)
    rel = idx[:, None] - idx[None, :]
    decay_mat = jnp.where(rel >= 0, jnp.exp(lg[:, None, None] * jnp.maximum(rel, 0.0)), 0.0)
    scores = jnp.einsum('bhnid,bhnjd->bhnij', qc, kc) * decay_mat[None, :, None]
    inner = jnp.einsum('bhnij,bhnjv->bhniv', scores, vc)
    k_decay = jnp.exp(lg[:, None] * (CHUNK - 1 - idx)[None, :])
    kv_chunk = jnp.einsum('bhnjd,hj,bhnjv->nbhdv', kc, k_decay, vc)
    chunk_decay = jnp.exp(lg * CHUNK)[None, :, None, None]

    def step(s, kv):
        return s * chunk_decay + kv, s

    s_final, s_prev = lax.scan(step, s0.astype(jnp.float32), kv_chunk)
    q_decay = jnp.exp(lg[:, None] * (idx + 1.0)[None, :])
    cross = jnp.einsum('bhnid,nbhdv,hi->bhniv', qc, s_prev, q_decay)
    o = (inner + cross).reshape(B, H, L, dv)
    return o, s_final


def _bidir_retention(q, k, v, lg_f, lg_b, s0_f, s0_b):
    o_f, s_f = _retention_dir(q, k, v, lg_f, s0_f)
    o_b, s_b = _retention_dir(jnp.flip(q, 2), jnp.flip(k, 2), jnp.flip(v, 2), lg_b, s0_b)
    return o_f + jnp.flip(o_b, 2), s_f, s_b


def _pool_mixer(u, pool_w, pool_scale):
    B, L, _ = u.shape
    uf = u.astype(jnp.float32)
    cs = jnp.concatenate([jnp.zeros((B, 1, POOL_WIDTH), jnp.float32), jnp.cumsum(uf, axis=1)], axis=1)
    t = jnp.arange(L)
    outs = []
    for gi, w in enumerate(POOL_WINDOWS):
        sl = slice(gi * POOL_GROUP, (gi + 1) * POOL_GROUP)
        csg = cs[..., sl]
        lo = jnp.clip(t - w // 2, 0, L)
        hi = jnp.clip(t + w // 2, 0, L)
        mean = (csg[:, hi] - csg[:, lo]) / (hi - lo).astype(jnp.float32)[None, :, None]
        outs.append(jnp.einsum('blc,cd->bld', mean - uf[..., sl], pool_w[gi].astype(jnp.float32)))
    out = jnp.concatenate(outs, axis=-1) * pool_scale.astype(jnp.float32)
    return out.astype(u.dtype)


def _layer(x, cond, is_latent, s0_f, s0_b, ada_w, ada_b, norm_ffn1, ffn1_w1, ffn1_w3, ffn1_w2,
           norm_mix, w_in, ret_decay_fwd, ret_decay_bwd, ret_gn, pool_w, pool_scale, w_out,
           norm_ffn2, ffn2_w1, ffn2_w3, ffn2_w2):
    B, L, _ = x.shape
    mods = (jax.nn.silu(cond.astype(jnp.float32)) @ ada_w.astype(jnp.float32) + ada_b.astype(jnp.float32)).astype(x.dtype)
    sh1, sc1, g1, sh2, sc2, g2, sh3, sc3, g3 = jnp.split(mods, N_MOD, axis=-1)

    h = x + 0.5 * g1[:, None, :] * _swiglu(_modulate(_rmsnorm(x, norm_ffn1), sh1, sc1), ffn1_w1, ffn1_w3, ffn1_w2)

    a = _modulate(_rmsnorm(h, norm_mix), sh2, sc2)
    proj = a @ w_in
    q, k, v, gate, u = jnp.split(
        proj, [RET_QK_WIDTH, 2 * RET_QK_WIDTH, 2 * RET_QK_WIDTH + RET_WIDTH, 2 * RET_QK_WIDTH + 2 * RET_WIDTH], axis=-1)
    q = q.reshape(B, L, N_RET_HEADS, RET_DK)
    k = k.reshape(B, L, N_RET_HEADS, RET_DK) * (RET_DK ** -0.5)
    if is_latent:
        q = _rotary_2d(q)
        k = _rotary_2d(k)
    q = q.transpose(0, 2, 1, 3)
    k = k.transpose(0, 2, 1, 3)
    v = v.reshape(B, L, N_RET_HEADS, RET_DV).transpose(0, 2, 1, 3)
    lg_f = -jnp.exp(ret_decay_fwd.astype(jnp.float32))
    lg_b = -jnp.exp(ret_decay_bwd.astype(jnp.float32))
    o, s_f, s_b = _bidir_retention(q, k, v, lg_f, lg_b, s0_f, s0_b)
    o = o * lax.rsqrt(jnp.mean(o * o, axis=-1, keepdims=True) + EPS)
    o = o.transpose(0, 2, 1, 3).reshape(B, L, RET_WIDTH) * ret_gn.astype(jnp.float32)
    ret_out = o.astype(x.dtype) * jax.nn.silu(gate)
    pool_out = _pool_mixer(u, pool_w, pool_scale)
    mix = jnp.concatenate([ret_out, pool_out], axis=-1) @ w_out
    h = h + g2[:, None, :] * mix

    h = h + 0.5 * g3[:, None, :] * _swiglu(_modulate(_rmsnorm(h, norm_ffn2), sh3, sc3), ffn2_w1, ffn2_w3, ffn2_w2)
    return h, s_f, s_b


def setup_inputs(seed: int = 0) -> dict:
    key = jax.random.key(seed)
    ks = jax.random.split(key, 32)
    D = D_MODEL
    f32 = jnp.float32

    def nrm(k, shape, scale):
        return jax.random.normal(k, shape, f32) * scale

    base_gamma = 1.0 - 2.0 ** (-5.0 - np.arange(N_RET_HEADS, dtype=np.float32))
    base_param = jnp.asarray(np.log(-np.log(base_gamma)), f32)
    st_shape = (DEC_BATCH, DEPTH, N_RET_HEADS, RET_DK, RET_DV)
    return {
        "x_prompt": nrm(ks[0], (BATCH, SEQ, D), 1.0),
        "x_sample": nrm(ks[1], (DEC_BATCH, DEC_SEQ, D), 1.0),
        "state_ret_fwd": nrm(ks[2], st_shape, 0.5),
        "state_ret_bwd": nrm(ks[3], st_shape, 0.5),
        "c": nrm(ks[4], (DEC_BATCH, D), 1.0),
        "c_ctx": nrm(ks[5], (D,), 1.0),
        "ada_w": nrm(ks[6], (DEPTH, D, N_MOD * D), 0.5 * D ** -0.5),
        "ada_b": nrm(ks[7], (DEPTH, N_MOD * D), 0.01),
        "norm_ffn1": 1.0 + nrm(ks[8], (DEPTH, D), 0.01),
        "ffn1_w1": nrm(ks[9], (DEPTH, D, D_FF), D ** -0.5),
        "ffn1_w3": nrm(ks[10], (DEPTH, D, D_FF), D ** -0.5),
        "ffn1_w2": nrm(ks[11], (DEPTH, D_FF, D), D_FF ** -0.5),
        "norm_mix": 1.0 + nrm(ks[12], (DEPTH, D), 0.01),
        "w_in": nrm(ks[13], (DEPTH, D, IN_WIDTH), D ** -0.5),
        "ret_decay_fwd": base_param[None, :] + nrm(ks[14], (DEPTH, N_RET_HEADS), 0.05),
        "ret_decay_bwd": base_param[None, :] + nrm(ks[15], (DEPTH, N_RET_HEADS), 0.05),
        "ret_gn": 1.0 + nrm(ks[16], (DEPTH, RET_WIDTH), 0.01),
        "pool_w": nrm(ks[17], (DEPTH, N_POOL_GROUPS, POOL_GROUP, POOL_GROUP), POOL_GROUP ** -0.5),
        "pool_scale": 1.0 + nrm(ks[18], (DEPTH, POOL_WIDTH), 0.02),
        "w_out": nrm(ks[19], (DEPTH, MIX_WIDTH, D), MIX_WIDTH ** -0.5),
        "norm_ffn2": 1.0 + nrm(ks[20], (DEPTH, D), 0.01),
        "ffn2_w1": nrm(ks[21], (DEPTH, D, D_FF), D ** -0.5),
        "ffn2_w3": nrm(ks[22], (DEPTH, D, D_FF), D ** -0.5),
        "ffn2_w2": nrm(ks[23], (DEPTH, D_FF, D), D_FF ** -0.5),
        "norm_final": 1.0 + nrm(ks[24], (D,), 0.01),
    }


def reference(x_prompt, x_sample, state_ret_fwd, state_ret_bwd, c, c_ctx, ada_w, ada_b, norm_ffn1,
              ffn1_w1, ffn1_w3, ffn1_w2, norm_mix, w_in, ret_decay_fwd, ret_decay_bwd, ret_gn, pool_w,
              pool_scale, w_out, norm_ffn2, ffn2_w1, ffn2_w3, ffn2_w2, norm_final):
    ctx = x_prompt
    lat = x_sample
    new_f = []
    new_b = []
    for l in range(DEPTH):
        p = (ada_w[l], ada_b[l], norm_ffn1[l], ffn1_w1[l], ffn1_w3[l], ffn1_w2[l], norm_mix[l], w_in[l],
             ret_decay_fwd[l], ret_decay_bwd[l], ret_gn[l], pool_w[l], pool_scale[l], w_out[l],
             norm_ffn2[l], ffn2_w1[l], ffn2_w3[l], ffn2_w2[l])
        zeros = jnp.zeros((ctx.shape[0], N_RET_HEADS, RET_DK, RET_DV), jnp.float32)
        ctx, s_f, s_b = _layer(ctx, c_ctx[None, :], False, zeros, zeros, *p)
        new_f.append(s_f.astype(x_prompt.dtype))
        new_b.append(s_b.astype(x_prompt.dtype))
        lat, _, _ = _layer(lat, c, True, state_ret_fwd[:, l], state_ret_bwd[:, l], *p)
    y_prompt = _rmsnorm(ctx, norm_final)
    y_sample = _rmsnorm(lat, norm_final)
    new_state_ret_fwd = jnp.stack(new_f, axis=1)
    new_state_ret_bwd = jnp.stack(new_b, axis=1)
    return (y_prompt, y_sample, new_state_ret_fwd, new_state_ret_bwd)
```

```cpp
#include <hip/hip_runtime.h>
#include <cstdio>
#include <cstdint>
namespace pg8 {
#define PG8_LAS __attribute__((address_space(3)))
typedef unsigned short bf16_t;
typedef short bf16x8 __attribute__((ext_vector_type(8)));
typedef float f32x4 __attribute__((ext_vector_type(4)));
typedef unsigned u32x4 __attribute__((ext_vector_type(4)));
constexpr int BM = 256, BK = 64, HALF = 128, HTB = HALF * BK * 2  , STAGE_BYTES = 8 * HTB, NXCD = 8, WGM = 8;

__host__ __device__ __forceinline__ int lds_byte(int r, int c) { const int st = (r >> 4) * 2 + (c >> 5), rr = r & 15, cc = c & 31, ob = rr * 64 + cc * 2; return st * 1024 + (ob ^ (((ob >> 9) & 1) << 5)); }
__host__ __device__ __forceinline__ void stage_rc(int b, int& R, int& C) { const int st = b / 1024, sb = b % 1024, swz = sb ^ (((sb >> 9) & 1) << 5); R = (st >> 1) * 16 + swz / 64; C = (st & 1) * 32 + (swz % 64) / 2; }
__host__ __device__ __forceinline__ int perm32(int rho) { const int n = rho >> 4, i = rho & 15; return 8 * (i >> 2) + 4 * n + (i & 3); }

struct Unit { int pm, pn; };
struct Gemm { const bf16_t* A; const bf16_t* Bt; int M, N, K, lda; };

struct StaticOrder {
    int nM, nN, nwg, G, c;
    __host__ __device__ void init(int M, int N, int G_, int c_) { nM = M / BM; nN = N / BM; nwg = nM * nN; G = G_; c = c_; }
    __host__ __device__ bool next(int i, Unit& u) const {
        const long L = (long)i * G + c; if (L >= nwg) return false;
        int wgid = (int)L; { const int q = nwg / NXCD, r = nwg % NXCD, xcd = wgid % NXCD, off = wgid / NXCD; wgid = (xcd < r ? xcd * (q + 1) : r * (q + 1) + (xcd - r) * q) + off; }
        const int nig = WGM * nN, gid = wgid / nig, fm = gid * WGM, gsz = (nM - fm) < WGM ? (nM - fm) : WGM;
        u.pm = fm + ((wgid % nig) % gsz); u.pn = (wgid % nig) / gsz; return true;
    }
    __device__ __forceinline__ void a_ready(const Unit&) const {}
    __device__ __forceinline__ void done(const Unit&) const {}
};

typedef float f32x2 __attribute__((ext_vector_type(2)));
typedef __bf16 bf16x2_t __attribute__((ext_vector_type(2)));
__device__ __forceinline__ unsigned cvt_pk_bf16(float lo, float hi) { const f32x2 v = {lo, hi}; return __builtin_bit_cast(unsigned, __builtin_convertvector(v, bf16x2_t)); }
__device__ __forceinline__ float silu_f(float x) { return x * __builtin_amdgcn_rcpf(1.0f + __expf(-x)); }
struct EpiSwiglu {
    static constexpr bool PERM = true, AFTER_DRAIN = false;
    bf16_t* O; int ldo;
    __device__ __forceinline__ void operator()(const f32x4 (&acc)[2][2][4][2], const Unit& u, int wr, int wc, int fr, int fq) const {
        const int row0 = u.pm * BM + wr * 64 + fr, col0 = u.pn * HALF + wc * 32 + 8 * fq;
#pragma unroll
        for (int ai = 0; ai < 2; ++ai)
#pragma unroll
            for (int m = 0; m < 4; ++m) { bf16_t* rowp = O + (size_t)(row0 + ai * HALF + m * 16) * ldo + col0;
                const f32x4 g0 = acc[ai][0][m][0], g1 = acc[ai][0][m][1], u0 = acc[ai][1][m][0], u1 = acc[ai][1][m][1];
                u32x4 w;
                w.x = cvt_pk_bf16(silu_f(g0[0]) * u0[0], silu_f(g0[1]) * u0[1]); w.y = cvt_pk_bf16(silu_f(g0[2]) * u0[2], silu_f(g0[3]) * u0[3]);
                w.z = cvt_pk_bf16(silu_f(g1[0]) * u1[0], silu_f(g1[1]) * u1[1]); w.w = cvt_pk_bf16(silu_f(g1[2]) * u1[2], silu_f(g1[3]) * u1[3]);
                *(u32x4*)rowp = w; }
    }
};
struct EpiResid {
    static constexpr bool PERM = false, AFTER_DRAIN = false;
    const float* base0; const float* base1; float* out; const float* coef; float mul;
    __device__ __forceinline__ void operator()(const f32x4 (&acc)[2][2][4][2], const Unit& u, int wr, int wc, int fr, int fq) const {
        const int rowt = u.pm * BM; const bool lat = rowt >= 8192; const int grp = lat ? 1 + ((rowt - 8192) >> 12) : 0;
        const float* bp = lat ? base1 : base0; const int rsub = lat ? 8192 : 0;
        const int row0 = rowt + wr * 64 + fr, col0 = u.pn * BM + wc * 32 + 4 * fq;
        f32x4 cf[2][2];
#pragma unroll
        for (int bj = 0; bj < 2; ++bj)
#pragma unroll
            for (int n = 0; n < 2; ++n) cf[bj][n] = *(const f32x4*)(coef + (size_t)grp * 9216 + col0 + bj * HALF + n * 16) * mul;
#pragma unroll
        for (int ai = 0; ai < 2; ++ai)
#pragma unroll
            for (int m = 0; m < 4; ++m) { const int r = row0 + ai * HALF + m * 16; const float* bsrc = bp + (size_t)(r - rsub) * 1024 + col0; float* dst = out + (size_t)r * 1024 + col0;
#pragma unroll
                for (int bj = 0; bj < 2; ++bj)
#pragma unroll
                    for (int n = 0; n < 2; ++n) { const f32x4 b = *(const f32x4*)(bsrc + bj * HALF + n * 16); *(f32x4*)(dst + bj * HALF + n * 16) = b + cf[bj][n] * acc[ai][bj][m][n]; }
                if (m & 1) asm volatile("" ::: "memory"); }
    }
};
struct EpiQKV {
    static constexpr bool PERM = true, AFTER_DRAIN = false;
    bf16_t* O; const float* rotc; const float* rots;
    __device__ __forceinline__ void operator()(const f32x4 (&acc)[2][2][4][2], const Unit& u, int wr, int wc, int fr, int fq) const {
        const int rowt = u.pm * BM, row0 = rowt + wr * 64 + fr, pn = u.pn;
        if (pn < 2 || pn == 4 || pn == 5) {
            const bool isk = pn >= 4; const int hp = (pn & 1) * 2 + (wc >> 1); const int d1 = 32 * (wc & 1) + 8 * fq;
            const int colbase = (isk ? 1024 : 0) + hp * 128 + d1; const float sc = isk ? 0.08838834764831845f : 1.0f; const bool lat = rowt >= 8192;
#pragma unroll
            for (int ai = 0; ai < 2; ++ai)
#pragma unroll
                for (int m = 0; m < 4; ++m) { const int r = row0 + ai * HALF + m * 16;
                    f32x4 x1a = acc[ai][0][m][0] * sc, x1b = acc[ai][0][m][1] * sc, x2a = acc[ai][1][m][0] * sc, x2b = acc[ai][1][m][1] * sc;
                    if (lat) { const int t = (r - 8192) & 4095; const int pos = (wc & 1) ? (t & 63) : (t >> 6);
                        const float* cp = rotc + pos * 32 + 8 * fq; const float* sp = rots + pos * 32 + 8 * fq;
                        const f32x4 c0 = *(const f32x4*)cp, c1 = *(const f32x4*)(cp + 4), s0 = *(const f32x4*)sp, s1 = *(const f32x4*)(sp + 4);
                        const f32x4 o1a = x1a * c0 - x2a * s0, o2a = x1a * s0 + x2a * c0, o1b = x1b * c1 - x2b * s1, o2b = x1b * s1 + x2b * c1;
                        x1a = o1a; x2a = o2a; x1b = o1b; x2b = o2b; }
                    bf16_t* rowp = O + (size_t)r * 2560 + colbase; u32x4 w;
                    w.x = cvt_pk_bf16(x1a[0], x1a[1]); w.y = cvt_pk_bf16(x1a[2], x1a[3]); w.z = cvt_pk_bf16(x1b[0], x1b[1]); w.w = cvt_pk_bf16(x1b[2], x1b[3]); *(u32x4*)rowp = w;
                    w.x = cvt_pk_bf16(x2a[0], x2a[1]); w.y = cvt_pk_bf16(x2a[2], x2a[3]); w.z = cvt_pk_bf16(x2b[0], x2b[1]); w.w = cvt_pk_bf16(x2b[2], x2b[3]); *(u32x4*)(rowp + 64) = w; }
        } else {
            const int col0 = pn * BM + wc * 32 + 8 * fq;
#pragma unroll
            for (int ai = 0; ai < 2; ++ai)
#pragma unroll
                for (int m = 0; m < 4; ++m) { bf16_t* rowp = O + (size_t)(row0 + ai * HALF + m * 16) * 2560 + col0;
#pragma unroll
                    for (int bj = 0; bj < 2; ++bj) { const f32x4 v0 = acc[ai][bj][m][0], v1 = acc[ai][bj][m][1]; u32x4 w;
                        w.x = cvt_pk_bf16(v0[0], v0[1]); w.y = cvt_pk_bf16(v0[2], v0[3]); w.z = cvt_pk_bf16(v1[0], v1[1]); w.w = cvt_pk_bf16(v1[2], v1[3]); *(u32x4*)(rowp + bj * HALF) = w; } }
        }
    }
};

struct AffOrder {
    int t0, ntl, nN, nloc, rank;
    __device__ void init(int t0_, int t1_, int N, int nloc_, int rank_) { t0 = t0_; ntl = t1_ - t0_; nN = N / BM; nloc = nloc_; rank = rank_; }
    __device__ bool next(int i, Unit& u) const { const int L = i * nloc + rank; if (L >= ntl * nN) return false; u.pm = t0 + L % ntl; u.pn = L / ntl; return true; }
    __device__ __forceinline__ void a_ready(const Unit&) const {}
    __device__ __forceinline__ void done(const Unit&) const {}
};

template <class Epi, class Sched, bool ALIGN_EPI = false, bool SP2 = false>
__device__ __forceinline__ void gemm_phase(PG8_LAS unsigned char* lds, const Gemm g, const Sched& S, const Epi& E) {
    const int tid = threadIdx.x, wid = __builtin_amdgcn_readfirstlane(tid >> 6), lane = tid & 63, wr = wid >> 2, wc = wid & 3, fr = lane & 15, fq = lane >> 4;
    const int K = g.K, nt = K / BK;
    unsigned voffA[2], voffB[2];
#pragma unroll
    for (int i = 0; i < 2; ++i) { int R, C; stage_rc(tid * 16 + i * 8192, R, C); const int Rb = Epi::PERM ? ((R & ~31) + perm32(R & 31)) : R;
        voffA[i] = (unsigned)(R * g.lda + C) * 2u; voffB[i] = (unsigned)(Rb * K + C) * 2u; }
    const size_t kstep = (size_t)(BK * 2);
    const size_t hstep = (size_t)HALF * K * 2;
    const size_t tstep = 2 * hstep; const size_t hstepA = (size_t)HALF * g.lda * 2, tstepA = 2 * hstepA;
    const unsigned ldsw = (unsigned)wid * 1024u;
    const int aoff = lds_byte(wr * 64 + fr, fq * 8), boff = lds_byte(wc * 32 + fr, fq * 8);
#define PG8_SA(b, h) (((b) * 2 + (h)) * HTB)
#define PG8_SB(b, h) ((4 + (b) * 2 + (h)) * HTB)
#define PG8_STAGE(bufoff, gbase, voff) do { _Pragma("unroll") for (int _i = 0; _i < 2; ++_i) \
        __builtin_amdgcn_global_load_lds((const unsigned*)((const char*)(gbase) + (voff)[_i]), (PG8_LAS unsigned*)(lds + (bufoff) + ldsw + _i * 8192), 16, 0, 0); } while (0)
#define PG8_LDA(dst, b, h) do { _Pragma("unroll") for (int m = 0; m < 4; ++m) _Pragma("unroll") for (int k = 0; k < 2; ++k) dst[m][k] = *(const PG8_LAS bf16x8*)(lds + PG8_SA(b, h) + aoff + m * 2048 + k * 1024); } while (0)
#define PG8_LDB(dst, b, h) do { _Pragma("unroll") for (int n = 0; n < 2; ++n) _Pragma("unroll") for (int k = 0; k < 2; ++k) dst[n][k] = *(const PG8_LAS bf16x8*)(lds + PG8_SB(b, h) + boff + n * 2048 + k * 1024); } while (0)
#define PG8_MMA(ai, bj, At, Bt) do { __builtin_amdgcn_s_setprio(1); _Pragma("unroll") for (int m = 0; m < 4; ++m) _Pragma("unroll") for (int n = 0; n < 2; ++n) _Pragma("unroll") for (int k = 0; k < 2; ++k) \
        acc[ai][bj][m][n] = __builtin_amdgcn_mfma_f32_16x16x32_bf16(Bt[n][k], At[m][k], acc[ai][bj][m][n], 0, 0, 0); __builtin_amdgcn_s_setprio(0); } while (0)
#define PG8_WAIT_V(n) asm volatile("s_waitcnt vmcnt(" #n ")" ::: "memory")
#define PG8_WAIT_L(n) asm volatile("s_waitcnt lgkmcnt(" #n ")" ::: "memory")
#define PG8_BAR __builtin_amdgcn_s_barrier()
#define PG8_SCHED __builtin_amdgcn_sched_barrier(0)
    Unit cur, nxt; int ui = 0;
    if (!S.next(0, cur)) return;
    f32x4 acc[2][2][4][2];
#pragma unroll
    for (int a = 0; a < 2; ++a)
#pragma unroll
        for (int b = 0; b < 2; ++b)
#pragma unroll
            for (int m = 0; m < 4; ++m)
#pragma unroll
                for (int n = 0; n < 2; ++n) acc[a][b][m][n] = (f32x4){0.f, 0.f, 0.f, 0.f};
    bf16x8 At[4][2], B0[2][2], B1[2][2];
    const char* cA = (const char*)g.A + (size_t)cur.pm * tstepA; const char* cB = (const char*)g.Bt + (size_t)cur.pn * tstep;
    S.a_ready(cur);
    if constexpr (SP2) {
        PG8_STAGE(PG8_SB(0, 0), cB, voffB); PG8_STAGE(PG8_SB(0, 1), cB + hstep, voffB); PG8_STAGE(PG8_SA(0, 0), cA, voffA); PG8_STAGE(PG8_SA(0, 1), cA + hstepA, voffA);
        if (wr == 1) PG8_BAR;
        PG8_WAIT_V(2); PG8_BAR;
        PG8_STAGE(PG8_SB(1, 0), cB + kstep, voffB); PG8_STAGE(PG8_SA(1, 0), cA + kstep, voffA); PG8_STAGE(PG8_SB(1, 1), cB + hstep + kstep, voffB);
        PG8_WAIT_V(6); PG8_BAR;
    } else {
        PG8_STAGE(PG8_SB(0, 0), cB, voffB); PG8_STAGE(PG8_SA(0, 0), cA, voffA); PG8_STAGE(PG8_SB(0, 1), cB + hstep, voffB); PG8_STAGE(PG8_SA(0, 1), cA + hstepA, voffA);
        if (wr == 1) PG8_BAR;
        PG8_WAIT_V(4); PG8_BAR;
        PG8_STAGE(PG8_SB(1, 0), cB + kstep, voffB); PG8_STAGE(PG8_SA(1, 0), cA + kstep, voffA); PG8_STAGE(PG8_SB(1, 1), cB + hstep + kstep, voffB);
        PG8_WAIT_V(6); PG8_BAR;
    }
    for (;;) {
        const bool has_next = S.next(ui + 1, nxt);
        const char* nA = has_next ? (const char*)g.A + (size_t)nxt.pm * tstepA : cA; const char* nB = has_next ? (const char*)g.Bt + (size_t)nxt.pn * tstep : cB;
        for (int t = 0; t < nt; t += 2) {
            const bool last = (t == nt - 2);
            const char* a1 = cA + (size_t)(t + 1) * kstep;
            const char* a2 = last ? nA : cA + (size_t)(t + 2) * kstep; const char* b2 = last ? nB : cB + (size_t)(t + 2) * kstep;
            const char* a3 = a2 + kstep; const char* b3 = b2 + kstep;
            if (last && has_next) S.a_ready(nxt);
            if constexpr (SP2) {
            PG8_LDB(B0, 0, 0); PG8_LDB(B1, 0, 1); PG8_SCHED; PG8_LDA(At, 0, 0); PG8_STAGE(PG8_SA(1, 1), a1 + hstepA, voffA);
            PG8_WAIT_V(8); PG8_WAIT_L(0); PG8_BAR; PG8_MMA(0, 0, At, B0); PG8_MMA(0, 1, At, B1); PG8_BAR; PG8_SCHED;
            PG8_LDA(At, 0, 1); PG8_STAGE(PG8_SB(0, 0), b2, voffB); PG8_STAGE(PG8_SB(0, 1), b2 + hstep, voffB); PG8_STAGE(PG8_SA(0, 0), a2, voffA);
            PG8_WAIT_V(8); PG8_WAIT_L(0); PG8_BAR; PG8_MMA(1, 0, At, B0); PG8_MMA(1, 1, At, B1); PG8_BAR; PG8_SCHED;
            PG8_LDB(B0, 1, 0); PG8_LDB(B1, 1, 1); PG8_SCHED; PG8_LDA(At, 1, 0); PG8_STAGE(PG8_SA(0, 1), a2 + hstepA, voffA);
            PG8_WAIT_V(8); PG8_WAIT_L(0); PG8_BAR; PG8_MMA(0, 0, At, B0); PG8_MMA(0, 1, At, B1); PG8_BAR; PG8_SCHED;
            PG8_LDA(At, 1, 1); PG8_STAGE(PG8_SB(1, 0), b3, voffB); PG8_STAGE(PG8_SB(1, 1), b3 + hstep, voffB); PG8_STAGE(PG8_SA(1, 0), a3, voffA);
            PG8_WAIT_V(8); PG8_WAIT_L(0); PG8_BAR; PG8_MMA(1, 0, At, B0); PG8_MMA(1, 1, At, B1); PG8_BAR; PG8_SCHED;
            } else {
            PG8_LDB(B0, 0, 0); PG8_SCHED; PG8_LDA(At, 0, 0); PG8_STAGE(PG8_SA(1, 1), a1 + hstepA, voffA);
            PG8_WAIT_L(8); PG8_BAR; PG8_WAIT_L(0); PG8_MMA(0, 0, At, B0); PG8_BAR; PG8_SCHED;
            PG8_LDB(B1, 0, 1); PG8_STAGE(PG8_SB(0, 0), b2, voffB);
            PG8_BAR; PG8_WAIT_L(0); PG8_MMA(0, 1, At, B1); PG8_BAR;
            PG8_LDA(At, 0, 1); PG8_STAGE(PG8_SA(0, 0), a2, voffA);
            PG8_BAR; PG8_WAIT_L(0); PG8_MMA(1, 0, At, B0); PG8_BAR; PG8_SCHED;
            PG8_STAGE(PG8_SB(0, 1), b2 + hstep, voffB);
            PG8_WAIT_V(6); PG8_BAR; PG8_MMA(1, 1, At, B1); PG8_BAR;
            PG8_LDB(B0, 1, 0); PG8_SCHED; PG8_LDA(At, 1, 0); PG8_STAGE(PG8_SA(0, 1), a2 + hstepA, voffA);
            PG8_WAIT_L(8); PG8_BAR; PG8_WAIT_L(0); PG8_MMA(0, 0, At, B0); PG8_BAR; PG8_SCHED;
            PG8_LDB(B1, 1, 1); PG8_STAGE(PG8_SB(1, 0), b3, voffB);
            PG8_BAR; PG8_WAIT_L(0); PG8_MMA(0, 1, At, B1); PG8_BAR;
            PG8_LDA(At, 1, 1); PG8_STAGE(PG8_SA(1, 0), a3, voffA);
            PG8_BAR; PG8_WAIT_L(0); PG8_MMA(1, 0, At, B0); PG8_BAR; PG8_SCHED;
            PG8_STAGE(PG8_SB(1, 1), b3 + hstep, voffB);
            PG8_WAIT_V(6); PG8_BAR; PG8_MMA(1, 1, At, B1); PG8_BAR;
            }
        }
        if constexpr (ALIGN_EPI) { if (wr == 0) PG8_BAR; }
        if constexpr (!Epi::AFTER_DRAIN) { E(acc, cur, wr, wc, fr, fq); S.done(cur); }
        if (!has_next) break;
#pragma unroll
        for (int a = 0; a < 2; ++a)
#pragma unroll
            for (int b = 0; b < 2; ++b)
#pragma unroll
                for (int m = 0; m < 4; ++m)
#pragma unroll
                    for (int n = 0; n < 2; ++n) acc[a][b][m][n] = (f32x4){0.f, 0.f, 0.f, 0.f};
        cur = nxt; cA = nA; cB = nB; ++ui;
        if constexpr (ALIGN_EPI) { if (wr == 1) PG8_BAR; }
    }
    PG8_WAIT_V(0);
    if constexpr (!ALIGN_EPI) { if (wr == 0) PG8_BAR; }
    PG8_BAR;
    if constexpr (Epi::AFTER_DRAIN) { E.fused(acc, cur, wr, wc, fr, fq, lds, wid, lane); S.done(cur); }
#undef PG8_SA
#undef PG8_SB
#undef PG8_STAGE
#undef PG8_LDA
#undef PG8_LDB
#undef PG8_MMA
#undef PG8_WAIT_V
#undef PG8_WAIT_L
#undef PG8_BAR
#undef PG8_SCHED
}
}
#define GAS __attribute__((address_space(1)))
#define LAS __attribute__((address_space(3)))
typedef unsigned short bf16;
typedef unsigned v4u __attribute__((ext_vector_type(4)));
typedef float f32x4 __attribute__((ext_vector_type(4)));
typedef short bf16x8 __attribute__((ext_vector_type(8)));
typedef GAS unsigned gu32;
typedef GAS unsigned long long gu64;
#define RLX_AGENT __ATOMIC_RELAXED, __HIP_MEMORY_SCOPE_AGENT
#define LDS_WAIT() asm volatile("s_waitcnt lgkmcnt(0)" ::: "memory")
#define VM_WAIT() asm volatile("s_waitcnt vmcnt(0)" ::: "memory")
__device__ __forceinline__ unsigned long long rt() { return __builtin_amdgcn_s_memrealtime(); }
__device__ __forceinline__ unsigned f2bf(float f) { unsigned u = __builtin_bit_cast(unsigned, f); return (u + 0x7fffu + ((u >> 16) & 1u)) >> 16; }
__device__ __forceinline__ unsigned pk2(float lo, float hi) { return f2bf(lo) | (f2bf(hi) << 16); }

#define XB_TMO      128
#define XB_XCNT(j)  (256  + 64 * (j))
#define XB_XSUB(j)  (1280 + 64 * (j))
#define XB_XGEN(j)  (2304 + 64 * (j))
#define XB_TOP      3328
#define XB_TOPGEN   3392
#define XCD_BAR_WORDS 3456
#define XB_SPIN_CAP (1u << 18)

__device__ __forceinline__ unsigned xb_ld(unsigned* p)              { return __hip_atomic_load(p, __ATOMIC_RELAXED, __HIP_MEMORY_SCOPE_AGENT); }
__device__ __forceinline__ unsigned xb_add(unsigned* p, unsigned v) { return __hip_atomic_fetch_add(p, v, __ATOMIC_RELAXED, __HIP_MEMORY_SCOPE_AGENT); }
__device__ __forceinline__ unsigned xb_xcc_id() { return (unsigned)__builtin_amdgcn_s_getreg((3 << 11) | 20) & 0xFu; }
#define XB_SPIN(cond, bar) do { unsigned _sp = 0; while (cond) { __builtin_amdgcn_s_sleep(1); \
    if ((++_sp & 255u) == 0u) { if (xb_ld(&(bar)[XB_TMO])) break; if (_sp > XB_SPIN_CAP) { atomicAdd(&(bar)[XB_TMO], 1u); break; } } } } while (0)

struct XcdBarrier {
    unsigned* bar; unsigned x;
    volatile LAS unsigned* st;
};

__device__ __forceinline__ XcdBarrier xcd_barrier_post(unsigned* bar, volatile LAS unsigned* st) {
    XcdBarrier b; b.bar = bar; b.x = xb_xcc_id(); b.st = st;
    if (threadIdx.x == 0) (void)xb_add(&bar[XB_XCNT(b.x)], 1u);
    return b;
}
__device__ __forceinline__ void xcd_barrier_complete(unsigned* bar, unsigned x, unsigned& nloc, unsigned& nx) {
    const unsigned G = gridDim.x * gridDim.y * gridDim.z;
    unsigned sum, cnt, mine, sp = 0u;
    for (;;) {
        sum = 0u; cnt = 0u; mine = 0u;
#pragma unroll
        for (unsigned j = 0; j < 16; ++j) { const unsigned c = xb_ld(&bar[XB_XCNT(j)]); sum += c; cnt += (c > 0u) ? 1u : 0u; mine = (j == x) ? c : mine; }
        if (sum == G) break;
        __builtin_amdgcn_s_sleep(1);
        if ((++sp & 255u) == 0u) { if (xb_ld(&bar[XB_TMO])) break; if (sp > XB_SPIN_CAP) { atomicAdd(&bar[XB_TMO], 1u); break; } }
    }
    nloc = mine > 0u ? mine : 1u; nx = cnt > 0u ? cnt : 1u;
}

__device__ __forceinline__ void xcd_barrier(const XcdBarrier& b) {
    asm volatile("s_waitcnt vmcnt(0)" ::: "memory");
    __syncthreads();
    if (threadIdx.x == 0) {
        unsigned* bar = b.bar;
        __builtin_amdgcn_s_waitcnt(0);
        unsigned nloc = b.st[0], nx = b.st[1];
        if (nloc == 0u) { xcd_barrier_complete(bar, b.x, nloc, nx); b.st[0] = nloc; b.st[1] = nx; }
        const unsigned old = xb_add(&bar[XB_XSUB(b.x)], 1u);
        const unsigned gen = old / nloc;
        if (old + 1u == (gen + 1u) * nloc) {
            __builtin_amdgcn_fence(__ATOMIC_RELEASE, "agent");
            asm volatile("s_waitcnt vmcnt(0)" ::: "memory");
            const unsigned og = xb_add(&bar[XB_TOP], 1u);
            const unsigned tg = og / nx;
            if (og + 1u == (tg + 1u) * nx) xb_add(&bar[XB_TOPGEN], 1u);
            else XB_SPIN(xb_ld(&bar[XB_TOPGEN]) == tg, bar);
            __builtin_amdgcn_fence(__ATOMIC_ACQUIRE, "agent");
            xb_add(&bar[XB_XGEN(b.x)], 1u);
            asm volatile("s_waitcnt vmcnt(0)" ::: "memory");
        } else {
            XB_SPIN(xb_ld(&bar[XB_XGEN(b.x)]) == gen, bar);
            __builtin_amdgcn_fence(__ATOMIC_ACQUIRE, "agent");
            asm volatile("s_waitcnt vmcnt(0)" ::: "memory");
        }
    }
    __syncthreads();
}

constexpr int NWAVES = 8, NTHR = 512;
constexpr int D = 1024, MCTX = 8192, MLAT = 16384, M = MCTX + MLAT, FF = 2816, NUP = 2 * FF, NIN = 2560, NMOD = 9 * D;
constexpr int NITEM = (M / 128) * 4;
constexpr float EPS = 1e-6f;
constexpr size_t MiB = 1u << 20;
constexpr size_t WS_CTL = 0, CTL_ZERO_BYTES = 65536;
constexpr size_t WS_MODS = 65536, WS_ROTC = 262144, WS_ROTS = 262144 + 8192;
constexpr size_t WS_W13A = 1 * MiB, WS_W13B = 12 * MiB, WS_W2A = 23 * MiB, WS_W2B = 29 * MiB, WS_WIN = 35 * MiB, WS_WOUT = 40 * MiB, WS_POOLW = 42 * MiB;
constexpr size_t WS_ABUF = 43 * MiB;
constexpr size_t WS_HBUF = 91 * MiB;
constexpr size_t WS_SLAT = 223 * MiB;
constexpr size_t WS_END = 255 * MiB;
constexpr int CW_BAR = 4096, CW_RANK = 8192;
constexpr int LDS_BYTES = 147456, MISC_OFF = LDS_BYTES - 256;
constexpr int OUT_SF = M * D, OUT_SB = M * D + 32 * 4 * 128 * 128;
constexpr int RS = 272;

__device__ __forceinline__ float wave_sum(float v) {
#pragma unroll
    for (int o = 1; o < 64; o <<= 1) v += __shfl_xor(v, o);
    return v;
}
__device__ __forceinline__ unsigned cvtpk(float lo, float hi) { return pg8::cvt_pk_bf16(lo, hi); }
__device__ __forceinline__ float bflo(unsigned w) { return __uint_as_float(w << 16); }
__device__ __forceinline__ float bfhi(unsigned w) { return __uint_as_float(w & 0xffff0000u); }
#define EX2(x) __builtin_amdgcn_exp2f(x)
__device__ __forceinline__ v4u ld16_sc1(const void* p) {
    const unsigned long long a = __hip_atomic_load((const unsigned long long*)p, __ATOMIC_RELAXED, __HIP_MEMORY_SCOPE_AGENT), b = __hip_atomic_load((const unsigned long long*)p + 1, __ATOMIC_RELAXED, __HIP_MEMORY_SCOPE_AGENT);
    return (v4u){(unsigned)a, (unsigned)(a >> 32), (unsigned)b, (unsigned)(b >> 32)};
}
#define MFMA16(x, y, c) __builtin_amdgcn_mfma_f32_16x16x32_bf16((x), (y), (c), 0, 0, 0)

struct Args { const float* in[25]; float* out; unsigned char* ws; };

__device__ __forceinline__ void p0_transpose_item(const float* W, int K, int N, bf16* WT, int dst_row0, LAS float* scr, int k0, int n0, int lane) {
#pragma unroll 8
    for (int i = 0; i < 32; ++i) { const int kk = 2 * i + (lane >> 5); scr[kk * 33 + (lane & 31)] = W[(size_t)(k0 + kk) * N + n0 + (lane & 31)]; }
    LDS_WAIT(); asm volatile("" ::: "memory");
    const int c = lane & 7;
#pragma unroll
    for (int j = 0; j < 4; ++j) { const int n = (lane >> 3) + 8 * j; const LAS float* s = scr + (8 * c) * 33 + n;
        v4u o; o.x = pk2(s[0 * 33], s[1 * 33]); o.y = pk2(s[2 * 33], s[3 * 33]); o.z = pk2(s[4 * 33], s[5 * 33]); o.w = pk2(s[6 * 33], s[7 * 33]);
        *(GAS v4u*)(WT + (size_t)(dst_row0 + n) * K + k0 + 8 * c) = o; }
    LDS_WAIT(); asm volatile("" ::: "memory");
}
__device__ __forceinline__ int map_in(int c) {
    if (c < 1024) { const int base = c < 512 ? 0 : 1024, cc = c & 511, h = cc >> 7, d = cc & 127; return base + 256 * (h >> 1) + 128 * (d >> 6) + 64 * (h & 1) + (d & 63); }
    if (c < 1536) return 1536 + (c - 1024);
    if (c < 2048) return 512 + (c - 1536);
    return c;
}

template <bool FINAL>
__device__ __forceinline__ void norm_rows(const float* src0, const float* src1, const float* gamma, const float* mods, int sh_off, int sc_off, bf16* A, float* outF, int row_lo, int row_hi, int lw, int NLW, int lane) {
    for (int row = row_lo + lw; row < row_hi; row += NLW) {
        const bool lat = row >= MCTX; const int grp = lat ? 1 + ((row - MCTX) >> 12) : 0;
        const f32x4* xr = (const f32x4*)((lat ? src1 + (size_t)(row - MCTX) * D : src0 + (size_t)row * D)) + lane;
        f32x4 v[4]; float s = 0.f;
#pragma unroll
        for (int j = 0; j < 4; ++j) { v[j] = xr[64 * j]; s += (v[j].x * v[j].x + v[j].y * v[j].y) + (v[j].z * v[j].z + v[j].w * v[j].w); }
        const float r = 1.0f / sqrtf(wave_sum(s) * (1.f / D) + EPS);
#pragma unroll
        for (int j = 0; j < 4; ++j) { const int col = 4 * (lane + 64 * j); const f32x4 g = *(const f32x4*)(gamma + col);
            if (FINAL) { *(f32x4*)(outF + (size_t)row * D + col) = v[j] * r * g; }
            else { const f32x4 sc = *(const f32x4*)(mods + (size_t)grp * NMOD + sc_off + col), sh = *(const f32x4*)(mods + (size_t)grp * NMOD + sh_off + col);
                const f32x4 a = (v[j] * r * g) * (sc + 1.0f) + sh;
                *(unsigned long long*)(A + (size_t)row * D + col) = (unsigned long long)cvtpk(a.x, a.y) | ((unsigned long long)cvtpk(a.z, a.w) << 32); } }
    }
}

__device__ __forceinline__ void stage_nat(LAS unsigned char* dst, const bf16* src, int ld, int tid) {
#pragma unroll
    for (int i = 0; i < 4; ++i) { const int c = tid + NTHR * i, row = c >> 4, cc = c & 15; *(LAS v4u*)(dst + row * RS + cc * 16) = *(const v4u*)(src + (size_t)row * ld + cc * 8); }
}


__device__ __forceinline__ void stage_zero(LAS unsigned char* dst, int tid) {
#pragma unroll
    for (int i = 0; i < 4; ++i) { const int c = tid + NTHR * i, row = c >> 4, cc = c & 15; *(LAS v4u*)(dst + row * RS + cc * 16) = (v4u){0u, 0u, 0u, 0u}; }
}


#ifdef PROBE_CK
__device__ __attribute__((noinline)) void cksum(const void* p, size_t nbytes, unsigned* dst, int gt, int GT, int lane) {
    unsigned s = 0; for (size_t i = gt; i < nbytes / 16; i += GT) { const v4u v = ((const v4u*)p)[i]; s += v.x + v.y * 3u + v.z * 5u + v.w * 7u; }
#pragma unroll
    for (int o = 1; o < 64; o <<= 1) s += __shfl_xor(s, o);
    if (lane == 0) atomicAdd(dst, s);
}
#define CKA(c, ptr, bytes_per_tile) cksum((const unsigned char*)(ptr) + (size_t)t0 * (bytes_per_tile), (size_t)(t1 - t0) * (bytes_per_tile), (unsigned*)(ws + 40960) + (c), rank * NTHR + tid, nloc * NTHR, lane)
#define CKG(c, ptr, nbytes) cksum((ptr), (nbytes), (unsigned*)(ws + 40960) + (c), bx * NTHR + tid, G * NTHR, lane)
#else
#define CKA(c, ptr, b) do {} while (0)
#define CKG(c, ptr, b) do {} while (0)
#endif
__global__ void __launch_bounds__(NTHR, 2) hyb_fwd(Args args) {
    extern __shared__ __attribute__((aligned(16))) unsigned char lds_raw[];
    LAS unsigned char* lds = (LAS unsigned char*)lds_raw;
    volatile LAS unsigned* MISC = (volatile LAS unsigned*)(lds + MISC_OFF);
    const int tid = threadIdx.x, lane = tid & 63, wave = __builtin_amdgcn_readfirstlane(tid >> 6), fr = lane & 15, fq = lane >> 4;
    const int G = gridDim.x, bx = blockIdx.x;
    const int gw = bx * NWAVES + wave, NGW = G * NWAVES;
    unsigned char* ws = args.ws;
    if (tid < 64) MISC[tid] = 0u;
    __syncthreads();
    XcdBarrier bar = xcd_barrier_post((unsigned*)(ws + WS_CTL) + CW_BAR, MISC + 8);
    if (tid == 0) MISC[16] = __hip_atomic_fetch_add((unsigned*)(ws + WS_CTL) + CW_RANK + 64 * bar.x, 1u, __ATOMIC_RELAXED, __HIP_MEMORY_SCOPE_AGENT);

    const float* x_ctx = args.in[0]; const float* x_lat = args.in[1];
    float* mods = (float*)(ws + WS_MODS); float* rotc = (float*)(ws + WS_ROTC); float* rots = (float*)(ws + WS_ROTS);
    bf16* W13A = (bf16*)(ws + WS_W13A); bf16* W13B = (bf16*)(ws + WS_W13B); bf16* W2A = (bf16*)(ws + WS_W2A); bf16* W2B = (bf16*)(ws + WS_W2B);
    bf16* WIN = (bf16*)(ws + WS_WIN); bf16* WOUT = (bf16*)(ws + WS_WOUT); bf16* POOLW = (bf16*)(ws + WS_POOLW);
    bf16* ABUF = (bf16*)(ws + WS_ABUF); bf16* HBUF = (bf16*)(ws + WS_HBUF); bf16* SBUF = ABUF; bf16* QKV = HBUF; bf16* SLAT = (bf16*)(ws + WS_SLAT);
    float* out = args.out;

    {
        LAS float* scr = (LAS float*)(lds + wave * 16384);
        constexpr int I_W1 = 16 * 88, I_W2 = 44 * 32, I_IN = 16 * 80, I_OUT = 16 * 32, I_POOL = 32;
        constexpr int NITEMS = 4 * I_W1 + 2 * I_W2 + I_IN + I_OUT + I_POOL;
        for (int it = gw; it < NITEMS; it += NGW) {
            int r = it;
            if (r < 4 * I_W1) { const int which = r / I_W1; r -= which * I_W1; const int kb = r / 88, nb = r % 88, n0 = 32 * nb;
                const float* src = args.in[which == 0 ? 9 : which == 1 ? 10 : which == 2 ? 21 : 22]; bf16* dst = which < 2 ? W13A : W13B;
                p0_transpose_item(src, D, FF, dst, 256 * (n0 >> 7) + 128 * (which & 1) + (n0 & 127), scr, 64 * kb, n0, lane); continue; }
            r -= 4 * I_W1;
            if (r < 2 * I_W2) { const int which = r / I_W2; r -= which * I_W2; const int kb = r / 32, nb = r % 32;
                p0_transpose_item(args.in[which ? 23 : 11], FF, D, which ? W2B : W2A, 32 * nb, scr, 64 * kb, 32 * nb, lane); continue; }
            r -= 2 * I_W2;
            if (r < I_IN) { const int kb = r / 80, nb = r % 80; p0_transpose_item(args.in[13], D, NIN, WIN, map_in(32 * nb), scr, 64 * kb, 32 * nb, lane); continue; }
            r -= I_IN;
            if (r < I_OUT) { const int kb = r / 32, nb = r % 32; p0_transpose_item(args.in[19], D, D, WOUT, 32 * nb, scr, 64 * kb, 32 * nb, lane); continue; }
            r -= I_OUT;
            { const int g = r >> 3, kb = (r >> 2) & 1, nb = r & 3; p0_transpose_item(args.in[17] + g * 16384, 128, 128, POOLW + g * 16384, 32 * nb, scr, 64 * kb, 32 * nb, lane); }
        }
        for (int i = bx * NTHR + tid; i < 2 * 2097152 / 4; i += G * NTHR) *(f32x4*)(out + OUT_SF + 4 * i) = (f32x4){0.f, 0.f, 0.f, 0.f};
        { const int gt = bx * NTHR + tid;
          if (gt < 2048) { const int pos = gt >> 5, f = gt & 31; double fr_ = 1.0; for (int i = 0; i < f; ++i) fr_ *= 0.7498942093324559;
              const double a = (double)pos * fr_; const double n = __builtin_rint(a * 0.15915494309189535); const double rr = a - n * 6.283185307179586; const double r2 = rr * rr;
              double cs = 1.0, sn = 1.0;
              for (int k = 13; k >= 1; --k) { cs = 1.0 - cs * r2 / (double)((2 * k - 1) * (2 * k)); sn = 1.0 - sn * r2 / (double)((2 * k) * (2 * k + 1)); }
              rotc[gt] = (float)cs; rots[gt] = (float)(sn * rr); } }
        __syncthreads();
        LAS float* scond = (LAS float*)lds;
        LAS float* red = (LAS float*)(lds + 5 * 1024 * 4);
        for (int i = tid; i < 5 * D; i += NTHR) { const int g = i >> 10, k = i & 1023; const float cv = g == 0 ? args.in[5][k] : args.in[4][(g - 1) * D + k]; scond[i] = cv / (1.0f + expf(-cv)); }
        __syncthreads();
        const float* ada_w = args.in[6]; const float* ada_b = args.in[7];
        for (int it = bx; it < NMOD / 32; it += G) {
            const int c0 = 32 * it, col = lane & 31, kp = lane >> 5; float a0 = 0.f, a1 = 0.f, a2 = 0.f, a3 = 0.f, a4 = 0.f;
#pragma unroll 8
            for (int i = 0; i < 64; ++i) { const int k = 128 * wave + 2 * i + kp; const float wv = ada_w[(size_t)k * NMOD + c0 + col];
                a0 += scond[k] * wv; a1 += scond[1024 + k] * wv; a2 += scond[2048 + k] * wv; a3 += scond[3072 + k] * wv; a4 += scond[4096 + k] * wv; }
            a0 += __shfl_xor(a0, 32); a1 += __shfl_xor(a1, 32); a2 += __shfl_xor(a2, 32); a3 += __shfl_xor(a3, 32); a4 += __shfl_xor(a4, 32);
            if (lane < 32) { LAS float* rp = red + wave * 160 + col; rp[0] = a0; rp[32] = a1; rp[64] = a2; rp[96] = a3; rp[128] = a4; }
            __syncthreads();
            if (tid < 160) { float s = 0.f;
#pragma unroll
                for (int w = 0; w < 8; ++w) s += red[w * 160 + tid];
                const int g = tid >> 5, cc = tid & 31; mods[(size_t)g * NMOD + c0 + cc] = s + ada_b[c0 + cc]; }
            __syncthreads();
        }
    }
    xcd_barrier(bar);

    if (tid == 0) { unsigned xi_ = 0, nx_ = 0; unsigned* bw = (unsigned*)(ws + WS_CTL) + CW_BAR;
        for (unsigned j = 0; j < 16; ++j) { const unsigned c = xb_ld(&bw[XB_XCNT(j)]); if (c) { if (j < bar.x) ++xi_; ++nx_; } }
        MISC[17] = xi_; MISC[18] = nx_; MISC[19] = xb_ld(&bw[XB_XCNT(bar.x)]); }
    __syncthreads();
    const int rank = __builtin_amdgcn_readfirstlane((int)MISC[16]), xi = __builtin_amdgcn_readfirstlane((int)MISC[17]), nx = __builtin_amdgcn_readfirstlane((int)MISC[18]), nloc = __builtin_amdgcn_readfirstlane((int)MISC[19]);
    const int t0 = (96 * xi) / nx, t1 = (96 * (xi + 1)) / nx;
    const int lwv = rank * NWAVES + wave, NLW = nloc * NWAVES;
    const int nitl = (t1 - t0) * 8;

    norm_rows<false>(x_ctx, x_lat, args.in[8], mods, 0, 1024, ABUF, nullptr, 256 * t0, 256 * t1, lwv, NLW, lane);
    xcd_barrier(bar);

    { pg8::Gemm g{ABUF, W13A, M, NUP, D, D}; pg8::AffOrder S; S.init(t0, t1, NUP, nloc, rank); pg8::EpiSwiglu E{HBUF, FF};
      pg8::gemm_phase<pg8::EpiSwiglu, pg8::AffOrder, true, true>(lds, g, S, E); }
    xcd_barrier(bar);
    { pg8::Gemm g{HBUF, W2A, M, D, FF, FF}; pg8::AffOrder S; S.init(t0, t1, D, nloc, rank); pg8::EpiResid E{x_ctx, x_lat, out, mods + 2048, 0.5f};
      pg8::gemm_phase<pg8::EpiResid, pg8::AffOrder, true, true>(lds, g, S, E); }
    xcd_barrier(bar);
    norm_rows<false>(out, out + (size_t)MCTX * D, args.in[12], mods, 3072, 4096, ABUF, nullptr, 256 * t0, 256 * t1, lwv, NLW, lane);
    xcd_barrier(bar);
    { pg8::Gemm g{ABUF, WIN, M, NIN, D, D}; pg8::AffOrder S; S.init(t0, t1, NIN, nloc, rank); pg8::EpiQKV E{QKV, rotc, rots};
      pg8::gemm_phase<pg8::EpiQKV, pg8::AffOrder, true, true>(lds, g, S, E); }
    xcd_barrier(bar);
    CKA(2, QKV, (size_t)256 * NIN * 2);

    {
        LAS unsigned char* KT = lds; LAS unsigned char* VFT = lds + 128 * RS; LAS unsigned char* VBT = lds + 2 * 128 * RS;
        for (int li = rank; li < nitl; li += nloc) {
            const int item = 8 * t0 + li, cg = item >> 2, h = item & 3, row0 = cg * 128;
            const float l2f = -expf(args.in[14][h]) * 1.4426950408889634f, l2b = -expf(args.in[15][h]) * 1.4426950408889634f;
            const int jp = 16 * (wave & 3) + (lane & 15), j0 = 2 * jp;
            const float wf0 = EX2(l2f * (float)(127 - j0)), wf1 = EX2(l2f * (float)(126 - j0)), wb0 = EX2(l2b * (float)j0), wb1 = EX2(l2b * (float)(j0 + 1));
#pragma unroll
            for (int pass = 0; pass < 2; ++pass) {
                const int c0 = 8 * (4 * (wave >> 2) + (lane >> 4) + 8 * pass);
                const bf16* kr = QKV + (size_t)(row0 + j0) * NIN + 1024 + h * 128 + c0; const bf16* vr = kr + 512;
                const v4u ka = *(const v4u*)kr, kb = *(const v4u*)(kr + NIN), va = *(const v4u*)vr, vb = *(const v4u*)(vr + NIN);
#pragma unroll
                for (int q = 0; q < 4; ++q) {
                    const unsigned a = ka[q], b = kb[q], c = va[q], d = vb[q];
                    const int r0 = (c0 + 2 * q) * RS + jp * 4, r1 = r0 + RS;
                    *(LAS unsigned*)(KT + r0) = (a & 0xffffu) | (b << 16); *(LAS unsigned*)(KT + r1) = (a >> 16) | (b & 0xffff0000u);
                    const float v00 = bflo(c), v01 = bfhi(c), v10 = bflo(d), v11 = bfhi(d);
                    *(LAS unsigned*)(VFT + r0) = cvtpk(v00 * wf0, v10 * wf1); *(LAS unsigned*)(VFT + r1) = cvtpk(v01 * wf0, v11 * wf1);
                    *(LAS unsigned*)(VBT + r0) = cvtpk(v00 * wb0, v10 * wb1); *(LAS unsigned*)(VBT + r1) = cvtpk(v01 * wb0, v11 * wb1);
                }
            }
            __syncthreads();
            f32x4 af[8], ab[8];
#pragma unroll
            for (int dt = 0; dt < 8; ++dt) { af[dt] = (f32x4){0.f, 0.f, 0.f, 0.f}; ab[dt] = (f32x4){0.f, 0.f, 0.f, 0.f}; }
#pragma unroll
            for (int kk = 0; kk < 4; ++kk) {
                const int ko = (32 * kk + 8 * fq) * 2;
                const bf16x8 yf = *(const LAS bf16x8*)(VFT + (16 * wave + fr) * RS + ko), yb = *(const LAS bf16x8*)(VBT + (16 * wave + fr) * RS + ko);
#pragma unroll
                for (int dt = 0; dt < 8; ++dt) { const bf16x8 xk = *(const LAS bf16x8*)(KT + (16 * dt + fr) * RS + ko); af[dt] = MFMA16(xk, yf, af[dt]); ab[dt] = MFMA16(xk, yb, ab[dt]); }
            }
            bf16* sf = SBUF + ((size_t)item * 2) * 16384 + (16 * wave + fr) * 128 + 4 * fq; bf16* sb = sf + 16384;
#pragma unroll
            for (int dt = 0; dt < 8; ++dt) {
                *(unsigned long long*)(sf + 16 * dt) = (unsigned long long)cvtpk(af[dt][0], af[dt][1]) | ((unsigned long long)cvtpk(af[dt][2], af[dt][3]) << 32);
                *(unsigned long long*)(sb + 16 * dt) = (unsigned long long)cvtpk(ab[dt][0], ab[dt][1]) | ((unsigned long long)cvtpk(ab[dt][2], ab[dt][3]) << 32);
            }
            if (item < 256) {
                const int nch = cg & 1, bh = (cg >> 1) * 4 + h;
                const float sfw = nch == 0 ? exp2f(l2f * 128.0f) : 1.0f, sbw = nch == 1 ? exp2f(l2b * 128.0f) : 1.0f;
                float* cf = out + OUT_SF + (size_t)bh * 16384 + (4 * fq) * 128 + 16 * wave + fr; float* cb = out + OUT_SB + (size_t)bh * 16384 + (4 * fq) * 128 + 16 * wave + fr;
#pragma unroll
                for (int dt = 0; dt < 8; ++dt)
#pragma unroll
                    for (int i = 0; i < 4; ++i) { unsafeAtomicAdd(cf + (16 * dt + i) * 128, af[dt][i] * sfw); unsafeAtomicAdd(cb + (16 * dt + i) * 128, ab[dt][i] * sbw); }
            }
            __syncthreads();
        }
    }
    xcd_barrier(bar);
    CKA(3, SBUF, (size_t)8 * 2 * 16384 * 2);

    {
        const int gt = bx * NTHR + tid, GT = G * NTHR;
        for (int task = gt; task < 4 * 4 * 2 * 2048; task += GT) {
            const int e8 = task & 2047, dir = (task >> 11) & 1, h = (task >> 12) & 3, b = task >> 14;
            float carry[8];
            { const float* s0 = args.in[dir ? 3 : 2] + ((size_t)b * 4 + h) * 16384; const int dv = e8 >> 4, dk0 = (e8 & 15) * 8;
#pragma unroll
              for (int e = 0; e < 8; ++e) carry[e] = s0[(dk0 + e) * 128 + dv]; }
            const float gC = exp2f(-expf(args.in[dir ? 15 : 14][h]) * 1.4426950408889634f * 128.0f);
            for (int sb = 0; sb < 32; sb += 8) {
                v4u kv[8];
#pragma unroll
                for (int i = 0; i < 8; ++i) { const int n = dir ? 31 - (sb + i) : sb + i; kv[i] = *(const v4u*)(SBUF + (((size_t)(64 + 32 * b + n) * 4 + h) * 2 + dir) * 16384 + e8 * 8); }
#pragma unroll
                for (int i = 0; i < 8; ++i) { const int n = dir ? 31 - (sb + i) : sb + i;
                    v4u o; o.x = cvtpk(carry[0], carry[1]); o.y = cvtpk(carry[2], carry[3]); o.z = cvtpk(carry[4], carry[5]); o.w = cvtpk(carry[6], carry[7]);
                    *(v4u*)(SLAT + (((size_t)(32 * b + n) * 4 + h) * 2 + dir) * 16384 + e8 * 8) = o;
#pragma unroll
                    for (int q = 0; q < 4; ++q) { carry[2 * q] = carry[2 * q] * gC + bflo(kv[i][q]); carry[2 * q + 1] = carry[2 * q + 1] * gC + bfhi(kv[i][q]); } }
            }
        }
    }
    xcd_barrier(bar);
    CKG(4, SLAT, (size_t)512 * 2 * 16384 * 2); CKG(4, out + OUT_SF, (size_t)2 * 2097152 * 4);

    {
        LAS unsigned char* KP = lds; LAS unsigned char* VT = lds + 128 * RS; LAS unsigned char* SFT = lds + 2 * 128 * RS; LAS unsigned char* SBT = lds + 3 * 128 * RS;
        LAS unsigned char* US = lds; LAS unsigned char* WT = lds + 2 * 128 * RS;
        for (int li = rank; li < nitl; li += nloc) {
            const int item = 8 * t0 + li, cg = item >> 2, h = item & 3, row0 = cg * 128;
            const bool lat = cg >= 64; const int n = lat ? (cg - 64) & 31 : cg & 1, L = lat ? 4096 : 256, seq_row0 = row0 - n * 128;
            const float l2f = -expf(args.in[14][h]) * 1.4426950408889634f, l2b = -expf(args.in[15][h]) * 1.4426950408889634f;
            stage_nat(KP, QKV + (size_t)row0 * NIN + 1024 + h * 128, NIN, tid);
            if (lat) { stage_nat(SFT, SLAT + ((size_t)(item - 256) * 2) * 16384, 128, tid); stage_nat(SBT, SLAT + ((size_t)(item - 256) * 2 + 1) * 16384, 128, tid); }
            else if (n == 0) { stage_zero(SFT, tid); stage_nat(SBT, SBUF + ((size_t)(item + 4) * 2 + 1) * 16384, 128, tid); }
            else { stage_nat(SFT, SBUF + ((size_t)(item - 4) * 2) * 16384, 128, tid); stage_zero(SBT, tid); }
            { const int jp = 16 * (wave & 3) + (lane & 15), j0 = 2 * jp;
#pragma unroll
              for (int pass = 0; pass < 2; ++pass) { const int c0 = 8 * (4 * (wave >> 2) + (lane >> 4) + 8 * pass);
                  const bf16* vr = QKV + (size_t)(row0 + j0) * NIN + 1536 + h * 128 + c0; const v4u va = *(const v4u*)vr, vb = *(const v4u*)(vr + NIN);
#pragma unroll
                  for (int q = 0; q < 4; ++q) { const unsigned a = va[q], b = vb[q]; const int r0 = (c0 + 2 * q) * RS + jp * 4;
                      *(LAS unsigned*)(VT + r0) = (a & 0xffffu) | (b << 16); *(LAS unsigned*)(VT + r0 + RS) = (a >> 16) | (b & 0xffff0000u); } } }
            const int il = 16 * wave + fr, row = row0 + il;
            bf16x8 yq[4];
#pragma unroll
            for (int kk = 0; kk < 4; ++kk) yq[kk] = *(const bf16x8*)(QKV + (size_t)row * NIN + h * 128 + 32 * kk + 8 * fq);
            __syncthreads();
            f32x4 sc[8];
#pragma unroll
            for (int jt = 0; jt < 8; ++jt) { sc[jt] = (f32x4){0.f, 0.f, 0.f, 0.f};
#pragma unroll
                for (int kk = 0; kk < 4; ++kk) sc[jt] = MFMA16(*(const LAS bf16x8*)(KP + (16 * jt + fr) * RS + (32 * kk + 8 * fq) * 2), yq[kk], sc[jt]); }
#pragma unroll
            for (int jt = 0; jt < 8; ++jt)
#pragma unroll
                for (int i = 0; i < 4; ++i) { const int j = 16 * jt + 4 * fq + i, dl = il - j; const float w = dl > 0 ? EX2(l2f * (float)dl) : (dl < 0 ? EX2(l2b * (float)(-dl)) : 2.0f); sc[jt][i] *= w; }
            __syncthreads();
#pragma unroll
            for (int jt = 0; jt < 8; ++jt) *(LAS unsigned long long*)(KP + il * RS + (16 * jt + 4 * fq) * 2) = (unsigned long long)cvtpk(sc[jt][0], sc[jt][1]) | ((unsigned long long)cvtpk(sc[jt][2], sc[jt][3]) << 32);
            __syncthreads();
            f32x4 oi[8];
#pragma unroll
            for (int dt = 0; dt < 8; ++dt) oi[dt] = (f32x4){0.f, 0.f, 0.f, 0.f};
            const float cfw = EX2(l2f * (float)(il + 1)), cbw = EX2(l2b * (float)(128 - il));
#pragma unroll 1
            for (int kk = 0; kk < 4; ++kk) { const int ko = (32 * kk + 8 * fq) * 2; const bf16x8 yp = *(const LAS bf16x8*)(KP + il * RS + ko);
                const v4u qw = *(const v4u*)(QKV + (size_t)row * NIN + h * 128 + 32 * kk + 8 * fq); v4u qf, qb;
#pragma unroll
                for (int q = 0; q < 4; ++q) { const float lo = bflo(qw[q]), hi = bfhi(qw[q]); qf[q] = cvtpk(lo * cfw, hi * cfw); qb[q] = cvtpk(lo * cbw, hi * cbw); }
                const bf16x8 yqf = __builtin_bit_cast(bf16x8, qf), yqb = __builtin_bit_cast(bf16x8, qb);
#pragma unroll
                for (int dt = 0; dt < 8; ++dt) { const int ro = (16 * dt + fr) * RS + ko;
                    oi[dt] = MFMA16(*(const LAS bf16x8*)(VT + ro), yp, oi[dt]); oi[dt] = MFMA16(*(const LAS bf16x8*)(SFT + ro), yqf, oi[dt]); oi[dt] = MFMA16(*(const LAS bf16x8*)(SBT + ro), yqb, oi[dt]); } }
            float ss = 0.f;
#pragma unroll
            for (int dt = 0; dt < 8; ++dt) ss += (oi[dt][0] * oi[dt][0] + oi[dt][1] * oi[dt][1]) + (oi[dt][2] * oi[dt][2] + oi[dt][3] * oi[dt][3]);
            ss += __shfl_xor(ss, 16); ss += __shfl_xor(ss, 32);
            const float rn = 1.0f / sqrtf(ss * (1.0f / 128.0f) + EPS);
            { bf16* qrow = QKV + (size_t)row * NIN + h * 128 + 4 * fq; const bf16* grow = qrow + 512; const float* gn = args.in[16] + h * 128 + 4 * fq;
#pragma unroll
              for (int dt = 0; dt < 8; ++dt) { const unsigned long long gw_ = *(const unsigned long long*)(grow + 16 * dt); const f32x4 g4 = *(const f32x4*)(gn + 16 * dt);
                  const unsigned g01 = (unsigned)gw_, g23 = (unsigned)(gw_ >> 32);
                  const float r0 = oi[dt][0] * rn * g4[0] * pg8::silu_f(bflo(g01)), r1 = oi[dt][1] * rn * g4[1] * pg8::silu_f(bfhi(g01));
                  const float r2 = oi[dt][2] * rn * g4[2] * pg8::silu_f(bflo(g23)), r3 = oi[dt][3] * rn * g4[3] * pg8::silu_f(bfhi(g23));
                  *(unsigned long long*)(qrow + 16 * dt) = (unsigned long long)cvtpk(r0, r1) | ((unsigned long long)cvtpk(r2, r3) << 32); } }
            __syncthreads();
            { const int half = 1 << h;
              for (int c = tid; c < 144 * 16; c += NTHR) { const int lr = c >> 4, cc = c & 15, pos = n * 128 - 8 + lr; v4u v = (v4u){0u, 0u, 0u, 0u};
                  if (pos >= 0 && pos < L) v = *(const v4u*)(QKV + (size_t)(seq_row0 + pos) * NIN + 2048 + h * 128 + cc * 8);
                  *(LAS v4u*)(US + lr * RS + cc * 16) = v; }
              stage_nat(WT, POOLW + h * 16384, 128, tid);
              __syncthreads();
              const int pos = n * 128 + il, lo = pos - half > 0 ? pos - half : 0, hi = pos + half < L ? pos + half : L; const float inv = 1.0f / (float)(hi - lo);
              bf16x8 yd[4];
#pragma unroll
              for (int kk = 0; kk < 4; ++kk) { const int co = (32 * kk + 8 * fq) * 2; float s[8];
#pragma unroll
                  for (int e = 0; e < 8; ++e) s[e] = 0.f;
                  for (int dd = -half; dd < half; ++dd) { const v4u v = *(const LAS v4u*)(US + (il + 8 + dd) * RS + co);
#pragma unroll
                      for (int q = 0; q < 4; ++q) { s[2 * q] += bflo(v[q]); s[2 * q + 1] += bfhi(v[q]); } }
                  const v4u cv = *(const LAS v4u*)(US + (il + 8) * RS + co); v4u dq;
#pragma unroll
                  for (int q = 0; q < 4; ++q) dq[q] = cvtpk(s[2 * q] * inv - bflo(cv[q]), s[2 * q + 1] * inv - bfhi(cv[q]));
                  yd[kk] = __builtin_bit_cast(bf16x8, dq); }
              f32x4 po[8];
#pragma unroll
              for (int dt = 0; dt < 8; ++dt) { po[dt] = (f32x4){0.f, 0.f, 0.f, 0.f};
#pragma unroll
                  for (int kk = 0; kk < 4; ++kk) po[dt] = MFMA16(*(const LAS bf16x8*)(WT + (16 * dt + fr) * RS + (32 * kk + 8 * fq) * 2), yd[kk], po[dt]); }
              bf16* prow = QKV + (size_t)row * NIN + 512 + h * 128 + 4 * fq; const float* ps = args.in[18] + h * 128 + 4 * fq;
#pragma unroll
              for (int dt = 0; dt < 8; ++dt) { const f32x4 p4 = *(const f32x4*)(ps + 16 * dt);
                  *(unsigned long long*)(prow + 16 * dt) = (unsigned long long)cvtpk(po[dt][0] * p4[0], po[dt][1] * p4[1]) | ((unsigned long long)cvtpk(po[dt][2] * p4[2], po[dt][3] * p4[3]) << 32); }
            }
            __syncthreads();
        }
    }
    xcd_barrier(bar);
    CKA(5, QKV, (size_t)256 * NIN * 2);

    { pg8::Gemm g{QKV, WOUT, M, D, D, NIN}; pg8::AffOrder S; S.init(t0, t1, D, nloc, rank); pg8::EpiResid E{out, out + (size_t)MCTX * D, out, mods + 5120, 1.0f};
      pg8::gemm_phase<pg8::EpiResid, pg8::AffOrder, true, true>(lds, g, S, E); }
    xcd_barrier(bar);
    norm_rows<false>(out, out + (size_t)MCTX * D, args.in[20], mods, 6144, 7168, ABUF, nullptr, 256 * t0, 256 * t1, lwv, NLW, lane);
    xcd_barrier(bar);
    { pg8::Gemm g{ABUF, W13B, M, NUP, D, D}; pg8::AffOrder S; S.init(t0, t1, NUP, nloc, rank); pg8::EpiSwiglu E{HBUF, FF};
      pg8::gemm_phase<pg8::EpiSwiglu, pg8::AffOrder, true, true>(lds, g, S, E); }
    xcd_barrier(bar);
    { pg8::Gemm g{HBUF, W2B, M, D, FF, FF}; pg8::AffOrder S; S.init(t0, t1, D, nloc, rank); pg8::EpiResid E{out, out + (size_t)MCTX * D, out, mods + 8192, 0.5f};
      pg8::gemm_phase<pg8::EpiResid, pg8::AffOrder, true, true>(lds, g, S, E); }
    xcd_barrier(bar);
    norm_rows<true>(out, out + (size_t)MCTX * D, args.in[24], nullptr, 0, 0, nullptr, out, 256 * t0, 256 * t1, lwv, NLW, lane);
#ifdef PROBE_CK
    xcd_barrier(bar);
    if (bx == 0 && tid == 0) {
        unsigned* P = (unsigned*)(ws + 255 * MiB + 65536); unsigned* cur = (unsigned*)(ws + 40960);
        unsigned bad = 0; const bool valid = P[15] == 0x5eed1234u; if (valid) bad = P[14];
#pragma unroll
        for (int i = 5; i >= 0; --i) { const unsigned ci = __hip_atomic_load(cur + i, __ATOMIC_RELAXED, __HIP_MEMORY_SCOPE_AGENT); if (valid && P[14] == 0 && P[i] != ci) bad = i + 1; P[i] = ci; }
        P[14] = bad; P[15] = 0x5eed1234u;
        if (bad && bad <= PROBE_CK) out[1] = 1e30f;
    }
#endif
}

extern "C" void kernel_launch(void* const* d_in, const int* in_sizes, int n_in, void* d_out, int out_size, void* d_ws, size_t ws_size, hipStream_t stream) {
    static int grid = 0;
    if (grid == 0) {
        if (n_in != 25 || in_sizes[0] != MCTX * D || in_sizes[1] != MLAT * D || out_size != M * D + 2 * 32 * 4 * 128 * 128 || ws_size < 256 * MiB) {
            fprintf(stderr, "kernel_launch: unexpected shapes (n_in %d, out %d, ws %zu); nothing launched\n", n_in, out_size, ws_size); grid = -1; return; }
        int dev = 0, cus = 0, per_cu = 0;
        if (hipGetDevice(&dev) != hipSuccess || hipDeviceGetAttribute(&cus, hipDeviceAttributeMultiprocessorCount, dev) != hipSuccess) { grid = -1; return; }
        if (hipFuncSetAttribute((const void*)hyb_fwd, hipFuncAttributeMaxDynamicSharedMemorySize, LDS_BYTES) != hipSuccess) { fprintf(stderr, "kernel_launch: hipFuncSetAttribute failed\n"); grid = -1; return; }
        if (hipOccupancyMaxActiveBlocksPerMultiprocessor(&per_cu, (const void*)hyb_fwd, NTHR, LDS_BYTES) != hipSuccess || per_cu < 1) {
            fprintf(stderr, "kernel_launch: occupancy query reports %d workgroups per CU; nothing launched\n", per_cu); (void)hipGetLastError(); grid = -1; return; }
        grid = cus;
    }
    if (grid < 0) return;
    (void)hipMemsetAsync((char*)d_ws + WS_CTL, 0, CTL_ZERO_BYTES, stream);
    Args a{};
    for (int i = 0; i < 25; ++i) a.in[i] = (const float*)d_in[i];
    a.out = (float*)d_out; a.ws = (unsigned char*)d_ws;
    hipLaunchKernelGGL(hyb_fwd, dim3(grid), dim3(NTHR), LDS_BYTES, stream, a);
}
```

```cpp
#include <hip/hip_runtime.h>
#include <cstdio>
#include <cstdint>
namespace pg8 {
#define PG8_LAS __attribute__((address_space(3)))
typedef unsigned short bf16_t;
typedef short bf16x8 __attribute__((ext_vector_type(8)));
typedef float f32x4 __attribute__((ext_vector_type(4)));
typedef unsigned u32x4 __attribute__((ext_vector_type(4)));
constexpr int BM = 256, BK = 64, HALF = 128, HTB = HALF * BK * 2  , STAGE_BYTES = 8 * HTB, NXCD = 8, WGM = 8;

__host__ __device__ __forceinline__ int lds_byte(int r, int c) { const int st = (r >> 4) * 2 + (c >> 5), rr = r & 15, cc = c & 31, ob = rr * 64 + cc * 2; return st * 1024 + (ob ^ (((ob >> 9) & 1) << 5)); }
__host__ __device__ __forceinline__ void stage_rc(int b, int& R, int& C) { const int st = b / 1024, sb = b % 1024, swz = sb ^ (((sb >> 9) & 1) << 5); R = (st >> 1) * 16 + swz / 64; C = (st & 1) * 32 + (swz % 64) / 2; }
__host__ __device__ __forceinline__ int perm32(int rho) { const int n = rho >> 4, i = rho & 15; return 8 * (i >> 2) + 4 * n + (i & 3); }

struct Unit { int pm, pn, kh; };
struct Gemm { const bf16_t* A; const bf16_t* Bt; int M, N, K, lda, Kh; };

struct StaticOrder {
    int nM, nN, nwg, G, c;
    __host__ __device__ void init(int M, int N, int G_, int c_) { nM = M / BM; nN = N / BM; nwg = nM * nN; G = G_; c = c_; }
    __host__ __device__ bool next(int i, Unit& u) const {
        const long L = (long)i * G + c; if (L >= nwg) return false;
        int wgid = (int)L; { const int q = nwg / NXCD, r = nwg % NXCD, xcd = wgid % NXCD, off = wgid / NXCD; wgid = (xcd < r ? xcd * (q + 1) : r * (q + 1) + (xcd - r) * q) + off; }
        const int nig = WGM * nN, gid = wgid / nig, fm = gid * WGM, gsz = (nM - fm) < WGM ? (nM - fm) : WGM;
        u.pm = fm + ((wgid % nig) % gsz); u.pn = (wgid % nig) / gsz; return true;
    }
    __device__ __forceinline__ void a_ready(const Unit&) const {}
    __device__ __forceinline__ void done(const Unit&) const {}
};

typedef float f32x2 __attribute__((ext_vector_type(2)));
typedef __bf16 bf16x2_t __attribute__((ext_vector_type(2)));
__device__ __forceinline__ unsigned cvt_pk_bf16(float lo, float hi) { const f32x2 v = {lo, hi}; return __builtin_bit_cast(unsigned, __builtin_convertvector(v, bf16x2_t)); }
__device__ __forceinline__ float silu_f(float x) { return x * __builtin_amdgcn_rcpf(1.0f + __expf(-x)); }
struct EpiSwiglu {
    static constexpr bool PERM = true, AFTER_DRAIN = false;
    bf16_t* O; int ldo;
    const float* rrow; const float* bias;
    __device__ __forceinline__ void operator()(const f32x4 (&acc)[2][2][4][2], const Unit& u, int wr, int wc, int fr, int fq) const {
        const int rowt = u.pm * BM, row0 = rowt + wr * 64 + fr, col0 = u.pn * HALF + wc * 32 + 8 * fq;
        const int grp = rowt >= 8192 ? 1 + ((rowt - 8192) >> 12) : 0;
        f32x4 bg[2], bu[2];
#pragma unroll
        for (int n = 0; n < 2; ++n) { bg[n] = (f32x4){0.f, 0.f, 0.f, 0.f}; bu[n] = bg[n];
            if (rrow) { const float* bp = bias + (size_t)grp * 5632 + u.pn * BM + wc * 32 + 8 * fq + 4 * n; bg[n] = *(const f32x4*)bp; bu[n] = *(const f32x4*)(bp + HALF); } }
#pragma unroll
        for (int ai = 0; ai < 2; ++ai)
#pragma unroll
            for (int m = 0; m < 4; ++m) { const int r = row0 + ai * HALF + m * 16; bf16_t* rowp = O + (size_t)r * ldo + col0;
                const float rs = rrow ? rrow[r] : 1.0f;
                const f32x4 g0 = acc[ai][0][m][0] * rs + bg[0], g1 = acc[ai][0][m][1] * rs + bg[1], u0 = acc[ai][1][m][0] * rs + bu[0], u1 = acc[ai][1][m][1] * rs + bu[1];
                u32x4 w;
                w.x = cvt_pk_bf16(silu_f(g0[0]) * u0[0], silu_f(g0[1]) * u0[1]); w.y = cvt_pk_bf16(silu_f(g0[2]) * u0[2], silu_f(g0[3]) * u0[3]);
                w.z = cvt_pk_bf16(silu_f(g1[0]) * u1[0], silu_f(g1[1]) * u1[1]); w.w = cvt_pk_bf16(silu_f(g1[2]) * u1[2], silu_f(g1[3]) * u1[3]);
                *(u32x4*)rowp = w; }
    }
};
struct EpiResid {
    static constexpr bool PERM = true, AFTER_DRAIN = false;
    const float* base0; const float* base1; float* out; const float* coef; float mul;
    unsigned* flag;
    bf16_t* hm; const float* gamma; const float* scn; float* sspa; float* sspb;
    __device__ __forceinline__ void operator()(const f32x4 (&acc)[2][2][4][2], const Unit& u, int wr, int wc, int fr, int fq) const {
        const int rowt = u.pm * BM; const bool lat = rowt >= 8192; const int grp = lat ? 1 + ((rowt - 8192) >> 12) : 0;
        const float* bp = lat ? base1 : base0; const int rsub = lat ? 8192 : 0;
        const int row0 = rowt + wr * 64 + fr, col0 = u.pn * BM + wc * 32 + 8 * fq;
        float* ssp = (u.pn < 2 ? sspa : sspb) + (u.pn & 1) * 4 + wc;
        float ss8[8];
#pragma unroll
        for (int k = 0; k < 8; ++k) ss8[k] = 0.f;
#pragma unroll
        for (int bj = 0; bj < 2; ++bj) {
            f32x4 cf[2], gm[2];
#pragma unroll
            for (int n = 0; n < 2; ++n) { cf[n] = *(const f32x4*)(coef + (size_t)grp * 9216 + col0 + bj * HALF + n * 4) * mul;
                gm[n] = hm ? *(const f32x4*)(gamma + col0 + bj * HALF + n * 4) * (*(const f32x4*)(scn + (size_t)grp * 9216 + col0 + bj * HALF + n * 4) + 1.0f) : cf[n]; }
#pragma unroll
            for (int ai = 0; ai < 2; ++ai)
#pragma unroll
                for (int m = 0; m < 4; ++m) { const int r = row0 + ai * HALF + m * 16; const float* bsrc = bp + (size_t)(r - rsub) * 1024 + col0 + bj * HALF; float* dst = out + (size_t)r * 1024 + col0 + bj * HALF;
                    const f32x4 h0 = *(const f32x4*)bsrc + cf[0] * acc[ai][bj][m][0], h1 = *(const f32x4*)(bsrc + 4) + cf[1] * acc[ai][bj][m][1];
                    *(f32x4*)dst = h0; *(f32x4*)(dst + 4) = h1;
                    if (hm) { ss8[ai * 4 + m] += ((h0[0] * h0[0] + h0[1] * h0[1]) + (h0[2] * h0[2] + h0[3] * h0[3])) + ((h1[0] * h1[0] + h1[1] * h1[1]) + (h1[2] * h1[2] + h1[3] * h1[3]));
                        const f32x4 a0 = h0 * gm[0], a1 = h1 * gm[1]; u32x4 w;
                        w.x = cvt_pk_bf16(a0[0], a0[1]); w.y = cvt_pk_bf16(a0[2], a0[3]); w.z = cvt_pk_bf16(a1[0], a1[1]); w.w = cvt_pk_bf16(a1[2], a1[3]);
                        *(u32x4*)(hm + (size_t)r * 1024 + col0 + bj * HALF) = w; }
                    if (m & 1) asm volatile("" ::: "memory"); }
        }
        if (hm) {
#pragma unroll
            for (int k = 0; k < 8; ++k) { float ss = ss8[k]; ss += __shfl_xor(ss, 16); ss += __shfl_xor(ss, 32); if (fq == 0) ssp[(size_t)(row0 + (k >> 2) * HALF + (k & 3) * 16) * 8] = ss; } }
    }
};
struct EpiQKV {
    static constexpr bool PERM = true, AFTER_DRAIN = false;
    bf16_t* O; int ldo; const float* rotc; const float* rots; const float* rrow; const float* bias;
    __device__ __forceinline__ void operator()(const f32x4 (&acc)[2][2][4][2], const Unit& u, int wr, int wc, int fr, int fq) const {
        const int rowt = u.pm * BM, row0 = rowt + wr * 64 + fr, pn = u.pn;
        const int grp = rowt >= 8192 ? 1 + ((rowt - 8192) >> 12) : 0;
        f32x4 bb[2][2];
#pragma unroll
        for (int bj = 0; bj < 2; ++bj)
#pragma unroll
            for (int n = 0; n < 2; ++n) bb[bj][n] = *(const f32x4*)(bias + (size_t)grp * 2560 + pn * BM + bj * HALF + wc * 32 + 8 * fq + 4 * n);
        if (pn < 2 || pn == 4 || pn == 5) {
            const bool isk = pn >= 4; const int hp = (pn & 1) * 2 + (wc >> 1); const int d1 = 32 * (wc & 1) + 8 * fq;
            const int colbase = (isk ? 1024 : 0) + hp * 128 + d1; const float sc = isk ? 0.08838834764831845f : 1.0f; const bool lat = rowt >= 8192;
#pragma unroll
            for (int ai = 0; ai < 2; ++ai)
#pragma unroll
                for (int m = 0; m < 4; ++m) { const int r = row0 + ai * HALF + m * 16;
                    const float rs = rrow[r];
                    f32x4 x1a = (acc[ai][0][m][0] * rs + bb[0][0]) * sc, x1b = (acc[ai][0][m][1] * rs + bb[0][1]) * sc, x2a = (acc[ai][1][m][0] * rs + bb[1][0]) * sc, x2b = (acc[ai][1][m][1] * rs + bb[1][1]) * sc;
                    if (lat) { const int t = (r - 8192) & 4095; const int pos = (wc & 1) ? (t & 63) : (t >> 6);
                        const float* cp = rotc + pos * 32 + 8 * fq; const float* sp = rots + pos * 32 + 8 * fq;
                        const f32x4 c0 = *(const f32x4*)cp, c1 = *(const f32x4*)(cp + 4), s0 = *(const f32x4*)sp, s1 = *(const f32x4*)(sp + 4);
                        const f32x4 o1a = x1a * c0 - x2a * s0, o2a = x1a * s0 + x2a * c0, o1b = x1b * c1 - x2b * s1, o2b = x1b * s1 + x2b * c1;
                        x1a = o1a; x2a = o2a; x1b = o1b; x2b = o2b; }
                    bf16_t* rowp = O + (size_t)r * ldo + colbase; u32x4 w;
                    w.x = cvt_pk_bf16(x1a[0], x1a[1]); w.y = cvt_pk_bf16(x1a[2], x1a[3]); w.z = cvt_pk_bf16(x1b[0], x1b[1]); w.w = cvt_pk_bf16(x1b[2], x1b[3]); *(u32x4*)rowp = w;
                    w.x = cvt_pk_bf16(x2a[0], x2a[1]); w.y = cvt_pk_bf16(x2a[2], x2a[3]); w.z = cvt_pk_bf16(x2b[0], x2b[1]); w.w = cvt_pk_bf16(x2b[2], x2b[3]); *(u32x4*)(rowp + 64) = w; }
        } else {
            const int col0 = pn * BM + wc * 32 + 8 * fq;
#pragma unroll
            for (int ai = 0; ai < 2; ++ai)
#pragma unroll
                for (int m = 0; m < 4; ++m) { const int r = row0 + ai * HALF + m * 16; bf16_t* rowp = O + (size_t)r * ldo + col0; const float rs = rrow[r];
#pragma unroll
                    for (int bj = 0; bj < 2; ++bj) { const f32x4 v0 = acc[ai][bj][m][0] * rs + bb[bj][0], v1 = acc[ai][bj][m][1] * rs + bb[bj][1]; u32x4 w;
                        w.x = cvt_pk_bf16(v0[0], v0[1]); w.y = cvt_pk_bf16(v0[2], v0[3]); w.z = cvt_pk_bf16(v1[0], v1[1]); w.w = cvt_pk_bf16(v1[2], v1[3]); *(u32x4*)(rowp + bj * HALF) = w; } }
        }
    }
};

struct AffOrder {
    int t0, ntl, nN, nloc, rank, split;
    __device__ void init(int t0_, int t1_, int N, int nloc_, int rank_, int split_ = 0) { t0 = t0_; ntl = t1_ - t0_; nN = N / BM; nloc = nloc_; rank = rank_; split = split_; }
    __device__ bool next(int i, Unit& u) const { int L = i * nloc + rank; const int nt_ = ntl * nN; if (L >= (split ? 2 * nt_ : nt_)) return false; u.kh = 0; if (L >= nt_) { L -= nt_; u.kh = 1; } u.pm = t0 + L % ntl; u.pn = L / ntl; return true; }
    __device__ __forceinline__ void a_ready(const Unit&) const {}
    __device__ __forceinline__ void done(const Unit&) const {}
};

template <class Epi, class Sched, bool ALIGN_EPI = false, bool SP2 = false>
__device__ __forceinline__ void gemm_phase(PG8_LAS unsigned char* lds, const Gemm g, const Sched& S, const Epi& E) {
    int tid_ = threadIdx.x; asm volatile("" : "+v"(tid_));
    const int tid = tid_, wid = __builtin_amdgcn_readfirstlane(tid >> 6), lane = tid & 63, wr = wid >> 2, wc = wid & 3, fr = lane & 15, fq = lane >> 4;
    const int K = g.K, nt = g.Kh / BK; const size_t khb = (size_t)g.Kh * 2;
    unsigned voffA[2], voffB[2];
#pragma unroll
    for (int i = 0; i < 2; ++i) { int R, C; stage_rc(tid * 16 + i * 8192, R, C); const int Rb = Epi::PERM ? ((R & ~31) + perm32(R & 31)) : R;
        voffA[i] = (unsigned)(R * g.lda + C) * 2u; voffB[i] = (unsigned)(Rb * K + C) * 2u; }
    const size_t kstep = (size_t)(BK * 2);
    const size_t hstep = (size_t)HALF * K * 2;
    const size_t tstep = 2 * hstep; const size_t hstepA = (size_t)HALF * g.lda * 2, tstepA = 2 * hstepA;
    const unsigned ldsw = (unsigned)wid * 1024u;
    const int aoff = lds_byte(wr * 64 + fr, fq * 8), boff = lds_byte(wc * 32 + fr, fq * 8);
#define PG8_SA(b, h) (((b) * 2 + (h)) * HTB)
#define PG8_SB(b, h) ((4 + (b) * 2 + (h)) * HTB)
#define PG8_STAGE(bufoff, gbase, voff) do { _Pragma("unroll") for (int _i = 0; _i < 2; ++_i) \
        __builtin_amdgcn_global_load_lds((const unsigned*)((const char*)(gbase) + (voff)[_i]), (PG8_LAS unsigned*)(lds + (bufoff) + ldsw + _i * 8192), 16, 0, 0); } while (0)
#define PG8_LDA(dst, b, h) do { _Pragma("unroll") for (int m = 0; m < 4; ++m) _Pragma("unroll") for (int k = 0; k < 2; ++k) dst[m][k] = *(const PG8_LAS bf16x8*)(lds + PG8_SA(b, h) + aoff + m * 2048 + k * 1024); } while (0)
#define PG8_LDB(dst, b, h) do { _Pragma("unroll") for (int n = 0; n < 2; ++n) _Pragma("unroll") for (int k = 0; k < 2; ++k) dst[n][k] = *(const PG8_LAS bf16x8*)(lds + PG8_SB(b, h) + boff + n * 2048 + k * 1024); } while (0)
#define PG8_MMA(ai, bj, At, Bt) do { __builtin_amdgcn_s_setprio(1); _Pragma("unroll") for (int m = 0; m < 4; ++m) _Pragma("unroll") for (int n = 0; n < 2; ++n) _Pragma("unroll") for (int k = 0; k < 2; ++k) \
        acc[ai][bj][m][n] = __builtin_amdgcn_mfma_f32_16x16x32_bf16(Bt[n][k], At[m][k], acc[ai][bj][m][n], 0, 0, 0); __builtin_amdgcn_s_setprio(0); } while (0)
#define PG8_WAIT_V(n) asm volatile("s_waitcnt vmcnt(" #n ")" ::: "memory")
#define PG8_WAIT_L(n) asm volatile("s_waitcnt lgkmcnt(" #n ")" ::: "memory")
#define PG8_BAR __builtin_amdgcn_s_barrier()
#define PG8_SCHED __builtin_amdgcn_sched_barrier(0)
    Unit cur, nxt; int ui = 0;
    if (!S.next(0, cur)) return;
    f32x4 acc[2][2][4][2];
#pragma unroll
    for (int a = 0; a < 2; ++a)
#pragma unroll
        for (int b = 0; b < 2; ++b)
#pragma unroll
            for (int m = 0; m < 4; ++m)
#pragma unroll
                for (int n = 0; n < 2; ++n) acc[a][b][m][n] = (f32x4){0.f, 0.f, 0.f, 0.f};
    bf16x8 At[4][2], B0[2][2], B1[2][2];
    const char* cA = (const char*)g.A + (size_t)cur.pm * tstepA + (size_t)cur.kh * khb; const char* cB = (const char*)g.Bt + (size_t)cur.pn * tstep + (size_t)cur.kh * khb;
    S.a_ready(cur);
    if constexpr (SP2) {
        PG8_STAGE(PG8_SB(0, 0), cB, voffB); PG8_STAGE(PG8_SB(0, 1), cB + hstep, voffB); PG8_STAGE(PG8_SA(0, 0), cA, voffA); PG8_STAGE(PG8_SA(0, 1), cA + hstepA, voffA);
        if (wr == 1) PG8_BAR;
        PG8_WAIT_V(2); PG8_BAR;
        PG8_STAGE(PG8_SB(1, 0), cB + kstep, voffB); PG8_STAGE(PG8_SA(1, 0), cA + kstep, voffA); PG8_STAGE(PG8_SB(1, 1), cB + hstep + kstep, voffB);
        PG8_WAIT_V(6); PG8_BAR;
    } else {
        PG8_STAGE(PG8_SB(0, 0), cB, voffB); PG8_STAGE(PG8_SA(0, 0), cA, voffA); PG8_STAGE(PG8_SB(0, 1), cB + hstep, voffB); PG8_STAGE(PG8_SA(0, 1), cA + hstepA, voffA);
        if (wr == 1) PG8_BAR;
        PG8_WAIT_V(4); PG8_BAR;
        PG8_STAGE(PG8_SB(1, 0), cB + kstep, voffB); PG8_STAGE(PG8_SA(1, 0), cA + kstep, voffA); PG8_STAGE(PG8_SB(1, 1), cB + hstep + kstep, voffB);
        PG8_WAIT_V(6); PG8_BAR;
    }
    for (;;) {
        const bool has_next = S.next(ui + 1, nxt);
        const char* nA = has_next ? (const char*)g.A + (size_t)nxt.pm * tstepA + (size_t)nxt.kh * khb : cA; const char* nB = has_next ? (const char*)g.Bt + (size_t)nxt.pn * tstep + (size_t)nxt.kh * khb : cB;
        for (int t = 0; t < nt; t += 2) {
            const bool last = (t == nt - 2);
            const char* a1 = cA + (size_t)(t + 1) * kstep;
            const char* a2 = last ? nA : cA + (size_t)(t + 2) * kstep; const char* b2 = last ? nB : cB + (size_t)(t + 2) * kstep;
            const char* a3 = a2 + kstep; const char* b3 = b2 + kstep;
            if (last && has_next) S.a_ready(nxt);
            if constexpr (SP2) {
            PG8_LDB(B0, 0, 0); PG8_LDB(B1, 0, 1); PG8_SCHED; PG8_LDA(At, 0, 0); PG8_STAGE(PG8_SA(1, 1), a1 + hstepA, voffA);
            PG8_WAIT_V(8); PG8_WAIT_L(0); PG8_BAR; PG8_MMA(0, 0, At, B0); PG8_MMA(0, 1, At, B1); PG8_BAR; PG8_SCHED;
            PG8_LDA(At, 0, 1); PG8_STAGE(PG8_SB(0, 0), b2, voffB); PG8_STAGE(PG8_SB(0, 1), b2 + hstep, voffB); PG8_STAGE(PG8_SA(0, 0), a2, voffA);
            PG8_WAIT_V(8); PG8_WAIT_L(0); PG8_BAR; PG8_MMA(1, 0, At, B0); PG8_MMA(1, 1, At, B1); PG8_BAR; PG8_SCHED;
            PG8_LDB(B0, 1, 0); PG8_LDB(B1, 1, 1); PG8_SCHED; PG8_LDA(At, 1, 0); PG8_STAGE(PG8_SA(0, 1), a2 + hstepA, voffA);
            PG8_WAIT_V(8); PG8_WAIT_L(0); PG8_BAR; PG8_MMA(0, 0, At, B0); PG8_MMA(0, 1, At, B1); PG8_BAR; PG8_SCHED;
            PG8_LDA(At, 1, 1); PG8_STAGE(PG8_SB(1, 0), b3, voffB); PG8_STAGE(PG8_SB(1, 1), b3 + hstep, voffB); PG8_STAGE(PG8_SA(1, 0), a3, voffA);
            PG8_WAIT_V(8); PG8_WAIT_L(0); PG8_BAR; PG8_MMA(1, 0, At, B0); PG8_MMA(1, 1, At, B1); PG8_BAR; PG8_SCHED;
            } else {
            PG8_LDB(B0, 0, 0); PG8_SCHED; PG8_LDA(At, 0, 0); PG8_STAGE(PG8_SA(1, 1), a1 + hstepA, voffA);
            PG8_WAIT_L(8); PG8_BAR; PG8_WAIT_L(0); PG8_MMA(0, 0, At, B0); PG8_BAR; PG8_SCHED;
            PG8_LDB(B1, 0, 1); PG8_STAGE(PG8_SB(0, 0), b2, voffB);
            PG8_BAR; PG8_WAIT_L(0); PG8_MMA(0, 1, At, B1); PG8_BAR;
            PG8_LDA(At, 0, 1); PG8_STAGE(PG8_SA(0, 0), a2, voffA);
            PG8_BAR; PG8_WAIT_L(0); PG8_MMA(1, 0, At, B0); PG8_BAR; PG8_SCHED;
            PG8_STAGE(PG8_SB(0, 1), b2 + hstep, voffB);
            PG8_WAIT_V(6); PG8_BAR; PG8_MMA(1, 1, At, B1); PG8_BAR;
            PG8_LDB(B0, 1, 0); PG8_SCHED; PG8_LDA(At, 1, 0); PG8_STAGE(PG8_SA(0, 1), a2 + hstepA, voffA);
            PG8_WAIT_L(8); PG8_BAR; PG8_WAIT_L(0); PG8_MMA(0, 0, At, B0); PG8_BAR; PG8_SCHED;
            PG8_LDB(B1, 1, 1); PG8_STAGE(PG8_SB(1, 0), b3, voffB);
            PG8_BAR; PG8_WAIT_L(0); PG8_MMA(0, 1, At, B1); PG8_BAR;
            PG8_LDA(At, 1, 1); PG8_STAGE(PG8_SA(1, 0), a3, voffA);
            PG8_BAR; PG8_WAIT_L(0); PG8_MMA(1, 0, At, B0); PG8_BAR; PG8_SCHED;
            PG8_STAGE(PG8_SB(1, 1), b3 + hstep, voffB);
            PG8_WAIT_V(6); PG8_BAR; PG8_MMA(1, 1, At, B1); PG8_BAR;
            }
        }
        if constexpr (ALIGN_EPI) { if (wr == 0) PG8_BAR; }
        if constexpr (!Epi::AFTER_DRAIN) { E(acc, cur, wr, wc, fr, fq); S.done(cur); }
        if (!has_next) break;
#pragma unroll
        for (int a = 0; a < 2; ++a)
#pragma unroll
            for (int b = 0; b < 2; ++b)
#pragma unroll
                for (int m = 0; m < 4; ++m)
#pragma unroll
                    for (int n = 0; n < 2; ++n) acc[a][b][m][n] = (f32x4){0.f, 0.f, 0.f, 0.f};
        cur = nxt; cA = nA; cB = nB; ++ui;
        if constexpr (ALIGN_EPI) { if (wr == 1) PG8_BAR; }
    }
    PG8_WAIT_V(0);
    if constexpr (!ALIGN_EPI) { if (wr == 0) PG8_BAR; }
    PG8_BAR;
    if constexpr (Epi::AFTER_DRAIN) { E.fused(acc, cur, wr, wc, fr, fq, lds, wid, lane); S.done(cur); }
#undef PG8_SA
#undef PG8_SB
#undef PG8_STAGE
#undef PG8_LDA
#undef PG8_LDB
#undef PG8_MMA
#undef PG8_WAIT_V
#undef PG8_WAIT_L
#undef PG8_BAR
#undef PG8_SCHED
}
}
#define GAS __attribute__((address_space(1)))
#define LAS __attribute__((address_space(3)))
typedef unsigned short bf16;
typedef unsigned v4u __attribute__((ext_vector_type(4)));
typedef float f32x4 __attribute__((ext_vector_type(4)));
typedef short bf16x8 __attribute__((ext_vector_type(8)));
typedef GAS unsigned gu32;
typedef GAS unsigned long long gu64;
#define RLX_AGENT __ATOMIC_RELAXED, __HIP_MEMORY_SCOPE_AGENT
#define LDS_WAIT() asm volatile("s_waitcnt lgkmcnt(0)" ::: "memory")
#define VM_WAIT() asm volatile("s_waitcnt vmcnt(0)" ::: "memory")
__device__ __forceinline__ unsigned long long rt() { return __builtin_amdgcn_s_memrealtime(); }
__device__ __forceinline__ unsigned f2bf(float f) { unsigned u = __builtin_bit_cast(unsigned, f); return (u + 0x7fffu + ((u >> 16) & 1u)) >> 16; }
__device__ __forceinline__ unsigned pk2(float lo, float hi) { return f2bf(lo) | (f2bf(hi) << 16); }

#define XB_TMO      128
#define XB_XCNT(j)  (256  + 64 * (j))
#define XB_XSUB(j)  (1280 + 64 * (j))
#define XB_XGEN(j)  (2304 + 64 * (j))
#define XB_TOP      3328
#define XB_TOPGEN   3392
#define XCD_BAR_WORDS 3456
#define XB_SPIN_CAP (1u << 18)

__device__ __forceinline__ unsigned xb_ld(unsigned* p)              { return __hip_atomic_load(p, __ATOMIC_RELAXED, __HIP_MEMORY_SCOPE_AGENT); }
__device__ __forceinline__ unsigned xb_add(unsigned* p, unsigned v) { return __hip_atomic_fetch_add(p, v, __ATOMIC_RELAXED, __HIP_MEMORY_SCOPE_AGENT); }
__device__ __forceinline__ unsigned xb_xcc_id() { return (unsigned)__builtin_amdgcn_s_getreg((3 << 11) | 20) & 0xFu; }
#define XB_SPIN(cond, bar) do { unsigned _sp = 0; while (cond) { __builtin_amdgcn_s_sleep(1); \
    if ((++_sp & 255u) == 0u) { if (xb_ld(&(bar)[XB_TMO])) break; if (_sp > XB_SPIN_CAP) { atomicAdd(&(bar)[XB_TMO], 1u); break; } } } } while (0)

struct XcdBarrier {
    unsigned* bar; unsigned x;
    volatile LAS unsigned* st;
};

__device__ __forceinline__ XcdBarrier xcd_barrier_post(unsigned* bar, volatile LAS unsigned* st) {
    XcdBarrier b; b.bar = bar; b.x = xb_xcc_id(); b.st = st;
    if (threadIdx.x == 0) (void)xb_add(&bar[XB_XCNT(b.x)], 1u);
    return b;
}
__device__ __forceinline__ void xcd_barrier_complete(unsigned* bar, unsigned x, unsigned& nloc, unsigned& nx) {
    const unsigned G = gridDim.x * gridDim.y * gridDim.z;
    unsigned sum, cnt, mine, sp = 0u;
    for (;;) {
        sum = 0u; cnt = 0u; mine = 0u;
#pragma unroll
        for (unsigned j = 0; j < 16; ++j) { const unsigned c = xb_ld(&bar[XB_XCNT(j)]); sum += c; cnt += (c > 0u) ? 1u : 0u; mine = (j == x) ? c : mine; }
        if (sum == G) break;
        __builtin_amdgcn_s_sleep(1);
        if ((++sp & 255u) == 0u) { if (xb_ld(&bar[XB_TMO])) break; if (sp > XB_SPIN_CAP) { atomicAdd(&bar[XB_TMO], 1u); break; } }
    }
    nloc = mine > 0u ? mine : 1u; nx = cnt > 0u ? cnt : 1u;
}

__device__ __forceinline__ void xcd_barrier(const XcdBarrier& b) {
    asm volatile("s_waitcnt vmcnt(0)" ::: "memory");
    __syncthreads();
    if (threadIdx.x == 0) {
        unsigned* bar = b.bar;
        __builtin_amdgcn_s_waitcnt(0);
        unsigned nloc = b.st[0], nx = b.st[1];
        if (nloc == 0u) { xcd_barrier_complete(bar, b.x, nloc, nx); b.st[0] = nloc; b.st[1] = nx; }
        const unsigned old = xb_add(&bar[XB_XSUB(b.x)], 1u);
        const unsigned gen = old / nloc;
        if (old + 1u == (gen + 1u) * nloc) {
            __builtin_amdgcn_fence(__ATOMIC_RELEASE, "agent");
            asm volatile("s_waitcnt vmcnt(0)" ::: "memory");
            const unsigned og = xb_add(&bar[XB_TOP], 1u);
            const unsigned tg = og / nx;
            if (og + 1u == (tg + 1u) * nx) xb_add(&bar[XB_TOPGEN], 1u);
            else XB_SPIN(xb_ld(&bar[XB_TOPGEN]) == tg, bar);
            __builtin_amdgcn_fence(__ATOMIC_ACQUIRE, "agent");
            xb_add(&bar[XB_XGEN(b.x)], 1u);
            asm volatile("s_waitcnt vmcnt(0)" ::: "memory");
        } else {
            XB_SPIN(xb_ld(&bar[XB_XGEN(b.x)]) == gen, bar);
            __builtin_amdgcn_fence(__ATOMIC_ACQUIRE, "agent");
            asm volatile("s_waitcnt vmcnt(0)" ::: "memory");
        }
    }
    __syncthreads();
}

constexpr int NWAVES = 8, NTHR = 512;
constexpr int D = 1024, MCTX = 8192, MLAT = 16384, M = MCTX + MLAT, FF = 2816, NUP = 2 * FF, NIN = 2560, NMOD = 9 * D;
constexpr int LDQ = FF;
constexpr int NITEM = (M / 128) * 4;
constexpr float EPS = 1e-6f;
constexpr size_t MiB = 1u << 20;
constexpr size_t WS_CTL = 0, CTL_ZERO_BYTES = 65536;
constexpr size_t WS_MODS = 65536, WS_ROTC = 262144, WS_ROTS = 262144 + 8192;
constexpr size_t WS_BIASQ = 288 * 1024, WS_BIAS3 = 352 * 1024, WS_RROW = 512 * 1024;
constexpr size_t WS_SSPA = 42 * MiB + 262144, WS_SSPB = 255 * MiB;
constexpr size_t WS_W13A = 1 * MiB, WS_W13B = 12 * MiB, WS_W2A = 23 * MiB, WS_W2B = 29 * MiB, WS_WIN = 35 * MiB, WS_WOUT = 40 * MiB, WS_POOLW = 42 * MiB;
constexpr size_t WS_ABUF = 43 * MiB;
constexpr size_t WS_HBUF = 91 * MiB;
constexpr size_t WS_SLAT = 223 * MiB;
constexpr size_t WS_END = 255 * MiB;
constexpr int CW_BAR = 4096, CW_RANK = 8192, CW_LBAR = 10240, CW_SPLIT = 12288;
constexpr int LDS_BYTES = 147456, MISC_OFF = LDS_BYTES - 256;
constexpr int OUT_SF = M * D, OUT_SB = M * D + 32 * 4 * 128 * 128;
constexpr int RS = 272;

__device__ __forceinline__ float wave_sum(float v) {
#pragma unroll
    for (int o = 1; o < 64; o <<= 1) v += __shfl_xor(v, o);
    return v;
}
__device__ __forceinline__ unsigned cvtpk(float lo, float hi) { return pg8::cvt_pk_bf16(lo, hi); }
__device__ __forceinline__ float bflo(unsigned w) { return __uint_as_float(w << 16); }
__device__ __forceinline__ float bfhi(unsigned w) { return __uint_as_float(w & 0xffff0000u); }
#define EX2(x) __builtin_amdgcn_exp2f(x)
__device__ __forceinline__ v4u ld16_sc1(const void* p) {
    const unsigned long long a = __hip_atomic_load((const unsigned long long*)p, __ATOMIC_RELAXED, __HIP_MEMORY_SCOPE_AGENT), b = __hip_atomic_load((const unsigned long long*)p + 1, __ATOMIC_RELAXED, __HIP_MEMORY_SCOPE_AGENT);
    return (v4u){(unsigned)a, (unsigned)(a >> 32), (unsigned)b, (unsigned)(b >> 32)};
}
#define MFMA16(x, y, c) __builtin_amdgcn_mfma_f32_16x16x32_bf16((x), (y), (c), 0, 0, 0)

struct Args { const float* in[25]; float* out; unsigned char* ws; };

__device__ __forceinline__ void p0_transpose_item(const float* W, int K, int N, bf16* WT, int dst_row0, LAS float* scr, int k0, int n0, int lane) {
#pragma unroll 8
    for (int i = 0; i < 32; ++i) { const int kk = 2 * i + (lane >> 5); scr[kk * 33 + (lane & 31)] = W[(size_t)(k0 + kk) * N + n0 + (lane & 31)]; }
    LDS_WAIT(); asm volatile("" ::: "memory");
    const int c = lane & 7;
#pragma unroll
    for (int j = 0; j < 4; ++j) { const int n = (lane >> 3) + 8 * j; const LAS float* s = scr + (8 * c) * 33 + n;
        v4u o; o.x = pk2(s[0 * 33], s[1 * 33]); o.y = pk2(s[2 * 33], s[3 * 33]); o.z = pk2(s[4 * 33], s[5 * 33]); o.w = pk2(s[6 * 33], s[7 * 33]);
        *(GAS v4u*)(WT + (size_t)(dst_row0 + n) * K + k0 + 8 * c) = o; }
    LDS_WAIT(); asm volatile("" ::: "memory");
}
__device__ __forceinline__ int map_in(int c) {
    if (c < 1024) { const int base = c < 512 ? 0 : 1024, cc = c & 511, h = cc >> 7, d = cc & 127; return base + 256 * (h >> 1) + 128 * (d >> 6) + 64 * (h & 1) + (d & 63); }
    if (c < 1536) return 1536 + (c - 1024);
    if (c < 2048) return 512 + (c - 1536);
    return c;
}

template <bool FINAL>
__device__ __forceinline__ void norm_rows(const float* src0, const float* src1, const float* gamma, const float* mods, int sh_off, int sc_off, bf16* A, float* outF, int row_lo, int row_hi, int lw, int NLW, int lane) {
    for (int row = row_lo + lw; row < row_hi; row += NLW) {
        const bool lat = row >= MCTX; const int grp = lat ? 1 + ((row - MCTX) >> 12) : 0;
        const f32x4* xr = (const f32x4*)((lat ? src1 + (size_t)(row - MCTX) * D : src0 + (size_t)row * D)) + lane;
        f32x4 v[4]; float s = 0.f;
#pragma unroll
        for (int j = 0; j < 4; ++j) { v[j] = xr[64 * j]; s += (v[j].x * v[j].x + v[j].y * v[j].y) + (v[j].z * v[j].z + v[j].w * v[j].w); }
        const float r = 1.0f / sqrtf(wave_sum(s) * (1.f / D) + EPS);
#pragma unroll
        for (int j = 0; j < 4; ++j) { const int col = 4 * (lane + 64 * j); const f32x4 g = *(const f32x4*)(gamma + col);
            if (FINAL) { *(f32x4*)(outF + (size_t)row * D + col) = v[j] * r * g; }
            else { const f32x4 sc = *(const f32x4*)(mods + (size_t)grp * NMOD + sc_off + col), sh = *(const f32x4*)(mods + (size_t)grp * NMOD + sh_off + col);
                const f32x4 a = (v[j] * r * g) * (sc + 1.0f) + sh;
                *(unsigned long long*)(A + (size_t)row * D + col) = (unsigned long long)cvtpk(a.x, a.y) | ((unsigned long long)cvtpk(a.z, a.w) << 32); } }
    }
}

__device__ __forceinline__ void stage_nat(LAS unsigned char* dst, const bf16* src, int ld, int tid) {
#pragma unroll
    for (int i = 0; i < 4; ++i) { const int c = tid + NTHR * i, row = c >> 4, cc = c & 15; *(LAS v4u*)(dst + row * RS + cc * 16) = *(const v4u*)(src + (size_t)row * ld + cc * 8); }
}


__device__ __forceinline__ void stage_zero(LAS unsigned char* dst, int tid) {
#pragma unroll
    for (int i = 0; i < 4; ++i) { const int c = tid + NTHR * i, row = c >> 4, cc = c & 15; *(LAS v4u*)(dst + row * RS + cc * 16) = (v4u){0u, 0u, 0u, 0u}; }
}


__device__ __forceinline__ void xcc_barrier(unsigned* lw, unsigned nloc, unsigned* tmo) {
    asm volatile("s_waitcnt vmcnt(0)" ::: "memory");
    __syncthreads();
    if (threadIdx.x == 0) {
        const unsigned old = xb_add(lw, 1u), gen = old / nloc;
        if (old + 1u == (gen + 1u) * nloc) xb_add(lw + 64, 1u);
        else XB_SPIN(xb_ld(lw + 64) == gen, tmo);
        __builtin_amdgcn_fence(__ATOMIC_ACQUIRE, "agent");
        asm volatile("s_waitcnt vmcnt(0)" ::: "memory");
    }
    __syncthreads();
}

__global__ void __launch_bounds__(NTHR, 2) hyb_fwd(Args args) {
    extern __shared__ __attribute__((aligned(16))) unsigned char lds_raw[];
    LAS unsigned char* lds = (LAS unsigned char*)lds_raw;
    volatile LAS unsigned* MISC = (volatile LAS unsigned*)(lds + MISC_OFF);
    const int tid = threadIdx.x, lane = tid & 63, wave = __builtin_amdgcn_readfirstlane(tid >> 6), fr = lane & 15, fq = lane >> 4;
    const int G = gridDim.x, bx = blockIdx.x;
    const int gw = bx * NWAVES + wave, NGW = G * NWAVES;
    unsigned char* ws = args.ws;
    if (tid < 64) MISC[tid] = 0u;
    __syncthreads();
    XcdBarrier bar = xcd_barrier_post((unsigned*)(ws + WS_CTL) + CW_BAR, MISC + 8);
    if (tid == 0) MISC[16] = __hip_atomic_fetch_add((unsigned*)(ws + WS_CTL) + CW_RANK + 64 * bar.x, 1u, __ATOMIC_RELAXED, __HIP_MEMORY_SCOPE_AGENT);

    const float* x_ctx = args.in[0]; const float* x_lat = args.in[1];
    float* mods = (float*)(ws + WS_MODS); float* rotc = (float*)(ws + WS_ROTC); float* rots = (float*)(ws + WS_ROTS);
    bf16* W13A = (bf16*)(ws + WS_W13A); bf16* W13B = (bf16*)(ws + WS_W13B); bf16* W2A = (bf16*)(ws + WS_W2A); bf16* W2B = (bf16*)(ws + WS_W2B);
    bf16* WIN = (bf16*)(ws + WS_WIN); bf16* WOUT = (bf16*)(ws + WS_WOUT); bf16* POOLW = (bf16*)(ws + WS_POOLW);
    bf16* ABUF = (bf16*)(ws + WS_ABUF); bf16* HBUF = (bf16*)(ws + WS_HBUF); bf16* SBUF = ABUF; bf16* QKV = HBUF; bf16* SLAT = (bf16*)(ws + WS_SLAT);
    float* out = args.out;
    float* biasq = (float*)(ws + WS_BIASQ); float* bias3 = (float*)(ws + WS_BIAS3); float* rrow = (float*)(ws + WS_RROW); float* sspa = (float*)(ws + WS_SSPA); float* sspb = (float*)(ws + WS_SSPB);

    {
        LAS float* scr = (LAS float*)(lds + wave * 16384);
        constexpr int I_W1 = 16 * 88, I_W2 = 44 * 32, I_IN = 16 * 80, I_OUT = 16 * 32, I_POOL = 32;
        constexpr int NITEMS = 4 * I_W1 + 2 * I_W2 + I_IN + I_OUT + I_POOL;
        for (int it = gw; it < NITEMS; it += NGW) {
            int r = it;
            if (r < 4 * I_W1) { const int which = r / I_W1; r -= which * I_W1; const int kb = r / 88, nb = r % 88, n0 = 32 * nb;
                const float* src = args.in[which == 0 ? 9 : which == 1 ? 10 : which == 2 ? 21 : 22]; bf16* dst = which < 2 ? W13A : W13B;
                p0_transpose_item(src, D, FF, dst, 256 * (n0 >> 7) + 128 * (which & 1) + (n0 & 127), scr, 64 * kb, n0, lane); continue; }
            r -= 4 * I_W1;
            if (r < 2 * I_W2) { const int which = r / I_W2; r -= which * I_W2; const int kb = r / 32, nb = r % 32;
                p0_transpose_item(args.in[which ? 23 : 11], FF, D, which ? W2B : W2A, 32 * nb, scr, 64 * kb, 32 * nb, lane); continue; }
            r -= 2 * I_W2;
            if (r < I_IN) { const int kb = r / 80, nb = r % 80; p0_transpose_item(args.in[13], D, NIN, WIN, map_in(32 * nb), scr, 64 * kb, 32 * nb, lane); continue; }
            r -= I_IN;
            if (r < I_OUT) { const int kb = r / 32, nb = r % 32; p0_transpose_item(args.in[19], D, D, WOUT, 32 * nb, scr, 64 * kb, 32 * nb, lane); continue; }
            r -= I_OUT;
            { const int g = r >> 3, kb = (r >> 2) & 1, nb = r & 3; p0_transpose_item(args.in[17] + g * 16384, 128, 128, POOLW + g * 16384, 32 * nb, scr, 64 * kb, 32 * nb, lane); }
        }
        for (int i = bx * NTHR + tid; i < 2 * 2097152 / 4; i += G * NTHR) *(f32x4*)(out + OUT_SF + 4 * i) = (f32x4){0.f, 0.f, 0.f, 0.f};
        { const int gt = bx * NTHR + tid;
          if (gt < 2048) { const int pos = gt >> 5, f = gt & 31; double fr_ = 1.0; for (int i = 0; i < f; ++i) fr_ *= 0.7498942093324559;
              const double a = (double)pos * fr_; const double n = __builtin_rint(a * 0.15915494309189535); const double rr = a - n * 6.283185307179586; const double r2 = rr * rr;
              double cs = 1.0, sn = 1.0;
              for (int k = 13; k >= 1; --k) { cs = 1.0 - cs * r2 / (double)((2 * k - 1) * (2 * k)); sn = 1.0 - sn * r2 / (double)((2 * k) * (2 * k + 1)); }
              rotc[gt] = (float)cs; rots[gt] = (float)(sn * rr); } }
        __syncthreads();
        LAS float* scond = (LAS float*)lds;
        LAS float* red = (LAS float*)(lds + 5 * 1024 * 4);
        for (int i = tid; i < 5 * D; i += NTHR) { const int g = i >> 10, k = i & 1023; const float cv = g == 0 ? args.in[5][k] : args.in[4][(g - 1) * D + k]; scond[i] = cv / (1.0f + expf(-cv)); }
        __syncthreads();
        const float* ada_w = args.in[6]; const float* ada_b = args.in[7];
        for (int it = bx; it < NMOD / 32; it += G) {
            const int c0 = 32 * it, col = lane & 31, kp = lane >> 5; float a0 = 0.f, a1 = 0.f, a2 = 0.f, a3 = 0.f, a4 = 0.f;
#pragma unroll 8
            for (int i = 0; i < 64; ++i) { const int k = 128 * wave + 2 * i + kp; const float wv = ada_w[(size_t)k * NMOD + c0 + col];
                a0 += scond[k] * wv; a1 += scond[1024 + k] * wv; a2 += scond[2048 + k] * wv; a3 += scond[3072 + k] * wv; a4 += scond[4096 + k] * wv; }
            a0 += __shfl_xor(a0, 32); a1 += __shfl_xor(a1, 32); a2 += __shfl_xor(a2, 32); a3 += __shfl_xor(a3, 32); a4 += __shfl_xor(a4, 32);
            if (lane < 32) { LAS float* rp = red + wave * 160 + col; rp[0] = a0; rp[32] = a1; rp[64] = a2; rp[96] = a3; rp[128] = a4; }
            __syncthreads();
            if (tid < 160) { float s = 0.f;
#pragma unroll
                for (int w = 0; w < 8; ++w) s += red[w * 160 + tid];
                const int g = tid >> 5, cc = tid & 31; mods[(size_t)g * NMOD + c0 + cc] = s + ada_b[c0 + cc]; }
            __syncthreads();
        }
    }
    xcd_barrier(bar);

    if (tid == 0) { unsigned xi_ = 0, nx_ = 0; unsigned* bw = (unsigned*)(ws + WS_CTL) + CW_BAR;
        for (unsigned j = 0; j < 16; ++j) { const unsigned c = xb_ld(&bw[XB_XCNT(j)]); if (c) { if (j < bar.x) ++xi_; ++nx_; } }
        MISC[17] = xi_; MISC[18] = nx_; MISC[19] = xb_ld(&bw[XB_XCNT(bar.x)]); }
    __syncthreads();
    const int rank = __builtin_amdgcn_readfirstlane((int)MISC[16]), xi = __builtin_amdgcn_readfirstlane((int)MISC[17]), nx = __builtin_amdgcn_readfirstlane((int)MISC[18]), nloc = __builtin_amdgcn_readfirstlane((int)MISC[19]);
    const int t0 = (96 * xi) / nx, t1 = (96 * (xi + 1)) / nx;
    const int lwv = rank * NWAVES + wave, NLW = nloc * NWAVES;
    unsigned* const lbw = (unsigned*)(ws + WS_CTL) + CW_LBAR + 128 * bar.x;
#define LOCAL_BAR() xcc_barrier(lbw, (unsigned)nloc, (unsigned*)(ws + WS_CTL) + CW_BAR)
    const int nitl = (t1 - t0) * 8;

    for (int rw = gw; rw < NIN + NUP; rw += NGW) {
        const bool isq = rw < NIN; const int n = isq ? rw : rw - NIN; const bf16* wrow = (isq ? WIN : W13B) + (size_t)n * D + 16 * lane;
        const v4u w0 = *(const v4u*)wrow, w1 = *(const v4u*)(wrow + 8); float wv[16];
#pragma unroll
        for (int q = 0; q < 4; ++q) { wv[2 * q] = bflo(w0[q]); wv[2 * q + 1] = bfhi(w0[q]); wv[8 + 2 * q] = bflo(w1[q]); wv[8 + 2 * q + 1] = bfhi(w1[q]); }
        const float* shp = mods + (isq ? 3072 : 6144) + 16 * lane;
#pragma unroll
        for (int g = 0; g < 5; ++g) { float a = 0.f;
#pragma unroll
            for (int q = 0; q < 4; ++q) { const f32x4 sv = *(const f32x4*)(shp + (size_t)g * NMOD + 4 * q); a += (sv[0] * wv[4 * q] + sv[1] * wv[4 * q + 1]) + (sv[2] * wv[4 * q + 2] + sv[3] * wv[4 * q + 3]); }
            a = wave_sum(a); if (lane == 0) (isq ? biasq + g * NIN : bias3 + g * NUP)[n] = a; }
    }
    norm_rows<false>(x_ctx, x_lat, args.in[8], mods, 0, 1024, ABUF, nullptr, 256 * t0, 256 * t1, lwv, NLW, lane);
    xcd_barrier(bar);

    { pg8::Gemm g{ABUF, W13A, M, NUP, D, D, D}; pg8::AffOrder S; S.init(t0, t1, NUP, nloc, rank); pg8::EpiSwiglu E{HBUF, FF, nullptr, nullptr};
      pg8::gemm_phase<pg8::EpiSwiglu, pg8::AffOrder, true, true>(lds, g, S, E); }
    LOCAL_BAR();
    { pg8::Gemm g{HBUF, W2A, M, D, FF, FF, FF}; pg8::AffOrder S; S.init(t0, t1, D, nloc, rank, 0); pg8::EpiResid E{x_ctx, x_lat, out, mods + 2048, 0.5f, nullptr, ABUF, args.in[12], mods + 4096, sspa, sspb};
      pg8::gemm_phase<pg8::EpiResid, pg8::AffOrder, true, true>(lds, g, S, E); }
    LOCAL_BAR();
    for (int r = 256 * t0 + rank * NTHR + tid; r < 256 * t1; r += nloc * NTHR) { const f32x4 a0 = *(const f32x4*)(sspa + (size_t)r * 8), a1 = *(const f32x4*)(sspa + (size_t)r * 8 + 4), b0 = *(const f32x4*)(sspb + (size_t)r * 8), b1 = *(const f32x4*)(sspb + (size_t)r * 8 + 4);
        const float ssq = (((a0[0] + a0[1]) + (a0[2] + a0[3])) + ((a1[0] + a1[1]) + (a1[2] + a1[3]))) + (((b0[0] + b0[1]) + (b0[2] + b0[3])) + ((b1[0] + b1[1]) + (b1[2] + b1[3])));
        rrow[r] = 1.0f / sqrtf(ssq * (1.f / D) + EPS); }
    LOCAL_BAR();
    { pg8::Gemm g{ABUF, WIN, M, NIN, D, D, D}; pg8::AffOrder S; S.init(t0, t1, NIN, nloc, rank); pg8::EpiQKV E{QKV, LDQ, rotc, rots, rrow, biasq};
      pg8::gemm_phase<pg8::EpiQKV, pg8::AffOrder, true, true>(lds, g, S, E); }
    LOCAL_BAR();

    {
        LAS unsigned char* KT = lds; LAS unsigned char* VFT = lds + 128 * RS; LAS unsigned char* VBT = lds + 2 * 128 * RS;
        for (int li = rank; li < nitl; li += nloc) {
            const int item = 8 * t0 + li, cg = item >> 2, h = item & 3, row0 = cg * 128;
            const float l2f = -expf(args.in[14][h]) * 1.4426950408889634f, l2b = -expf(args.in[15][h]) * 1.4426950408889634f;
            const int jp = 16 * (wave & 3) + (lane & 15), j0 = 2 * jp;
            const float wf0 = EX2(l2f * (float)(127 - j0)), wf1 = EX2(l2f * (float)(126 - j0)), wb0 = EX2(l2b * (float)j0), wb1 = EX2(l2b * (float)(j0 + 1));
#pragma unroll
            for (int pass = 0; pass < 2; ++pass) {
                const int c0 = 8 * (4 * (wave >> 2) + (lane >> 4) + 8 * pass);
                const bf16* kr = QKV + (size_t)(row0 + j0) * LDQ + 1024 + h * 128 + c0; const bf16* vr = kr + 512;
                const v4u ka = *(const v4u*)kr, kb = *(const v4u*)(kr + LDQ), va = *(const v4u*)vr, vb = *(const v4u*)(vr + LDQ);
#pragma unroll
                for (int q = 0; q < 4; ++q) {
                    const unsigned a = ka[q], b = kb[q], c = va[q], d = vb[q];
                    const int r0 = (c0 + 2 * q) * RS + jp * 4, r1 = r0 + RS;
                    *(LAS unsigned*)(KT + r0) = (a & 0xffffu) | (b << 16); *(LAS unsigned*)(KT + r1) = (a >> 16) | (b & 0xffff0000u);
                    const float v00 = bflo(c), v01 = bfhi(c), v10 = bflo(d), v11 = bfhi(d);
                    *(LAS unsigned*)(VFT + r0) = cvtpk(v00 * wf0, v10 * wf1); *(LAS unsigned*)(VFT + r1) = cvtpk(v01 * wf0, v11 * wf1);
                    *(LAS unsigned*)(VBT + r0) = cvtpk(v00 * wb0, v10 * wb1); *(LAS unsigned*)(VBT + r1) = cvtpk(v01 * wb0, v11 * wb1);
                }
            }
            __syncthreads();
            f32x4 af[8], ab[8];
#pragma unroll
            for (int dt = 0; dt < 8; ++dt) { af[dt] = (f32x4){0.f, 0.f, 0.f, 0.f}; ab[dt] = (f32x4){0.f, 0.f, 0.f, 0.f}; }
#pragma unroll
            for (int kk = 0; kk < 4; ++kk) {
                const int ko = (32 * kk + 8 * fq) * 2;
                const bf16x8 yf = *(const LAS bf16x8*)(VFT + (16 * wave + fr) * RS + ko), yb = *(const LAS bf16x8*)(VBT + (16 * wave + fr) * RS + ko);
#pragma unroll
                for (int dt = 0; dt < 8; ++dt) { const bf16x8 xk = *(const LAS bf16x8*)(KT + (16 * dt + fr) * RS + ko); af[dt] = MFMA16(xk, yf, af[dt]); ab[dt] = MFMA16(xk, yb, ab[dt]); }
            }
            bf16* sf = SBUF + ((size_t)item * 2) * 16384 + (16 * wave + fr) * 128 + 4 * fq; bf16* sb = sf + 16384;
#pragma unroll
            for (int dt = 0; dt < 8; ++dt) {
                *(unsigned long long*)(sf + 16 * dt) = (unsigned long long)cvtpk(af[dt][0], af[dt][1]) | ((unsigned long long)cvtpk(af[dt][2], af[dt][3]) << 32);
                *(unsigned long long*)(sb + 16 * dt) = (unsigned long long)cvtpk(ab[dt][0], ab[dt][1]) | ((unsigned long long)cvtpk(ab[dt][2], ab[dt][3]) << 32);
            }
            if (item < 256) {
                const int nch = cg & 1, bh = (cg >> 1) * 4 + h;
                const float sfw = nch == 0 ? exp2f(l2f * 128.0f) : 1.0f, sbw = nch == 1 ? exp2f(l2b * 128.0f) : 1.0f;
                float* cf = out + OUT_SF + (size_t)bh * 16384 + (4 * fq) * 128 + 16 * wave + fr; float* cb = out + OUT_SB + (size_t)bh * 16384 + (4 * fq) * 128 + 16 * wave + fr;
#pragma unroll
                for (int dt = 0; dt < 8; ++dt)
#pragma unroll
                    for (int i = 0; i < 4; ++i) { unsafeAtomicAdd(cf + (16 * dt + i) * 128, af[dt][i] * sfw); unsafeAtomicAdd(cb + (16 * dt + i) * 128, ab[dt][i] * sbw); }
            }
            __syncthreads();
        }
    }
    xcd_barrier(bar);

    {
        const int gt = bx * NTHR + tid, GT = G * NTHR;
        for (int task = gt; task < 4 * 4 * 2 * 2048; task += GT) {
            const int e8 = task & 2047, dir = (task >> 11) & 1, h = (task >> 12) & 3, b = task >> 14;
            float carry[8];
            { const float* s0 = args.in[dir ? 3 : 2] + ((size_t)b * 4 + h) * 16384; const int dv = e8 >> 4, dk0 = (e8 & 15) * 8;
#pragma unroll
              for (int e = 0; e < 8; ++e) carry[e] = s0[(dk0 + e) * 128 + dv]; }
            const float gC = exp2f(-expf(args.in[dir ? 15 : 14][h]) * 1.4426950408889634f * 128.0f);
            for (int sb = 0; sb < 32; sb += 8) {
                v4u kv[8];
#pragma unroll
                for (int i = 0; i < 8; ++i) { const int n = dir ? 31 - (sb + i) : sb + i; kv[i] = *(const v4u*)(SBUF + (((size_t)(64 + 32 * b + n) * 4 + h) * 2 + dir) * 16384 + e8 * 8); }
#pragma unroll
                for (int i = 0; i < 8; ++i) { const int n = dir ? 31 - (sb + i) : sb + i;
                    v4u o; o.x = cvtpk(carry[0], carry[1]); o.y = cvtpk(carry[2], carry[3]); o.z = cvtpk(carry[4], carry[5]); o.w = cvtpk(carry[6], carry[7]);
                    *(v4u*)(SLAT + (((size_t)(32 * b + n) * 4 + h) * 2 + dir) * 16384 + e8 * 8) = o;
#pragma unroll
                    for (int q = 0; q < 4; ++q) { carry[2 * q] = carry[2 * q] * gC + bflo(kv[i][q]); carry[2 * q + 1] = carry[2 * q + 1] * gC + bfhi(kv[i][q]); } }
            }
        }
    }
    xcd_barrier(bar);

    {
        LAS unsigned char* KP = lds; LAS unsigned char* VT = lds + 128 * RS; LAS unsigned char* SFT = lds + 2 * 128 * RS; LAS unsigned char* SBT = lds + 3 * 128 * RS;
        LAS unsigned char* US = lds; LAS unsigned char* WT = lds + 2 * 128 * RS;
        for (int li = rank; li < nitl; li += nloc) {
            const int item = 8 * t0 + li, cg = item >> 2, h = item & 3, row0 = cg * 128;
            const bool lat = cg >= 64; const int n = lat ? (cg - 64) & 31 : cg & 1, L = lat ? 4096 : 256, seq_row0 = row0 - n * 128;
            const float l2f = -expf(args.in[14][h]) * 1.4426950408889634f, l2b = -expf(args.in[15][h]) * 1.4426950408889634f;
            stage_nat(KP, QKV + (size_t)row0 * LDQ + 1024 + h * 128, LDQ, tid);
            if (lat) { stage_nat(SFT, SLAT + ((size_t)(item - 256) * 2) * 16384, 128, tid); stage_nat(SBT, SLAT + ((size_t)(item - 256) * 2 + 1) * 16384, 128, tid); }
            else if (n == 0) { stage_zero(SFT, tid); stage_nat(SBT, SBUF + ((size_t)(item + 4) * 2 + 1) * 16384, 128, tid); }
            else { stage_nat(SFT, SBUF + ((size_t)(item - 4) * 2) * 16384, 128, tid); stage_zero(SBT, tid); }
            { const int jp = 16 * (wave & 3) + (lane & 15), j0 = 2 * jp;
#pragma unroll
              for (int pass = 0; pass < 2; ++pass) { const int c0 = 8 * (4 * (wave >> 2) + (lane >> 4) + 8 * pass);
                  const bf16* vr = QKV + (size_t)(row0 + j0) * LDQ + 1536 + h * 128 + c0; const v4u va = *(const v4u*)vr, vb = *(const v4u*)(vr + LDQ);
#pragma unroll
                  for (int q = 0; q < 4; ++q) { const unsigned a = va[q], b = vb[q]; const int r0 = (c0 + 2 * q) * RS + jp * 4;
                      *(LAS unsigned*)(VT + r0) = (a & 0xffffu) | (b << 16); *(LAS unsigned*)(VT + r0 + RS) = (a >> 16) | (b & 0xffff0000u); } } }
            const int il = 16 * wave + fr, row = row0 + il;
            bf16x8 yq[4];
#pragma unroll
            for (int kk = 0; kk < 4; ++kk) yq[kk] = *(const bf16x8*)(QKV + (size_t)row * LDQ + h * 128 + 32 * kk + 8 * fq);
            __syncthreads();
            f32x4 sc[8];
#pragma unroll
            for (int jt = 0; jt < 8; ++jt) { sc[jt] = (f32x4){0.f, 0.f, 0.f, 0.f};
#pragma unroll
                for (int kk = 0; kk < 4; ++kk) sc[jt] = MFMA16(*(const LAS bf16x8*)(KP + (16 * jt + fr) * RS + (32 * kk + 8 * fq) * 2), yq[kk], sc[jt]); }
#pragma unroll
            for (int jt = 0; jt < 8; ++jt)
#pragma unroll
                for (int i = 0; i < 4; ++i) { const int j = 16 * jt + 4 * fq + i, dl = il - j; const float w = dl > 0 ? EX2(l2f * (float)dl) : (dl < 0 ? EX2(l2b * (float)(-dl)) : 2.0f); sc[jt][i] *= w; }
            __syncthreads();
#pragma unroll
            for (int jt = 0; jt < 8; ++jt) *(LAS unsigned long long*)(KP + il * RS + (16 * jt + 4 * fq) * 2) = (unsigned long long)cvtpk(sc[jt][0], sc[jt][1]) | ((unsigned long long)cvtpk(sc[jt][2], sc[jt][3]) << 32);
            __syncthreads();
            f32x4 oi[8];
#pragma unroll
            for (int dt = 0; dt < 8; ++dt) oi[dt] = (f32x4){0.f, 0.f, 0.f, 0.f};
            const float cfw = EX2(l2f * (float)(il + 1)), cbw = EX2(l2b * (float)(128 - il));
#pragma unroll 1
            for (int kk = 0; kk < 4; ++kk) { const int ko = (32 * kk + 8 * fq) * 2; const bf16x8 yp = *(const LAS bf16x8*)(KP + il * RS + ko);
                const v4u qw = *(const v4u*)(QKV + (size_t)row * LDQ + h * 128 + 32 * kk + 8 * fq); v4u qf, qb;
#pragma unroll
                for (int q = 0; q < 4; ++q) { const float lo = bflo(qw[q]), hi = bfhi(qw[q]); qf[q] = cvtpk(lo * cfw, hi * cfw); qb[q] = cvtpk(lo * cbw, hi * cbw); }
                const bf16x8 yqf = __builtin_bit_cast(bf16x8, qf), yqb = __builtin_bit_cast(bf16x8, qb);
#pragma unroll
                for (int dt = 0; dt < 8; ++dt) { const int ro = (16 * dt + fr) * RS + ko;
                    oi[dt] = MFMA16(*(const LAS bf16x8*)(VT + ro), yp, oi[dt]); oi[dt] = MFMA16(*(const LAS bf16x8*)(SFT + ro), yqf, oi[dt]); oi[dt] = MFMA16(*(const LAS bf16x8*)(SBT + ro), yqb, oi[dt]); } }
            float ss = 0.f;
#pragma unroll
            for (int dt = 0; dt < 8; ++dt) ss += (oi[dt][0] * oi[dt][0] + oi[dt][1] * oi[dt][1]) + (oi[dt][2] * oi[dt][2] + oi[dt][3] * oi[dt][3]);
            ss += __shfl_xor(ss, 16); ss += __shfl_xor(ss, 32);
            const float rn = 1.0f / sqrtf(ss * (1.0f / 128.0f) + EPS);
            { bf16* qrow = QKV + (size_t)row * LDQ + h * 128 + 4 * fq; const bf16* grow = qrow + 512; const float* gn = args.in[16] + h * 128 + 4 * fq;
#pragma unroll
              for (int dt = 0; dt < 8; ++dt) { const unsigned long long gw_ = *(const unsigned long long*)(grow + 16 * dt); const f32x4 g4 = *(const f32x4*)(gn + 16 * dt);
                  const unsigned g01 = (unsigned)gw_, g23 = (unsigned)(gw_ >> 32);
                  const float r0 = oi[dt][0] * rn * g4[0] * pg8::silu_f(bflo(g01)), r1 = oi[dt][1] * rn * g4[1] * pg8::silu_f(bfhi(g01));
                  const float r2 = oi[dt][2] * rn * g4[2] * pg8::silu_f(bflo(g23)), r3 = oi[dt][3] * rn * g4[3] * pg8::silu_f(bfhi(g23));
                  *(unsigned long long*)(qrow + 16 * dt) = (unsigned long long)cvtpk(r0, r1) | ((unsigned long long)cvtpk(r2, r3) << 32); } }
            __syncthreads();
            { const int half = 1 << h;
              for (int c = tid; c < 144 * 16; c += NTHR) { const int lr = c >> 4, cc = c & 15, pos = n * 128 - 8 + lr; v4u v = (v4u){0u, 0u, 0u, 0u};
                  if (pos >= 0 && pos < L) v = *(const v4u*)(QKV + (size_t)(seq_row0 + pos) * LDQ + 2048 + h * 128 + cc * 8);
                  *(LAS v4u*)(US + lr * RS + cc * 16) = v; }
              stage_nat(WT, POOLW + h * 16384, 128, tid);
              __syncthreads();
              const int pos = n * 128 + il, lo = pos - half > 0 ? pos - half : 0, hi = pos + half < L ? pos + half : L; const float inv = 1.0f / (float)(hi - lo);
              bf16x8 yd[4];
#pragma unroll
              for (int kk = 0; kk < 4; ++kk) { const int co = (32 * kk + 8 * fq) * 2; float s[8];
#pragma unroll
                  for (int e = 0; e < 8; ++e) s[e] = 0.f;
                  for (int dd = -half; dd < half; ++dd) { const v4u v = *(const LAS v4u*)(US + (il + 8 + dd) * RS + co);
#pragma unroll
                      for (int q = 0; q < 4; ++q) { s[2 * q] += bflo(v[q]); s[2 * q + 1] += bfhi(v[q]); } }
                  const v4u cv = *(const LAS v4u*)(US + (il + 8) * RS + co); v4u dq;
#pragma unroll
                  for (int q = 0; q < 4; ++q) dq[q] = cvtpk(s[2 * q] * inv - bflo(cv[q]), s[2 * q + 1] * inv - bfhi(cv[q]));
                  yd[kk] = __builtin_bit_cast(bf16x8, dq); }
              f32x4 po[8];
#pragma unroll
              for (int dt = 0; dt < 8; ++dt) { po[dt] = (f32x4){0.f, 0.f, 0.f, 0.f};
#pragma unroll
                  for (int kk = 0; kk < 4; ++kk) po[dt] = MFMA16(*(const LAS bf16x8*)(WT + (16 * dt + fr) * RS + (32 * kk + 8 * fq) * 2), yd[kk], po[dt]); }
              bf16* prow = QKV + (size_t)row * LDQ + 512 + h * 128 + 4 * fq; const float* ps = args.in[18] + h * 128 + 4 * fq;
#pragma unroll
              for (int dt = 0; dt < 8; ++dt) { const f32x4 p4 = *(const f32x4*)(ps + 16 * dt);
                  *(unsigned long long*)(prow + 16 * dt) = (unsigned long long)cvtpk(po[dt][0] * p4[0], po[dt][1] * p4[1]) | ((unsigned long long)cvtpk(po[dt][2] * p4[2], po[dt][3] * p4[3]) << 32); }
            }
            __syncthreads();
        }
    }
    xcd_barrier(bar);

    { pg8::Gemm g{QKV, WOUT, M, D, D, LDQ, D}; pg8::AffOrder S; S.init(t0, t1, D, nloc, rank, 0); pg8::EpiResid E{out, out + (size_t)MCTX * D, out, mods + 5120, 1.0f, nullptr, ABUF, args.in[20], mods + 7168, sspa, sspb};
      pg8::gemm_phase<pg8::EpiResid, pg8::AffOrder, true, true>(lds, g, S, E); }
    LOCAL_BAR();
    for (int r = 256 * t0 + rank * NTHR + tid; r < 256 * t1; r += nloc * NTHR) { const f32x4 a0 = *(const f32x4*)(sspa + (size_t)r * 8), a1 = *(const f32x4*)(sspa + (size_t)r * 8 + 4), b0 = *(const f32x4*)(sspb + (size_t)r * 8), b1 = *(const f32x4*)(sspb + (size_t)r * 8 + 4);
        const float ssq = (((a0[0] + a0[1]) + (a0[2] + a0[3])) + ((a1[0] + a1[1]) + (a1[2] + a1[3]))) + (((b0[0] + b0[1]) + (b0[2] + b0[3])) + ((b1[0] + b1[1]) + (b1[2] + b1[3])));
        rrow[r] = 1.0f / sqrtf(ssq * (1.f / D) + EPS); }
    LOCAL_BAR();
    { pg8::Gemm g{ABUF, W13B, M, NUP, D, D, D}; pg8::AffOrder S; S.init(t0, t1, NUP, nloc, rank); pg8::EpiSwiglu E{HBUF, FF, rrow, bias3};
      pg8::gemm_phase<pg8::EpiSwiglu, pg8::AffOrder, true, true>(lds, g, S, E); }
    LOCAL_BAR();
    { pg8::Gemm g{HBUF, W2B, M, D, FF, FF, FF}; pg8::AffOrder S; S.init(t0, t1, D, nloc, rank, 0); pg8::EpiResid E{out, out + (size_t)MCTX * D, out, mods + 8192, 0.5f, nullptr, nullptr, nullptr, nullptr, nullptr, nullptr};
      pg8::gemm_phase<pg8::EpiResid, pg8::AffOrder, true, true>(lds, g, S, E); }
    LOCAL_BAR();
    norm_rows<true>(out, out + (size_t)MCTX * D, args.in[24], nullptr, 0, 0, nullptr, out, 256 * t0, 256 * t1, lwv, NLW, lane);
}

extern "C" void kernel_launch(void* const* d_in, const int* in_sizes, int n_in, void* d_out, int out_size, void* d_ws, size_t ws_size, hipStream_t stream) {
    static int grid = 0;
    if (grid == 0) {
        if (n_in != 25 || in_sizes[0] != MCTX * D || in_sizes[1] != MLAT * D || out_size != M * D + 2 * 32 * 4 * 128 * 128 || ws_size < 256 * MiB) {
            fprintf(stderr, "kernel_launch: unexpected shapes (n_in %d, out %d, ws %zu); nothing launched\n", n_in, out_size, ws_size); grid = -1; return; }
        int dev = 0, cus = 0, per_cu = 0;
        if (hipGetDevice(&dev) != hipSuccess || hipDeviceGetAttribute(&cus, hipDeviceAttributeMultiprocessorCount, dev) != hipSuccess) { grid = -1; return; }
        if (hipFuncSetAttribute((const void*)hyb_fwd, hipFuncAttributeMaxDynamicSharedMemorySize, LDS_BYTES) != hipSuccess) { fprintf(stderr, "kernel_launch: hipFuncSetAttribute failed\n"); grid = -1; return; }
        if (hipOccupancyMaxActiveBlocksPerMultiprocessor(&per_cu, (const void*)hyb_fwd, NTHR, LDS_BYTES) != hipSuccess || per_cu < 1) {
            fprintf(stderr, "kernel_launch: occupancy query reports %d workgroups per CU; nothing launched\n", per_cu); (void)hipGetLastError(); grid = -1; return; }
        grid = cus;
    }
    if (grid < 0) return;
    (void)hipMemsetAsync((char*)d_ws + WS_CTL, 0, CTL_ZERO_BYTES, stream);
    Args a{};
    for (int i = 0; i < 25; ++i) a.in[i] = (const float*)d_in[i];
    a.out = (float*)d_out; a.ws = (unsigned char*)d_ws;
    hipLaunchKernelGGL(hyb_fwd, dim3(grid), dim3(NTHR), LDS_BYTES, stream, a);
}
```

```cpp
#include <hip/hip_runtime.h>
#include <cstdio>
#include <cstdint>
namespace pg8 {
#define PG8_LAS __attribute__((address_space(3)))
typedef unsigned short bf16_t;
typedef short bf16x8 __attribute__((ext_vector_type(8)));
typedef float f32x4 __attribute__((ext_vector_type(4)));
typedef unsigned u32x4 __attribute__((ext_vector_type(4)));
constexpr int BM = 256, BK = 64, HALF = 128, HTB = HALF * BK * 2  , STAGE_BYTES = 8 * HTB, NXCD = 8, WGM = 8;

__host__ __device__ __forceinline__ int lds_byte(int r, int c) { const int st = (r >> 4) * 2 + (c >> 5), rr = r & 15, cc = c & 31, ob = rr * 64 + cc * 2; return st * 1024 + (ob ^ (((ob >> 9) & 1) << 5)); }
__host__ __device__ __forceinline__ void stage_rc(int b, int& R, int& C) { const int st = b / 1024, sb = b % 1024, swz = sb ^ (((sb >> 9) & 1) << 5); R = (st >> 1) * 16 + swz / 64; C = (st & 1) * 32 + (swz % 64) / 2; }
__host__ __device__ __forceinline__ int perm32(int rho) { const int n = rho >> 4, i = rho & 15; return 8 * (i >> 2) + 4 * n + (i & 3); }

struct Unit { int pm, pn, kh; };
struct Gemm { const bf16_t* A; const bf16_t* Bt; int M, N, K, lda, Kh; };

struct StaticOrder {
    int nM, nN, nwg, G, c;
    __host__ __device__ void init(int M, int N, int G_, int c_) { nM = M / BM; nN = N / BM; nwg = nM * nN; G = G_; c = c_; }
    __host__ __device__ bool next(int i, Unit& u) const {
        const long L = (long)i * G + c; if (L >= nwg) return false;
        int wgid = (int)L; { const int q = nwg / NXCD, r = nwg % NXCD, xcd = wgid % NXCD, off = wgid / NXCD; wgid = (xcd < r ? xcd * (q + 1) : r * (q + 1) + (xcd - r) * q) + off; }
        const int nig = WGM * nN, gid = wgid / nig, fm = gid * WGM, gsz = (nM - fm) < WGM ? (nM - fm) : WGM;
        u.pm = fm + ((wgid % nig) % gsz); u.pn = (wgid % nig) / gsz; return true;
    }
    __device__ __forceinline__ void a_ready(const Unit&) const {}
    __device__ __forceinline__ void done(const Unit&) const {}
};

typedef float f32x2 __attribute__((ext_vector_type(2)));
typedef __bf16 bf16x2_t __attribute__((ext_vector_type(2)));
__device__ __forceinline__ unsigned cvt_pk_bf16(float lo, float hi) { const f32x2 v = {lo, hi}; return __builtin_bit_cast(unsigned, __builtin_convertvector(v, bf16x2_t)); }
__device__ __forceinline__ float silu_f(float x) { return x * __builtin_amdgcn_rcpf(1.0f + __expf(-x)); }
struct EpiSwiglu {
    static constexpr bool PERM = true, AFTER_DRAIN = false;
    bf16_t* O; int ldo;
    const float* rrow; const float* bias;
    __device__ __forceinline__ void operator()(const f32x4 (&acc)[2][2][4][2], const Unit& u, int wr, int wc, int fr, int fq) const {
        const int rowt = u.pm * BM, row0 = rowt + wr * 64 + fr, col0 = u.pn * HALF + wc * 32 + 8 * fq;
        const int grp = rowt >= 8192 ? 1 + ((rowt - 8192) >> 12) : 0;
        f32x4 bg[2], bu[2];
#pragma unroll
        for (int n = 0; n < 2; ++n) { bg[n] = (f32x4){0.f, 0.f, 0.f, 0.f}; bu[n] = bg[n];
            if (rrow) { const float* bp = bias + (size_t)grp * 5632 + u.pn * BM + wc * 32 + 8 * fq + 4 * n; bg[n] = *(const f32x4*)bp; bu[n] = *(const f32x4*)(bp + HALF); } }
#pragma unroll
        for (int ai = 0; ai < 2; ++ai)
#pragma unroll
            for (int m = 0; m < 4; ++m) { const int r = row0 + ai * HALF + m * 16; bf16_t* rowp = O + (size_t)r * ldo + col0;
                const float rs = rrow ? rrow[r] : 1.0f;
                const f32x4 g0 = acc[ai][0][m][0] * rs + bg[0], g1 = acc[ai][0][m][1] * rs + bg[1], u0 = acc[ai][1][m][0] * rs + bu[0], u1 = acc[ai][1][m][1] * rs + bu[1];
                u32x4 w;
                w.x = cvt_pk_bf16(silu_f(g0[0]) * u0[0], silu_f(g0[1]) * u0[1]); w.y = cvt_pk_bf16(silu_f(g0[2]) * u0[2], silu_f(g0[3]) * u0[3]);
                w.z = cvt_pk_bf16(silu_f(g1[0]) * u1[0], silu_f(g1[1]) * u1[1]); w.w = cvt_pk_bf16(silu_f(g1[2]) * u1[2], silu_f(g1[3]) * u1[3]);
                *(u32x4*)rowp = w; }
    }
};
struct EpiResid {
    static constexpr bool PERM = true, AFTER_DRAIN = false;
    const float* base0; const float* base1; float* out; const float* coef; float mul;
    unsigned* flag;
    bf16_t* hm; const float* gamma; const float* scn; float* sspa; float* sspb;
    __device__ __forceinline__ void operator()(const f32x4 (&acc)[2][2][4][2], const Unit& u, int wr, int wc, int fr, int fq) const {
        const int rowt = u.pm * BM; const bool lat = rowt >= 8192; const int grp = lat ? 1 + ((rowt - 8192) >> 12) : 0;
        const float* bp = lat ? base1 : base0; const int rsub = lat ? 8192 : 0;
        const int row0 = rowt + wr * 64 + fr, col0 = u.pn * BM + wc * 32 + 8 * fq;
        float* ssp = (u.pn < 2 ? sspa : sspb) + (u.pn & 1) * 4 + wc;
        float ss8[8];
#pragma unroll
        for (int k = 0; k < 8; ++k) ss8[k] = 0.f;
#pragma unroll
        for (int bj = 0; bj < 2; ++bj) {
            f32x4 cf[2], gm[2];
#pragma unroll
            for (int n = 0; n < 2; ++n) { cf[n] = *(const f32x4*)(coef + (size_t)grp * 9216 + col0 + bj * HALF + n * 4) * mul;
                gm[n] = hm ? *(const f32x4*)(gamma + col0 + bj * HALF + n * 4) * (*(const f32x4*)(scn + (size_t)grp * 9216 + col0 + bj * HALF + n * 4) + 1.0f) : cf[n]; }
#pragma unroll
            for (int ai = 0; ai < 2; ++ai)
#pragma unroll
                for (int m = 0; m < 4; ++m) { const int r = row0 + ai * HALF + m * 16; const float* bsrc = bp + (size_t)(r - rsub) * 1024 + col0 + bj * HALF; float* dst = out + (size_t)r * 1024 + col0 + bj * HALF;
                    const f32x4 h0 = *(const f32x4*)bsrc + cf[0] * acc[ai][bj][m][0], h1 = *(const f32x4*)(bsrc + 4) + cf[1] * acc[ai][bj][m][1];
                    *(f32x4*)dst = h0; *(f32x4*)(dst + 4) = h1;
                    if (hm) { ss8[ai * 4 + m] += ((h0[0] * h0[0] + h0[1] * h0[1]) + (h0[2] * h0[2] + h0[3] * h0[3])) + ((h1[0] * h1[0] + h1[1] * h1[1]) + (h1[2] * h1[2] + h1[3] * h1[3]));
                        const f32x4 a0 = h0 * gm[0], a1 = h1 * gm[1]; u32x4 w;
                        w.x = cvt_pk_bf16(a0[0], a0[1]); w.y = cvt_pk_bf16(a0[2], a0[3]); w.z = cvt_pk_bf16(a1[0], a1[1]); w.w = cvt_pk_bf16(a1[2], a1[3]);
                        *(u32x4*)(hm + (size_t)r * 1024 + col0 + bj * HALF) = w; }
                    if (m & 1) asm volatile("" ::: "memory"); }
        }
        if (hm) {
#pragma unroll
            for (int k = 0; k < 8; ++k) { float ss = ss8[k]; ss += __shfl_xor(ss, 16); ss += __shfl_xor(ss, 32); if (fq == 0) ssp[(size_t)(row0 + (k >> 2) * HALF + (k & 3) * 16) * 8] = ss; } }
    }
};
struct EpiQKV {
    static constexpr bool PERM = true, AFTER_DRAIN = false;
    bf16_t* O; int ldo; const float* rotc; const float* rots; const float* rrow; const float* bias;
    __device__ __forceinline__ void operator()(const f32x4 (&acc)[2][2][4][2], const Unit& u, int wr, int wc, int fr, int fq) const {
        const int rowt = u.pm * BM, row0 = rowt + wr * 64 + fr, pn = u.pn;
        const int grp = rowt >= 8192 ? 1 + ((rowt - 8192) >> 12) : 0;
        f32x4 bb[2][2];
#pragma unroll
        for (int bj = 0; bj < 2; ++bj)
#pragma unroll
            for (int n = 0; n < 2; ++n) bb[bj][n] = *(const f32x4*)(bias + (size_t)grp * 2560 + pn * BM + bj * HALF + wc * 32 + 8 * fq + 4 * n);
        if (pn < 2 || pn == 4 || pn == 5) {
            const bool isk = pn >= 4; const int hp = (pn & 1) * 2 + (wc >> 1); const int d1 = 32 * (wc & 1) + 8 * fq;
            const int colbase = (isk ? 1024 : 0) + hp * 128 + d1; const float sc = isk ? 0.08838834764831845f : 1.0f; const bool lat = rowt >= 8192;
#pragma unroll
            for (int ai = 0; ai < 2; ++ai)
#pragma unroll
                for (int m = 0; m < 4; ++m) { const int r = row0 + ai * HALF + m * 16;
                    const float rs = rrow[r];
                    f32x4 x1a = (acc[ai][0][m][0] * rs + bb[0][0]) * sc, x1b = (acc[ai][0][m][1] * rs + bb[0][1]) * sc, x2a = (acc[ai][1][m][0] * rs + bb[1][0]) * sc, x2b = (acc[ai][1][m][1] * rs + bb[1][1]) * sc;
                    if (lat) { const int t = (r - 8192) & 4095; const int pos = (wc & 1) ? (t & 63) : (t >> 6);
                        const float* cp = rotc + pos * 32 + 8 * fq; const float* sp = rots + pos * 32 + 8 * fq;
                        const f32x4 c0 = *(const f32x4*)cp, c1 = *(const f32x4*)(cp + 4), s0 = *(const f32x4*)sp, s1 = *(const f32x4*)(sp + 4);
                        const f32x4 o1a = x1a * c0 - x2a * s0, o2a = x1a * s0 + x2a * c0, o1b = x1b * c1 - x2b * s1, o2b = x1b * s1 + x2b * c1;
                        x1a = o1a; x2a = o2a; x1b = o1b; x2b = o2b; }
                    bf16_t* rowp = O + (size_t)r * ldo + colbase; u32x4 w;
                    w.x = cvt_pk_bf16(x1a[0], x1a[1]); w.y = cvt_pk_bf16(x1a[2], x1a[3]); w.z = cvt_pk_bf16(x1b[0], x1b[1]); w.w = cvt_pk_bf16(x1b[2], x1b[3]); *(u32x4*)rowp = w;
                    w.x = cvt_pk_bf16(x2a[0], x2a[1]); w.y = cvt_pk_bf16(x2a[2], x2a[3]); w.z = cvt_pk_bf16(x2b[0], x2b[1]); w.w = cvt_pk_bf16(x2b[2], x2b[3]); *(u32x4*)(rowp + 64) = w; }
        } else {
            const int col0 = pn * BM + wc * 32 + 8 * fq;
#pragma unroll
            for (int ai = 0; ai < 2; ++ai)
#pragma unroll
                for (int m = 0; m < 4; ++m) { const int r = row0 + ai * HALF + m * 16; bf16_t* rowp = O + (size_t)r * ldo + col0; const float rs = rrow[r];
#pragma unroll
                    for (int bj = 0; bj < 2; ++bj) { const f32x4 v0 = acc[ai][bj][m][0] * rs + bb[bj][0], v1 = acc[ai][bj][m][1] * rs + bb[bj][1]; u32x4 w;
                        w.x = cvt_pk_bf16(v0[0], v0[1]); w.y = cvt_pk_bf16(v0[2], v0[3]); w.z = cvt_pk_bf16(v1[0], v1[1]); w.w = cvt_pk_bf16(v1[2], v1[3]); *(u32x4*)(rowp + bj * HALF) = w; } }
        }
    }
};

struct EpiDelta {
    static constexpr bool PERM = true, AFTER_DRAIN = false;
    bf16_t* O; const float* coef;
    __device__ __forceinline__ void operator()(const f32x4 (&acc)[2][2][4][2], const Unit& u, int wr, int wc, int fr, int fq) const {
        const int rowt = u.pm * BM; const int grp = rowt >= 8192 ? 1 + ((rowt - 8192) >> 12) : 0;
        const int row0 = rowt + wr * 64 + fr, col0 = u.pn * BM + wc * 32 + 8 * fq;
#pragma unroll
        for (int bj = 0; bj < 2; ++bj) {
            const f32x4 c0 = *(const f32x4*)(coef + (size_t)grp * 9216 + col0 + bj * HALF) * 0.5f, c1 = *(const f32x4*)(coef + (size_t)grp * 9216 + col0 + bj * HALF + 4) * 0.5f;
#pragma unroll
            for (int ai = 0; ai < 2; ++ai)
#pragma unroll
                for (int m = 0; m < 4; ++m) { const f32x4 v0 = acc[ai][bj][m][0] * c0, v1 = acc[ai][bj][m][1] * c1; u32x4 w;
                    w.x = cvt_pk_bf16(v0[0], v0[1]); w.y = cvt_pk_bf16(v0[2], v0[3]); w.z = cvt_pk_bf16(v1[0], v1[1]); w.w = cvt_pk_bf16(v1[2], v1[3]);
                    *(u32x4*)(O + (size_t)(row0 + ai * HALF + m * 16) * 1024 + col0 + bj * HALF) = w; }
        }
    }
};

struct AffOrder {
    int t0, ntl, nN, nloc, rank, split;
    __device__ void init(int t0_, int t1_, int N, int nloc_, int rank_, int split_ = 0) { t0 = t0_; ntl = t1_ - t0_; nN = N / BM; nloc = nloc_; rank = rank_; split = split_; }
    __device__ bool next(int i, Unit& u) const { int L = i * nloc + rank; const int nt_ = ntl * nN; if (L >= (split ? 2 * nt_ : nt_)) return false; u.kh = 0; if (L >= nt_) { L -= nt_; u.kh = 1; } u.pm = t0 + L % ntl; u.pn = L / ntl; return true; }
    __device__ __forceinline__ void a_ready(const Unit&) const {}
    __device__ __forceinline__ void done(const Unit&) const {}
};

template <class Epi, class Sched, bool ALIGN_EPI = false, bool SP2 = false>
__device__ __forceinline__ void gemm_phase(PG8_LAS unsigned char* lds, const Gemm g, const Sched& S, const Epi& E) {
    int tid_ = threadIdx.x; asm volatile("" : "+v"(tid_));
    const int tid = tid_, wid = __builtin_amdgcn_readfirstlane(tid >> 6), lane = tid & 63, wr = wid >> 2, wc = wid & 3, fr = lane & 15, fq = lane >> 4;
    const int K = g.K, nt = g.Kh / BK; const size_t khb = (size_t)g.Kh * 2;
    unsigned voffA[2], voffB[2];
#pragma unroll
    for (int i = 0; i < 2; ++i) { int R, C; stage_rc(tid * 16 + i * 8192, R, C); const int Rb = Epi::PERM ? ((R & ~31) + perm32(R & 31)) : R;
        voffA[i] = (unsigned)(R * g.lda + C) * 2u; voffB[i] = (unsigned)(Rb * K + C) * 2u; }
    const size_t kstep = (size_t)(BK * 2);
    const size_t hstep = (size_t)HALF * K * 2;
    const size_t tstep = 2 * hstep; const size_t hstepA = (size_t)HALF * g.lda * 2, tstepA = 2 * hstepA;
    const unsigned ldsw = (unsigned)wid * 1024u;
    const int aoff = lds_byte(wr * 64 + fr, fq * 8), boff = lds_byte(wc * 32 + fr, fq * 8);
#define PG8_SA(b, h) (((b) * 2 + (h)) * HTB)
#define PG8_SB(b, h) ((4 + (b) * 2 + (h)) * HTB)
#define PG8_STAGE(bufoff, gbase, voff) do { _Pragma("unroll") for (int _i = 0; _i < 2; ++_i) \
        __builtin_amdgcn_global_load_lds((const unsigned*)((const char*)(gbase) + (voff)[_i]), (PG8_LAS unsigned*)(lds + (bufoff) + ldsw + _i * 8192), 16, 0, 0); } while (0)
#define PG8_LDA(dst, b, h) do { _Pragma("unroll") for (int m = 0; m < 4; ++m) _Pragma("unroll") for (int k = 0; k < 2; ++k) dst[m][k] = *(const PG8_LAS bf16x8*)(lds + PG8_SA(b, h) + aoff + m * 2048 + k * 1024); } while (0)
#define PG8_LDB(dst, b, h) do { _Pragma("unroll") for (int n = 0; n < 2; ++n) _Pragma("unroll") for (int k = 0; k < 2; ++k) dst[n][k] = *(const PG8_LAS bf16x8*)(lds + PG8_SB(b, h) + boff + n * 2048 + k * 1024); } while (0)
#define PG8_MMA(ai, bj, At, Bt) do { __builtin_amdgcn_s_setprio(1); _Pragma("unroll") for (int m = 0; m < 4; ++m) _Pragma("unroll") for (int n = 0; n < 2; ++n) _Pragma("unroll") for (int k = 0; k < 2; ++k) \
        acc[ai][bj][m][n] = __builtin_amdgcn_mfma_f32_16x16x32_bf16(Bt[n][k], At[m][k], acc[ai][bj][m][n], 0, 0, 0); __builtin_amdgcn_s_setprio(0); } while (0)
#define PG8_WAIT_V(n) asm volatile("s_waitcnt vmcnt(" #n ")" ::: "memory")
#define PG8_WAIT_L(n) asm volatile("s_waitcnt lgkmcnt(" #n ")" ::: "memory")
#define PG8_BAR __builtin_amdgcn_s_barrier()
#define PG8_SCHED __builtin_amdgcn_sched_barrier(0)
    Unit cur, nxt; int ui = 0;
    if (!S.next(0, cur)) return;
    f32x4 acc[2][2][4][2];
#pragma unroll
    for (int a = 0; a < 2; ++a)
#pragma unroll
        for (int b = 0; b < 2; ++b)
#pragma unroll
            for (int m = 0; m < 4; ++m)
#pragma unroll
                for (int n = 0; n < 2; ++n) acc[a][b][m][n] = (f32x4){0.f, 0.f, 0.f, 0.f};
    bf16x8 At[4][2], B0[2][2], B1[2][2];
    const char* cA = (const char*)g.A + (size_t)cur.pm * tstepA + (size_t)cur.kh * khb; const char* cB = (const char*)g.Bt + (size_t)cur.pn * tstep + (size_t)cur.kh * khb;
    S.a_ready(cur);
    if constexpr (SP2) {
        PG8_STAGE(PG8_SB(0, 0), cB, voffB); PG8_STAGE(PG8_SB(0, 1), cB + hstep, voffB); PG8_STAGE(PG8_SA(0, 0), cA, voffA); PG8_STAGE(PG8_SA(0, 1), cA + hstepA, voffA);
        if (wr == 1) PG8_BAR;
        PG8_WAIT_V(2); PG8_BAR;
        PG8_STAGE(PG8_SB(1, 0), cB + kstep, voffB); PG8_STAGE(PG8_SA(1, 0), cA + kstep, voffA); PG8_STAGE(PG8_SB(1, 1), cB + hstep + kstep, voffB);
        PG8_WAIT_V(6); PG8_BAR;
    } else {
        PG8_STAGE(PG8_SB(0, 0), cB, voffB); PG8_STAGE(PG8_SA(0, 0), cA, voffA); PG8_STAGE(PG8_SB(0, 1), cB + hstep, voffB); PG8_STAGE(PG8_SA(0, 1), cA + hstepA, voffA);
        if (wr == 1) PG8_BAR;
        PG8_WAIT_V(4); PG8_BAR;
        PG8_STAGE(PG8_SB(1, 0), cB + kstep, voffB); PG8_STAGE(PG8_SA(1, 0), cA + kstep, voffA); PG8_STAGE(PG8_SB(1, 1), cB + hstep + kstep, voffB);
        PG8_WAIT_V(6); PG8_BAR;
    }
    for (;;) {
        const bool has_next = S.next(ui + 1, nxt);
        const char* nA = has_next ? (const char*)g.A + (size_t)nxt.pm * tstepA + (size_t)nxt.kh * khb : cA; const char* nB = has_next ? (const char*)g.Bt + (size_t)nxt.pn * tstep + (size_t)nxt.kh * khb : cB;
        for (int t = 0; t < nt; t += 2) {
            const bool last = (t == nt - 2);
            const char* a1 = cA + (size_t)(t + 1) * kstep;
            const char* a2 = last ? nA : cA + (size_t)(t + 2) * kstep; const char* b2 = last ? nB : cB + (size_t)(t + 2) * kstep;
            const char* a3 = a2 + kstep; const char* b3 = b2 + kstep;
            if (last && has_next) S.a_ready(nxt);
            if constexpr (SP2) {
            PG8_LDB(B0, 0, 0); PG8_LDB(B1, 0, 1); PG8_SCHED; PG8_LDA(At, 0, 0); PG8_STAGE(PG8_SA(1, 1), a1 + hstepA, voffA);
            PG8_WAIT_V(8); PG8_WAIT_L(0); PG8_BAR; PG8_MMA(0, 0, At, B0); PG8_MMA(0, 1, At, B1); PG8_BAR; PG8_SCHED;
            PG8_LDA(At, 0, 1); PG8_STAGE(PG8_SB(0, 0), b2, voffB); PG8_STAGE(PG8_SB(0, 1), b2 + hstep, voffB); PG8_STAGE(PG8_SA(0, 0), a2, voffA);
            PG8_WAIT_V(8); PG8_WAIT_L(0); PG8_BAR; PG8_MMA(1, 0, At, B0); PG8_MMA(1, 1, At, B1); PG8_BAR; PG8_SCHED;
            PG8_LDB(B0, 1, 0); PG8_LDB(B1, 1, 1); PG8_SCHED; PG8_LDA(At, 1, 0); PG8_STAGE(PG8_SA(0, 1), a2 + hstepA, voffA);
            PG8_WAIT_V(8); PG8_WAIT_L(0); PG8_BAR; PG8_MMA(0, 0, At, B0); PG8_MMA(0, 1, At, B1); PG8_BAR; PG8_SCHED;
            PG8_LDA(At, 1, 1); PG8_STAGE(PG8_SB(1, 0), b3, voffB); PG8_STAGE(PG8_SB(1, 1), b3 + hstep, voffB); PG8_STAGE(PG8_SA(1, 0), a3, voffA);
            PG8_WAIT_V(8); PG8_WAIT_L(0); PG8_BAR; PG8_MMA(1, 0, At, B0); PG8_MMA(1, 1, At, B1); PG8_BAR; PG8_SCHED;
            } else {
            PG8_LDB(B0, 0, 0); PG8_SCHED; PG8_LDA(At, 0, 0); PG8_STAGE(PG8_SA(1, 1), a1 + hstepA, voffA);
            PG8_WAIT_L(8); PG8_BAR; PG8_WAIT_L(0); PG8_MMA(0, 0, At, B0); PG8_BAR; PG8_SCHED;
            PG8_LDB(B1, 0, 1); PG8_STAGE(PG8_SB(0, 0), b2, voffB);
            PG8_BAR; PG8_WAIT_L(0); PG8_MMA(0, 1, At, B1); PG8_BAR;
            PG8_LDA(At, 0, 1); PG8_STAGE(PG8_SA(0, 0), a2, voffA);
            PG8_BAR; PG8_WAIT_L(0); PG8_MMA(1, 0, At, B0); PG8_BAR; PG8_SCHED;
            PG8_STAGE(PG8_SB(0, 1), b2 + hstep, voffB);
            PG8_WAIT_V(6); PG8_BAR; PG8_MMA(1, 1, At, B1); PG8_BAR;
            PG8_LDB(B0, 1, 0); PG8_SCHED; PG8_LDA(At, 1, 0); PG8_STAGE(PG8_SA(0, 1), a2 + hstepA, voffA);
            PG8_WAIT_L(8); PG8_BAR; PG8_WAIT_L(0); PG8_MMA(0, 0, At, B0); PG8_BAR; PG8_SCHED;
            PG8_LDB(B1, 1, 1); PG8_STAGE(PG8_SB(1, 0), b3, voffB);
            PG8_BAR; PG8_WAIT_L(0); PG8_MMA(0, 1, At, B1); PG8_BAR;
            PG8_LDA(At, 1, 1); PG8_STAGE(PG8_SA(1, 0), a3, voffA);
            PG8_BAR; PG8_WAIT_L(0); PG8_MMA(1, 0, At, B0); PG8_BAR; PG8_SCHED;
            PG8_STAGE(PG8_SB(1, 1), b3 + hstep, voffB);
            PG8_WAIT_V(6); PG8_BAR; PG8_MMA(1, 1, At, B1); PG8_BAR;
            }
        }
        if constexpr (ALIGN_EPI) { if (wr == 0) PG8_BAR; }
        if constexpr (!Epi::AFTER_DRAIN) { E(acc, cur, wr, wc, fr, fq); S.done(cur); }
        if (!has_next) break;
#pragma unroll
        for (int a = 0; a < 2; ++a)
#pragma unroll
            for (int b = 0; b < 2; ++b)
#pragma unroll
                for (int m = 0; m < 4; ++m)
#pragma unroll
                    for (int n = 0; n < 2; ++n) acc[a][b][m][n] = (f32x4){0.f, 0.f, 0.f, 0.f};
        cur = nxt; cA = nA; cB = nB; ++ui;
        if constexpr (ALIGN_EPI) { if (wr == 1) PG8_BAR; }
    }
    PG8_WAIT_V(0);
    if constexpr (!ALIGN_EPI) { if (wr == 0) PG8_BAR; }
    PG8_BAR;
    if constexpr (Epi::AFTER_DRAIN) { E.fused(acc, cur, wr, wc, fr, fq, lds, wid, lane); S.done(cur); }
#undef PG8_SA
#undef PG8_SB
#undef PG8_STAGE
#undef PG8_LDA
#undef PG8_LDB
#undef PG8_MMA
#undef PG8_WAIT_V
#undef PG8_WAIT_L
#undef PG8_BAR
#undef PG8_SCHED
}
}
#define GAS __attribute__((address_space(1)))
#define LAS __attribute__((address_space(3)))
typedef unsigned short bf16;
typedef unsigned v4u __attribute__((ext_vector_type(4)));
typedef float f32x4 __attribute__((ext_vector_type(4)));
typedef short bf16x8 __attribute__((ext_vector_type(8)));
typedef GAS unsigned gu32;
typedef GAS unsigned long long gu64;
#define RLX_AGENT __ATOMIC_RELAXED, __HIP_MEMORY_SCOPE_AGENT
#define LDS_WAIT() asm volatile("s_waitcnt lgkmcnt(0)" ::: "memory")
#define VM_WAIT() asm volatile("s_waitcnt vmcnt(0)" ::: "memory")
__device__ __forceinline__ unsigned long long rt() { return __builtin_amdgcn_s_memrealtime(); }
__device__ __forceinline__ unsigned f2bf(float f) { unsigned u = __builtin_bit_cast(unsigned, f); return (u + 0x7fffu + ((u >> 16) & 1u)) >> 16; }
__device__ __forceinline__ unsigned pk2(float lo, float hi) { return f2bf(lo) | (f2bf(hi) << 16); }

#define XB_TMO      128
#define XB_XCNT(j)  (256  + 64 * (j))
#define XB_XSUB(j)  (1280 + 64 * (j))
#define XB_XGEN(j)  (2304 + 64 * (j))
#define XB_TOP      3328
#define XB_TOPGEN   3392
#define XCD_BAR_WORDS 3456
#define XB_SPIN_CAP (1u << 18)

__device__ __forceinline__ unsigned xb_ld(unsigned* p)              { return __hip_atomic_load(p, __ATOMIC_RELAXED, __HIP_MEMORY_SCOPE_AGENT); }
__device__ __forceinline__ unsigned xb_add(unsigned* p, unsigned v) { return __hip_atomic_fetch_add(p, v, __ATOMIC_RELAXED, __HIP_MEMORY_SCOPE_AGENT); }
__device__ __forceinline__ unsigned xb_xcc_id() { return (unsigned)__builtin_amdgcn_s_getreg((3 << 11) | 20) & 0xFu; }
#define XB_SPIN(cond, bar) do { unsigned _sp = 0; while (cond) { __builtin_amdgcn_s_sleep(1); \
    if ((++_sp & 255u) == 0u) { if (xb_ld(&(bar)[XB_TMO])) break; if (_sp > XB_SPIN_CAP) { atomicAdd(&(bar)[XB_TMO], 1u); break; } } } } while (0)

struct XcdBarrier {
    unsigned* bar; unsigned x;
    volatile LAS unsigned* st;
};

__device__ __forceinline__ XcdBarrier xcd_barrier_post(unsigned* bar, volatile LAS unsigned* st) {
    XcdBarrier b; b.bar = bar; b.x = xb_xcc_id(); b.st = st;
    if (threadIdx.x == 0) (void)xb_add(&bar[XB_XCNT(b.x)], 1u);
    return b;
}
__device__ __forceinline__ void xcd_barrier_complete(unsigned* bar, unsigned x, unsigned& nloc, unsigned& nx) {
    const unsigned G = gridDim.x * gridDim.y * gridDim.z;
    unsigned sum, cnt, mine, sp = 0u;
    for (;;) {
        sum = 0u; cnt = 0u; mine = 0u;
#pragma unroll
        for (unsigned j = 0; j < 16; ++j) { const unsigned c = xb_ld(&bar[XB_XCNT(j)]); sum += c; cnt += (c > 0u) ? 1u : 0u; mine = (j == x) ? c : mine; }
        if (sum == G) break;
        __builtin_amdgcn_s_sleep(1);
        if ((++sp & 255u) == 0u) { if (xb_ld(&bar[XB_TMO])) break; if (sp > XB_SPIN_CAP) { atomicAdd(&bar[XB_TMO], 1u); break; } }
    }
    nloc = mine > 0u ? mine : 1u; nx = cnt > 0u ? cnt : 1u;
}

__device__ __forceinline__ void xcd_barrier(const XcdBarrier& b) {
    asm volatile("s_waitcnt vmcnt(0)" ::: "memory");
    __syncthreads();
    if (threadIdx.x == 0) {
        unsigned* bar = b.bar;
        __builtin_amdgcn_s_waitcnt(0);
        unsigned nloc = b.st[0], nx = b.st[1];
        if (nloc == 0u) { xcd_barrier_complete(bar, b.x, nloc, nx); b.st[0] = nloc; b.st[1] = nx; }
        const unsigned old = xb_add(&bar[XB_XSUB(b.x)], 1u);
        const unsigned gen = old / nloc;
        if (old + 1u == (gen + 1u) * nloc) {
            __builtin_amdgcn_fence(__ATOMIC_RELEASE, "agent");
            asm volatile("s_waitcnt vmcnt(0)" ::: "memory");
            const unsigned og = xb_add(&bar[XB_TOP], 1u);
            const unsigned tg = og / nx;
            if (og + 1u == (tg + 1u) * nx) xb_add(&bar[XB_TOPGEN], 1u);
            else XB_SPIN(xb_ld(&bar[XB_TOPGEN]) == tg, bar);
            __builtin_amdgcn_fence(__ATOMIC_ACQUIRE, "agent");
            xb_add(&bar[XB_XGEN(b.x)], 1u);
            asm volatile("s_waitcnt vmcnt(0)" ::: "memory");
        } else {
            XB_SPIN(xb_ld(&bar[XB_XGEN(b.x)]) == gen, bar);
            __builtin_amdgcn_fence(__ATOMIC_ACQUIRE, "agent");
            asm volatile("s_waitcnt vmcnt(0)" ::: "memory");
        }
    }
    __syncthreads();
}

constexpr int NWAVES = 8, NTHR = 512;
constexpr int D = 1024, MCTX = 8192, MLAT = 16384, M = MCTX + MLAT, FF = 2816, NUP = 2 * FF, NIN = 2560, NMOD = 9 * D;
constexpr int LDQ = FF;
constexpr int NITEM = (M / 128) * 4;
constexpr float EPS = 1e-6f;
constexpr size_t MiB = 1u << 20;
constexpr size_t WS_CTL = 0, CTL_ZERO_BYTES = 65536;
constexpr size_t WS_MODS = 65536, WS_ROTC = 262144, WS_ROTS = 262144 + 8192;
constexpr size_t WS_BIASQ = 288 * 1024, WS_BIAS3 = 352 * 1024, WS_RROW = 512 * 1024;
constexpr size_t WS_SSPA = 42 * MiB + 262144, WS_SSPB = 255 * MiB;
constexpr size_t WS_W13A = 1 * MiB, WS_W13B = 12 * MiB, WS_W2A = 23 * MiB, WS_W2B = 29 * MiB, WS_WIN = 35 * MiB, WS_WOUT = 40 * MiB, WS_POOLW = 42 * MiB;
constexpr size_t WS_ABUF = 43 * MiB;
constexpr size_t WS_HBUF = 91 * MiB;
constexpr size_t WS_SLAT = 223 * MiB;
constexpr size_t WS_END = 255 * MiB;
constexpr int CW_BAR = 4096, CW_RANK = 8192, CW_LBAR = 10240, CW_SPLIT = 12288;
constexpr int LDS_BYTES = 147456, MISC_OFF = LDS_BYTES - 256;
constexpr int OUT_SF = M * D, OUT_SB = M * D + 32 * 4 * 128 * 128;
constexpr int RS = 272;

__device__ __forceinline__ float wave_sum(float v) {
#pragma unroll
    for (int o = 1; o < 64; o <<= 1) v += __shfl_xor(v, o);
    return v;
}
__device__ __forceinline__ unsigned cvtpk(float lo, float hi) { return pg8::cvt_pk_bf16(lo, hi); }
__device__ __forceinline__ float bflo(unsigned w) { return __uint_as_float(w << 16); }
__device__ __forceinline__ float bfhi(unsigned w) { return __uint_as_float(w & 0xffff0000u); }
#define EX2(x) __builtin_amdgcn_exp2f(x)
__device__ __forceinline__ v4u ld16_sc1(const void* p) {
    const unsigned long long a = __hip_atomic_load((const unsigned long long*)p, __ATOMIC_RELAXED, __HIP_MEMORY_SCOPE_AGENT), b = __hip_atomic_load((const unsigned long long*)p + 1, __ATOMIC_RELAXED, __HIP_MEMORY_SCOPE_AGENT);
    return (v4u){(unsigned)a, (unsigned)(a >> 32), (unsigned)b, (unsigned)(b >> 32)};
}
#define MFMA16(x, y, c) __builtin_amdgcn_mfma_f32_16x16x32_bf16((x), (y), (c), 0, 0, 0)

struct Args { const float* in[25]; float* out; unsigned char* ws; };

__device__ __forceinline__ void p0_transpose_item(const float* W, int K, int N, bf16* WT, int dst_row0, LAS float* scr, int k0, int n0, int lane) {
#pragma unroll 8
    for (int i = 0; i < 32; ++i) { const int kk = 2 * i + (lane >> 5); scr[kk * 33 + (lane & 31)] = W[(size_t)(k0 + kk) * N + n0 + (lane & 31)]; }
    LDS_WAIT(); asm volatile("" ::: "memory");
    const int c = lane & 7;
#pragma unroll
    for (int j = 0; j < 4; ++j) { const int n = (lane >> 3) + 8 * j; const LAS float* s = scr + (8 * c) * 33 + n;
        v4u o; o.x = pk2(s[0 * 33], s[1 * 33]); o.y = pk2(s[2 * 33], s[3 * 33]); o.z = pk2(s[4 * 33], s[5 * 33]); o.w = pk2(s[6 * 33], s[7 * 33]);
        *(GAS v4u*)(WT + (size_t)(dst_row0 + n) * K + k0 + 8 * c) = o; }
    LDS_WAIT(); asm volatile("" ::: "memory");
}
__device__ __forceinline__ int map_in(int c) {
    if (c < 1024) { const int base = c < 512 ? 0 : 1024, cc = c & 511, h = cc >> 7, d = cc & 127; return base + 256 * (h >> 1) + 128 * (d >> 6) + 64 * (h & 1) + (d & 63); }
    if (c < 1536) return 1536 + (c - 1024);
    if (c < 2048) return 512 + (c - 1536);
    return c;
}

template <bool FINAL>
__device__ __forceinline__ void norm_rows(const float* src0, const float* src1, const float* gamma, const float* mods, int sh_off, int sc_off, bf16* A, float* outF, int row_lo, int row_hi, int lw, int NLW, int lane) {
    for (int row = row_lo + lw; row < row_hi; row += NLW) {
        const bool lat = row >= MCTX; const int grp = lat ? 1 + ((row - MCTX) >> 12) : 0;
        const f32x4* xr = (const f32x4*)((lat ? src1 + (size_t)(row - MCTX) * D : src0 + (size_t)row * D)) + lane;
        f32x4 v[4]; float s = 0.f;
#pragma unroll
        for (int j = 0; j < 4; ++j) { v[j] = xr[64 * j]; s += (v[j].x * v[j].x + v[j].y * v[j].y) + (v[j].z * v[j].z + v[j].w * v[j].w); }
        const float r = 1.0f / sqrtf(wave_sum(s) * (1.f / D) + EPS);
#pragma unroll
        for (int j = 0; j < 4; ++j) { const int col = 4 * (lane + 64 * j); const f32x4 g = *(const f32x4*)(gamma + col);
            if (FINAL) { *(f32x4*)(outF + (size_t)row * D + col) = v[j] * r * g; }
            else { const f32x4 sc = *(const f32x4*)(mods + (size_t)grp * NMOD + sc_off + col), sh = *(const f32x4*)(mods + (size_t)grp * NMOD + sh_off + col);
                const f32x4 a = (v[j] * r * g) * (sc + 1.0f) + sh;
                *(unsigned long long*)(A + (size_t)row * D + col) = (unsigned long long)cvtpk(a.x, a.y) | ((unsigned long long)cvtpk(a.z, a.w) << 32); } }
    }
}

__device__ __forceinline__ void final_rows(float* out, const bf16* d3, const float* gamma, int row_lo, int row_hi, int lw, int NLW, int lane) {
    for (int row = row_lo + lw; row < row_hi; row += NLW) {
        f32x4* xr = (f32x4*)(out + (size_t)row * D) + lane; const unsigned long long* dr = (const unsigned long long*)(d3 + (size_t)row * D) + lane;
        f32x4 v[4]; unsigned long long dv[4]; float s = 0.f;
#pragma unroll
        for (int j = 0; j < 4; ++j) { v[j] = xr[64 * j]; dv[j] = dr[64 * j]; }
#pragma unroll
        for (int j = 0; j < 4; ++j) { const unsigned lo = (unsigned)dv[j], hi = (unsigned)(dv[j] >> 32); v[j] = v[j] + (f32x4){bflo(lo), bfhi(lo), bflo(hi), bfhi(hi)};
            s += (v[j].x * v[j].x + v[j].y * v[j].y) + (v[j].z * v[j].z + v[j].w * v[j].w); }
        const float r = 1.0f / sqrtf(wave_sum(s) * (1.f / D) + EPS);
#pragma unroll
        for (int j = 0; j < 4; ++j) { const f32x4 g = *(const f32x4*)(gamma + 4 * (lane + 64 * j)); xr[64 * j] = v[j] * r * g; }
    }
}

__device__ __forceinline__ void stage_nat(LAS unsigned char* dst, const bf16* src, int ld, int tid) {
#pragma unroll
    for (int i = 0; i < 4; ++i) { const int c = tid + NTHR * i, row = c >> 4, cc = c & 15; *(LAS v4u*)(dst + row * RS + cc * 16) = *(const v4u*)(src + (size_t)row * ld + cc * 8); }
}


__device__ __forceinline__ void stage_zero(LAS unsigned char* dst, int tid) {
#pragma unroll
    for (int i = 0; i < 4; ++i) { const int c = tid + NTHR * i, row = c >> 4, cc = c & 15; *(LAS v4u*)(dst + row * RS + cc * 16) = (v4u){0u, 0u, 0u, 0u}; }
}


__device__ __forceinline__ void xcc_barrier(unsigned* lw, unsigned nloc, unsigned* tmo) {
    asm volatile("s_waitcnt vmcnt(0)" ::: "memory");
    __syncthreads();
    if (threadIdx.x == 0) {
        const unsigned old = xb_add(lw, 1u), gen = old / nloc;
        if (old + 1u == (gen + 1u) * nloc) xb_add(lw + 64, 1u);
        else XB_SPIN(xb_ld(lw + 64) == gen, tmo);
        __builtin_amdgcn_fence(__ATOMIC_ACQUIRE, "agent");
        asm volatile("s_waitcnt vmcnt(0)" ::: "memory");
    }
    __syncthreads();
}

__global__ void __launch_bounds__(NTHR, 2) hyb_fwd(Args args) {
    extern __shared__ __attribute__((aligned(16))) unsigned char lds_raw[];
    LAS unsigned char* lds = (LAS unsigned char*)lds_raw;
    volatile LAS unsigned* MISC = (volatile LAS unsigned*)(lds + MISC_OFF);
    const int tid = threadIdx.x, lane = tid & 63, wave = __builtin_amdgcn_readfirstlane(tid >> 6), fr = lane & 15, fq = lane >> 4;
    const int G = gridDim.x, bx = blockIdx.x;
    const int gw = bx * NWAVES + wave, NGW = G * NWAVES;
    unsigned char* ws = args.ws;
    if (tid < 64) MISC[tid] = 0u;
    __syncthreads();
    XcdBarrier bar = xcd_barrier_post((unsigned*)(ws + WS_CTL) + CW_BAR, MISC + 8);
    if (tid == 0) MISC[16] = __hip_atomic_fetch_add((unsigned*)(ws + WS_CTL) + CW_RANK + 64 * bar.x, 1u, __ATOMIC_RELAXED, __HIP_MEMORY_SCOPE_AGENT);

    const float* x_ctx = args.in[0]; const float* x_lat = args.in[1];
    float* mods = (float*)(ws + WS_MODS); float* rotc = (float*)(ws + WS_ROTC); float* rots = (float*)(ws + WS_ROTS);
    bf16* W13A = (bf16*)(ws + WS_W13A); bf16* W13B = (bf16*)(ws + WS_W13B); bf16* W2A = (bf16*)(ws + WS_W2A); bf16* W2B = (bf16*)(ws + WS_W2B);
    bf16* WIN = (bf16*)(ws + WS_WIN); bf16* WOUT = (bf16*)(ws + WS_WOUT); bf16* POOLW = (bf16*)(ws + WS_POOLW);
    bf16* ABUF = (bf16*)(ws + WS_ABUF); bf16* HBUF = (bf16*)(ws + WS_HBUF); bf16* SBUF = ABUF; bf16* QKV = HBUF; bf16* SLAT = (bf16*)(ws + WS_SLAT);
    float* out = args.out;
    float* biasq = (float*)(ws + WS_BIASQ); float* bias3 = (float*)(ws + WS_BIAS3); float* rrow = (float*)(ws + WS_RROW); float* sspa = (float*)(ws + WS_SSPA); float* sspb = (float*)(ws + WS_SSPB);

    {
        LAS float* scr = (LAS float*)(lds + wave * 16384);
        constexpr int I_W1 = 16 * 88, I_W2 = 44 * 32, I_IN = 16 * 80, I_OUT = 16 * 32, I_POOL = 32;
        constexpr int NITEMS = 4 * I_W1 + 2 * I_W2 + I_IN + I_OUT + I_POOL;
        for (int it = gw; it < NITEMS; it += NGW) {
            int r = it;
            if (r < 4 * I_W1) { const int which = r / I_W1; r -= which * I_W1; const int kb = r / 88, nb = r % 88, n0 = 32 * nb;
                const float* src = args.in[which == 0 ? 9 : which == 1 ? 10 : which == 2 ? 21 : 22]; bf16* dst = which < 2 ? W13A : W13B;
                p0_transpose_item(src, D, FF, dst, 256 * (n0 >> 7) + 128 * (which & 1) + (n0 & 127), scr, 64 * kb, n0, lane); continue; }
            r -= 4 * I_W1;
            if (r < 2 * I_W2) { const int which = r / I_W2; r -= which * I_W2; const int kb = r / 32, nb = r % 32;
                p0_transpose_item(args.in[which ? 23 : 11], FF, D, which ? W2B : W2A, 32 * nb, scr, 64 * kb, 32 * nb, lane); continue; }
            r -= 2 * I_W2;
            if (r < I_IN) { const int kb = r / 80, nb = r % 80; p0_transpose_item(args.in[13], D, NIN, WIN, map_in(32 * nb), scr, 64 * kb, 32 * nb, lane); continue; }
            r -= I_IN;
            if (r < I_OUT) { const int kb = r / 32, nb = r % 32; p0_transpose_item(args.in[19], D, D, WOUT, 32 * nb, scr, 64 * kb, 32 * nb, lane); continue; }
            r -= I_OUT;
            { const int g = r >> 3, kb = (r >> 2) & 1, nb = r & 3; p0_transpose_item(args.in[17] + g * 16384, 128, 128, POOLW + g * 16384, 32 * nb, scr, 64 * kb, 32 * nb, lane); }
        }
        for (int i = bx * NTHR + tid; i < 2 * 2097152 / 4; i += G * NTHR) *(f32x4*)(out + OUT_SF + 4 * i) = (f32x4){0.f, 0.f, 0.f, 0.f};
        { const int gt = bx * NTHR + tid;
          if (gt < 2048) { const int pos = gt >> 5, f = gt & 31; double fr_ = 1.0; for (int i = 0; i < f; ++i) fr_ *= 0.7498942093324559;
              const double a = (double)pos * fr_; const double n = __builtin_rint(a * 0.15915494309189535); const double rr = a - n * 6.283185307179586; const double r2 = rr * rr;
              double cs = 1.0, sn = 1.0;
              for (int k = 13; k >= 1; --k) { cs = 1.0 - cs * r2 / (double)((2 * k - 1) * (2 * k)); sn = 1.0 - sn * r2 / (double)((2 * k) * (2 * k + 1)); }
              rotc[gt] = (float)cs; rots[gt] = (float)(sn * rr); } }
        __syncthreads();
        LAS float* scond = (LAS float*)lds;
        LAS float* red = (LAS float*)(lds + 5 * 1024 * 4);
        for (int i = tid; i < 5 * D; i += NTHR) { const int g = i >> 10, k = i & 1023; const float cv = g == 0 ? args.in[5][k] : args.in[4][(g - 1) * D + k]; scond[i] = cv / (1.0f + expf(-cv)); }
        __syncthreads();
        const float* ada_w = args.in[6]; const float* ada_b = args.in[7];
        for (int it = bx; it < NMOD / 32; it += G) {
            const int c0 = 32 * it, col = lane & 31, kp = lane >> 5; float a0 = 0.f, a1 = 0.f, a2 = 0.f, a3 = 0.f, a4 = 0.f;
#pragma unroll 8
            for (int i = 0; i < 64; ++i) { const int k = 128 * wave + 2 * i + kp; const float wv = ada_w[(size_t)k * NMOD + c0 + col];
                a0 += scond[k] * wv; a1 += scond[1024 + k] * wv; a2 += scond[2048 + k] * wv; a3 += scond[3072 + k] * wv; a4 += scond[4096 + k] * wv; }
            a0 += __shfl_xor(a0, 32); a1 += __shfl_xor(a1, 32); a2 += __shfl_xor(a2, 32); a3 += __shfl_xor(a3, 32); a4 += __shfl_xor(a4, 32);
            if (lane < 32) { LAS float* rp = red + wave * 160 + col; rp[0] = a0; rp[32] = a1; rp[64] = a2; rp[96] = a3; rp[128] = a4; }
            __syncthreads();
            if (tid < 160) { float s = 0.f;
#pragma unroll
                for (int w = 0; w < 8; ++w) s += red[w * 160 + tid];
                const int g = tid >> 5, cc = tid & 31; mods[(size_t)g * NMOD + c0 + cc] = s + ada_b[c0 + cc]; }
            __syncthreads();
        }
    }
    xcd_barrier(bar);

    if (tid == 0) { unsigned xi_ = 0, nx_ = 0; unsigned* bw = (unsigned*)(ws + WS_CTL) + CW_BAR;
        for (unsigned j = 0; j < 16; ++j) { const unsigned c = xb_ld(&bw[XB_XCNT(j)]); if (c) { if (j < bar.x) ++xi_; ++nx_; } }
        MISC[17] = xi_; MISC[18] = nx_; MISC[19] = xb_ld(&bw[XB_XCNT(bar.x)]); }
    __syncthreads();
    const int rank = __builtin_amdgcn_readfirstlane((int)MISC[16]), xi = __builtin_amdgcn_readfirstlane((int)MISC[17]), nx = __builtin_amdgcn_readfirstlane((int)MISC[18]), nloc = __builtin_amdgcn_readfirstlane((int)MISC[19]);
    const int t0 = (96 * xi) / nx, t1 = (96 * (xi + 1)) / nx;
    const int lwv = rank * NWAVES + wave, NLW = nloc * NWAVES;
    unsigned* const lbw = (unsigned*)(ws + WS_CTL) + CW_LBAR + 128 * bar.x;
#define LOCAL_BAR() xcc_barrier(lbw, (unsigned)nloc, (unsigned*)(ws + WS_CTL) + CW_BAR)
    const int nitl = (t1 - t0) * 8;

    for (int rw = gw; rw < NIN + NUP; rw += NGW) {
        const bool isq = rw < NIN; const int n = isq ? rw : rw - NIN; const bf16* wrow = (isq ? WIN : W13B) + (size_t)n * D + 16 * lane;
        const v4u w0 = *(const v4u*)wrow, w1 = *(const v4u*)(wrow + 8); float wv[16];
#pragma unroll
        for (int q = 0; q < 4; ++q) { wv[2 * q] = bflo(w0[q]); wv[2 * q + 1] = bfhi(w0[q]); wv[8 + 2 * q] = bflo(w1[q]); wv[8 + 2 * q + 1] = bfhi(w1[q]); }
        const float* shp = mods + (isq ? 3072 : 6144) + 16 * lane;
#pragma unroll
        for (int g = 0; g < 5; ++g) { float a = 0.f;
#pragma unroll
            for (int q = 0; q < 4; ++q) { const f32x4 sv = *(const f32x4*)(shp + (size_t)g * NMOD + 4 * q); a += (sv[0] * wv[4 * q] + sv[1] * wv[4 * q + 1]) + (sv[2] * wv[4 * q + 2] + sv[3] * wv[4 * q + 3]); }
            a = wave_sum(a); if (lane == 0) (isq ? biasq + g * NIN : bias3 + g * NUP)[n] = a; }
    }
    norm_rows<false>(x_ctx, x_lat, args.in[8], mods, 0, 1024, ABUF, nullptr, 256 * t0, 256 * t1, lwv, NLW, lane);
    xcd_barrier(bar);

    { pg8::Gemm g{ABUF, W13A, M, NUP, D, D, D}; pg8::AffOrder S; S.init(t0, t1, NUP, nloc, rank); pg8::EpiSwiglu E{HBUF, FF, nullptr, nullptr};
      pg8::gemm_phase<pg8::EpiSwiglu, pg8::AffOrder, true, true>(lds, g, S, E); }
    LOCAL_BAR();
    { pg8::Gemm g{HBUF, W2A, M, D, FF, FF, FF}; pg8::AffOrder S; S.init(t0, t1, D, nloc, rank, 0); pg8::EpiResid E{x_ctx, x_lat, out, mods + 2048, 0.5f, nullptr, ABUF, args.in[12], mods + 4096, sspa, sspb};
      pg8::gemm_phase<pg8::EpiResid, pg8::AffOrder, true, true>(lds, g, S, E); }
    LOCAL_BAR();
    for (int r = 256 * t0 + rank * NTHR + tid; r < 256 * t1; r += nloc * NTHR) { const f32x4 a0 = *(const f32x4*)(sspa + (size_t)r * 8), a1 = *(const f32x4*)(sspa + (size_t)r * 8 + 4), b0 = *(const f32x4*)(sspb + (size_t)r * 8), b1 = *(const f32x4*)(sspb + (size_t)r * 8 + 4);
        const float ssq = (((a0[0] + a0[1]) + (a0[2] + a0[3])) + ((a1[0] + a1[1]) + (a1[2] + a1[3]))) + (((b0[0] + b0[1]) + (b0[2] + b0[3])) + ((b1[0] + b1[1]) + (b1[2] + b1[3])));
        rrow[r] = 1.0f / sqrtf(ssq * (1.f / D) + EPS); }
    LOCAL_BAR();
    { pg8::Gemm g{ABUF, WIN, M, NIN, D, D, D}; pg8::AffOrder S; S.init(t0, t1, NIN, nloc, rank); pg8::EpiQKV E{QKV, LDQ, rotc, rots, rrow, biasq};
      pg8::gemm_phase<pg8::EpiQKV, pg8::AffOrder, true, true>(lds, g, S, E); }
    LOCAL_BAR();

    {
        LAS unsigned char* KT = lds; LAS unsigned char* VFT = lds + 128 * RS; LAS unsigned char* VBT = lds + 2 * 128 * RS;
        for (int li = rank; li < nitl; li += nloc) {
            const int item = 8 * t0 + li, cg = item >> 2, h = item & 3, row0 = cg * 128;
            const float l2f = -expf(args.in[14][h]) * 1.4426950408889634f, l2b = -expf(args.in[15][h]) * 1.4426950408889634f;
            const int jp = 16 * (wave & 3) + (lane & 15), j0 = 2 * jp;
            const float wf0 = EX2(l2f * (float)(127 - j0)), wf1 = EX2(l2f * (float)(126 - j0)), wb0 = EX2(l2b * (float)j0), wb1 = EX2(l2b * (float)(j0 + 1));
#pragma unroll
            for (int pass = 0; pass < 2; ++pass) {
                const int c0 = 8 * (4 * (wave >> 2) + (lane >> 4) + 8 * pass);
                const bf16* kr = QKV + (size_t)(row0 + j0) * LDQ + 1024 + h * 128 + c0; const bf16* vr = kr + 512;
                const v4u ka = *(const v4u*)kr, kb = *(const v4u*)(kr + LDQ), va = *(const v4u*)vr, vb = *(const v4u*)(vr + LDQ);
#pragma unroll
                for (int q = 0; q < 4; ++q) {
                    const unsigned a = ka[q], b = kb[q], c = va[q], d = vb[q];
                    const int r0 = (c0 + 2 * q) * RS + jp * 4, r1 = r0 + RS;
                    *(LAS unsigned*)(KT + r0) = (a & 0xffffu) | (b << 16); *(LAS unsigned*)(KT + r1) = (a >> 16) | (b & 0xffff0000u);
                    const float v00 = bflo(c), v01 = bfhi(c), v10 = bflo(d), v11 = bfhi(d);
                    *(LAS unsigned*)(VFT + r0) = cvtpk(v00 * wf0, v10 * wf1); *(LAS unsigned*)(VFT + r1) = cvtpk(v01 * wf0, v11 * wf1);
                    *(LAS unsigned*)(VBT + r0) = cvtpk(v00 * wb0, v10 * wb1); *(LAS unsigned*)(VBT + r1) = cvtpk(v01 * wb0, v11 * wb1);
                }
            }
            __syncthreads();
            f32x4 af[8], ab[8];
#pragma unroll
            for (int dt = 0; dt < 8; ++dt) { af[dt] = (f32x4){0.f, 0.f, 0.f, 0.f}; ab[dt] = (f32x4){0.f, 0.f, 0.f, 0.f}; }
#pragma unroll
            for (int kk = 0; kk < 4; ++kk) {
                const int ko = (32 * kk + 8 * fq) * 2;
                const bf16x8 yf = *(const LAS bf16x8*)(VFT + (16 * wave + fr) * RS + ko), yb = *(const LAS bf16x8*)(VBT + (16 * wave + fr) * RS + ko);
#pragma unroll
                for (int dt = 0; dt < 8; ++dt) { const bf16x8 xk = *(const LAS bf16x8*)(KT + (16 * dt + fr) * RS + ko); af[dt] = MFMA16(xk, yf, af[dt]); ab[dt] = MFMA16(xk, yb, ab[dt]); }
            }
            bf16* sf = SBUF + ((size_t)item * 2) * 16384 + (16 * wave + fr) * 128 + 4 * fq; bf16* sb = sf + 16384;
#pragma unroll
            for (int dt = 0; dt < 8; ++dt) {
                *(unsigned long long*)(sf + 16 * dt) = (unsigned long long)cvtpk(af[dt][0], af[dt][1]) | ((unsigned long long)cvtpk(af[dt][2], af[dt][3]) << 32);
                *(unsigned long long*)(sb + 16 * dt) = (unsigned long long)cvtpk(ab[dt][0], ab[dt][1]) | ((unsigned long long)cvtpk(ab[dt][2], ab[dt][3]) << 32);
            }
            if (item < 256) {
                const int nch = cg & 1, bh = (cg >> 1) * 4 + h;
                const float sfw = nch == 0 ? exp2f(l2f * 128.0f) : 1.0f, sbw = nch == 1 ? exp2f(l2b * 128.0f) : 1.0f;
                float* cf = out + OUT_SF + (size_t)bh * 16384 + (4 * fq) * 128 + 16 * wave + fr; float* cb = out + OUT_SB + (size_t)bh * 16384 + (4 * fq) * 128 + 16 * wave + fr;
#pragma unroll
                for (int dt = 0; dt < 8; ++dt)
#pragma unroll
                    for (int i = 0; i < 4; ++i) { unsafeAtomicAdd(cf + (16 * dt + i) * 128, af[dt][i] * sfw); unsafeAtomicAdd(cb + (16 * dt + i) * 128, ab[dt][i] * sbw); }
            }
            __syncthreads();
        }
    }
    xcd_barrier(bar);

    {
        const int gt = bx * NTHR + tid, GT = G * NTHR;
        for (int task = gt; task < 4 * 4 * 2 * 2048; task += GT) {
            const int e8 = task & 2047, dir = (task >> 11) & 1, h = (task >> 12) & 3, b = task >> 14;
            float carry[8];
            { const float* s0 = args.in[dir ? 3 : 2] + ((size_t)b * 4 + h) * 16384; const int dv = e8 >> 4, dk0 = (e8 & 15) * 8;
#pragma unroll
              for (int e = 0; e < 8; ++e) carry[e] = s0[(dk0 + e) * 128 + dv]; }
            const float gC = exp2f(-expf(args.in[dir ? 15 : 14][h]) * 1.4426950408889634f * 128.0f);
            for (int sb = 0; sb < 32; sb += 8) {
                v4u kv[8];
#pragma unroll
                for (int i = 0; i < 8; ++i) { const int n = dir ? 31 - (sb + i) : sb + i; kv[i] = *(const v4u*)(SBUF + (((size_t)(64 + 32 * b + n) * 4 + h) * 2 + dir) * 16384 + e8 * 8); }
#pragma unroll
                for (int i = 0; i < 8; ++i) { const int n = dir ? 31 - (sb + i) : sb + i;
                    v4u o; o.x = cvtpk(carry[0], carry[1]); o.y = cvtpk(carry[2], carry[3]); o.z = cvtpk(carry[4], carry[5]); o.w = cvtpk(carry[6], carry[7]);
                    *(v4u*)(SLAT + (((size_t)(32 * b + n) * 4 + h) * 2 + dir) * 16384 + e8 * 8) = o;
#pragma unroll
                    for (int q = 0; q < 4; ++q) { carry[2 * q] = carry[2 * q] * gC + bflo(kv[i][q]); carry[2 * q + 1] = carry[2 * q + 1] * gC + bfhi(kv[i][q]); } }
            }
        }
    }
    xcd_barrier(bar);

    {
        LAS unsigned char* KP = lds; LAS unsigned char* VT = lds + 128 * RS; LAS unsigned char* SFT = lds + 2 * 128 * RS; LAS unsigned char* SBT = lds + 3 * 128 * RS;
        LAS unsigned char* US = lds; LAS unsigned char* WT = lds + 2 * 128 * RS;
        for (int li = rank; li < nitl; li += nloc) {
            const int item = 8 * t0 + li, cg = item >> 2, h = item & 3, row0 = cg * 128;
            const bool lat = cg >= 64; const int n = lat ? (cg - 64) & 31 : cg & 1, L = lat ? 4096 : 256, seq_row0 = row0 - n * 128;
            const float l2f = -expf(args.in[14][h]) * 1.4426950408889634f, l2b = -expf(args.in[15][h]) * 1.4426950408889634f;
            stage_nat(KP, QKV + (size_t)row0 * LDQ + 1024 + h * 128, LDQ, tid);
            if (lat) { stage_nat(SFT, SLAT + ((size_t)(item - 256) * 2) * 16384, 128, tid); stage_nat(SBT, SLAT + ((size_t)(item - 256) * 2 + 1) * 16384, 128, tid); }
            else if (n == 0) { stage_zero(SFT, tid); stage_nat(SBT, SBUF + ((size_t)(item + 4) * 2 + 1) * 16384, 128, tid); }
            else { stage_nat(SFT, SBUF + ((size_t)(item - 4) * 2) * 16384, 128, tid); stage_zero(SBT, tid); }
            { const int jp = 16 * (wave & 3) + (lane & 15), j0 = 2 * jp;
#pragma unroll
              for (int pass = 0; pass < 2; ++pass) { const int c0 = 8 * (4 * (wave >> 2) + (lane >> 4) + 8 * pass);
                  const bf16* vr = QKV + (size_t)(row0 + j0) * LDQ + 1536 + h * 128 + c0; const v4u va = *(const v4u*)vr, vb = *(const v4u*)(vr + LDQ);
#pragma unroll
                  for (int q = 0; q < 4; ++q) { const unsigned a = va[q], b = vb[q]; const int r0 = (c0 + 2 * q) * RS + jp * 4;
                      *(LAS unsigned*)(VT + r0) = (a & 0xffffu) | (b << 16); *(LAS unsigned*)(VT + r0 + RS) = (a >> 16) | (b & 0xffff0000u); } } }
            const int il = 16 * wave + fr, row = row0 + il;
            bf16x8 yq[4];
#pragma unroll
            for (int kk = 0; kk < 4; ++kk) yq[kk] = *(const bf16x8*)(QKV + (size_t)row * LDQ + h * 128 + 32 * kk + 8 * fq);
            __syncthreads();
            f32x4 sc[8];
#pragma unroll
            for (int jt = 0; jt < 8; ++jt) { sc[jt] = (f32x4){0.f, 0.f, 0.f, 0.f};
#pragma unroll
                for (int kk = 0; kk < 4; ++kk) sc[jt] = MFMA16(*(const LAS bf16x8*)(KP + (16 * jt + fr) * RS + (32 * kk + 8 * fq) * 2), yq[kk], sc[jt]); }
#pragma unroll
            for (int jt = 0; jt < 8; ++jt)
#pragma unroll
                for (int i = 0; i < 4; ++i) { const int j = 16 * jt + 4 * fq + i, dl = il - j; const float w = dl > 0 ? EX2(l2f * (float)dl) : (dl < 0 ? EX2(l2b * (float)(-dl)) : 2.0f); sc[jt][i] *= w; }
            __syncthreads();
#pragma unroll
            for (int jt = 0; jt < 8; ++jt) *(LAS unsigned long long*)(KP + il * RS + (16 * jt + 4 * fq) * 2) = (unsigned long long)cvtpk(sc[jt][0], sc[jt][1]) | ((unsigned long long)cvtpk(sc[jt][2], sc[jt][3]) << 32);
            __syncthreads();
            f32x4 oi[8];
#pragma unroll
            for (int dt = 0; dt < 8; ++dt) oi[dt] = (f32x4){0.f, 0.f, 0.f, 0.f};
            const float cfw = EX2(l2f * (float)(il + 1)), cbw = EX2(l2b * (float)(128 - il));
#pragma unroll 1
            for (int kk = 0; kk < 4; ++kk) { const int ko = (32 * kk + 8 * fq) * 2; const bf16x8 yp = *(const LAS bf16x8*)(KP + il * RS + ko);
                const v4u qw = *(const v4u*)(QKV + (size_t)row * LDQ + h * 128 + 32 * kk + 8 * fq); v4u qf, qb;
#pragma unroll
                for (int q = 0; q < 4; ++q) { const float lo = bflo(qw[q]), hi = bfhi(qw[q]); qf[q] = cvtpk(lo * cfw, hi * cfw); qb[q] = cvtpk(lo * cbw, hi * cbw); }
                const bf16x8 yqf = __builtin_bit_cast(bf16x8, qf), yqb = __builtin_bit_cast(bf16x8, qb);
#pragma unroll
                for (int dt = 0; dt < 8; ++dt) { const int ro = (16 * dt + fr) * RS + ko;
                    oi[dt] = MFMA16(*(const LAS bf16x8*)(VT + ro), yp, oi[dt]); oi[dt] = MFMA16(*(const LAS bf16x8*)(SFT + ro), yqf, oi[dt]); oi[dt] = MFMA16(*(const LAS bf16x8*)(SBT + ro), yqb, oi[dt]); } }
            float ss = 0.f;
#pragma unroll
            for (int dt = 0; dt < 8; ++dt) ss += (oi[dt][0] * oi[dt][0] + oi[dt][1] * oi[dt][1]) + (oi[dt][2] * oi[dt][2] + oi[dt][3] * oi[dt][3]);
            ss += __shfl_xor(ss, 16); ss += __shfl_xor(ss, 32);
            const float rn = 1.0f / sqrtf(ss * (1.0f / 128.0f) + EPS);
            { bf16* qrow = QKV + (size_t)row * LDQ + h * 128 + 4 * fq; const bf16* grow = qrow + 512; const float* gn = args.in[16] + h * 128 + 4 * fq;
#pragma unroll
              for (int dt = 0; dt < 8; ++dt) { const unsigned long long gw_ = *(const unsigned long long*)(grow + 16 * dt); const f32x4 g4 = *(const f32x4*)(gn + 16 * dt);
                  const unsigned g01 = (unsigned)gw_, g23 = (unsigned)(gw_ >> 32);
                  const float r0 = oi[dt][0] * rn * g4[0] * pg8::silu_f(bflo(g01)), r1 = oi[dt][1] * rn * g4[1] * pg8::silu_f(bfhi(g01));
                  const float r2 = oi[dt][2] * rn * g4[2] * pg8::silu_f(bflo(g23)), r3 = oi[dt][3] * rn * g4[3] * pg8::silu_f(bfhi(g23));
                  *(unsigned long long*)(qrow + 16 * dt) = (unsigned long long)cvtpk(r0, r1) | ((unsigned long long)cvtpk(r2, r3) << 32); } }
            __syncthreads();
            { const int half = 1 << h;
              for (int c = tid; c < 144 * 16; c += NTHR) { const int lr = c >> 4, cc = c & 15, pos = n * 128 - 8 + lr; v4u v = (v4u){0u, 0u, 0u, 0u};
                  if (pos >= 0 && pos < L) v = *(const v4u*)(QKV + (size_t)(seq_row0 + pos) * LDQ + 2048 + h * 128 + cc * 8);
                  *(LAS v4u*)(US + lr * RS + cc * 16) = v; }
              stage_nat(WT, POOLW + h * 16384, 128, tid);
              __syncthreads();
              const int pos = n * 128 + il, lo = pos - half > 0 ? pos - half : 0, hi = pos + half < L ? pos + half : L; const float inv = 1.0f / (float)(hi - lo);
              bf16x8 yd[4];
#pragma unroll
              for (int kk = 0; kk < 4; ++kk) { const int co = (32 * kk + 8 * fq) * 2; float s[8];
#pragma unroll
                  for (int e = 0; e < 8; ++e) s[e] = 0.f;
                  for (int dd = -half; dd < half; ++dd) { const v4u v = *(const LAS v4u*)(US + (il + 8 + dd) * RS + co);
#pragma unroll
                      for (int q = 0; q < 4; ++q) { s[2 * q] += bflo(v[q]); s[2 * q + 1] += bfhi(v[q]); } }
                  const v4u cv = *(const LAS v4u*)(US + (il + 8) * RS + co); v4u dq;
#pragma unroll
                  for (int q = 0; q < 4; ++q) dq[q] = cvtpk(s[2 * q] * inv - bflo(cv[q]), s[2 * q + 1] * inv - bfhi(cv[q]));
                  yd[kk] = __builtin_bit_cast(bf16x8, dq); }
              f32x4 po[8];
#pragma unroll
              for (int dt = 0; dt < 8; ++dt) { po[dt] = (f32x4){0.f, 0.f, 0.f, 0.f};
#pragma unroll
                  for (int kk = 0; kk < 4; ++kk) po[dt] = MFMA16(*(const LAS bf16x8*)(WT + (16 * dt + fr) * RS + (32 * kk + 8 * fq) * 2), yd[kk], po[dt]); }
              bf16* prow = QKV + (size_t)row * LDQ + 512 + h * 128 + 4 * fq; const float* ps = args.in[18] + h * 128 + 4 * fq;
#pragma unroll
              for (int dt = 0; dt < 8; ++dt) { const f32x4 p4 = *(const f32x4*)(ps + 16 * dt);
                  *(unsigned long long*)(prow + 16 * dt) = (unsigned long long)cvtpk(po[dt][0] * p4[0], po[dt][1] * p4[1]) | ((unsigned long long)cvtpk(po[dt][2] * p4[2], po[dt][3] * p4[3]) << 32); }
            }
            __syncthreads();
        }
    }
    xcd_barrier(bar);

    { pg8::Gemm g{QKV, WOUT, M, D, D, LDQ, D}; pg8::AffOrder S; S.init(t0, t1, D, nloc, rank, 0); pg8::EpiResid E{out, out + (size_t)MCTX * D, out, mods + 5120, 1.0f, nullptr, ABUF, args.in[20], mods + 7168, sspa, sspb};
      pg8::gemm_phase<pg8::EpiResid, pg8::AffOrder, true, true>(lds, g, S, E); }
    LOCAL_BAR();
    for (int r = 256 * t0 + rank * NTHR + tid; r < 256 * t1; r += nloc * NTHR) { const f32x4 a0 = *(const f32x4*)(sspa + (size_t)r * 8), a1 = *(const f32x4*)(sspa + (size_t)r * 8 + 4), b0 = *(const f32x4*)(sspb + (size_t)r * 8), b1 = *(const f32x4*)(sspb + (size_t)r * 8 + 4);
        const float ssq = (((a0[0] + a0[1]) + (a0[2] + a0[3])) + ((a1[0] + a1[1]) + (a1[2] + a1[3]))) + (((b0[0] + b0[1]) + (b0[2] + b0[3])) + ((b1[0] + b1[1]) + (b1[2] + b1[3])));
        rrow[r] = 1.0f / sqrtf(ssq * (1.f / D) + EPS); }
    LOCAL_BAR();
    { pg8::Gemm g{ABUF, W13B, M, NUP, D, D, D}; pg8::AffOrder S; S.init(t0, t1, NUP, nloc, rank); pg8::EpiSwiglu E{HBUF, FF, rrow, bias3};
      pg8::gemm_phase<pg8::EpiSwiglu, pg8::AffOrder, true, true>(lds, g, S, E); }
    LOCAL_BAR();
    { pg8::Gemm g{HBUF, W2B, M, D, FF, FF, FF}; pg8::AffOrder S; S.init(t0, t1, D, nloc, rank, 0); pg8::EpiDelta E{ABUF, mods + 8192};
      pg8::gemm_phase<pg8::EpiDelta, pg8::AffOrder, true, true>(lds, g, S, E); }
    LOCAL_BAR();
    final_rows(out, ABUF, args.in[24], 256 * t0, 256 * t1, lwv, NLW, lane);
}

extern "C" void kernel_launch(void* const* d_in, const int* in_sizes, int n_in, void* d_out, int out_size, void* d_ws, size_t ws_size, hipStream_t stream) {
    static int grid = 0;
    if (grid == 0) {
        if (n_in != 25 || in_sizes[0] != MCTX * D || in_sizes[1] != MLAT * D || out_size != M * D + 2 * 32 * 4 * 128 * 128 || ws_size < 256 * MiB) {
            fprintf(stderr, "kernel_launch: unexpected shapes (n_in %d, out %d, ws %zu); nothing launched\n", n_in, out_size, ws_size); grid = -1; return; }
        int dev = 0, cus = 0, per_cu = 0;
        if (hipGetDevice(&dev) != hipSuccess || hipDeviceGetAttribute(&cus, hipDeviceAttributeMultiprocessorCount, dev) != hipSuccess) { grid = -1; return; }
        if (hipFuncSetAttribute((const void*)hyb_fwd, hipFuncAttributeMaxDynamicSharedMemorySize, LDS_BYTES) != hipSuccess) { fprintf(stderr, "kernel_launch: hipFuncSetAttribute failed\n"); grid = -1; return; }
        if (hipOccupancyMaxActiveBlocksPerMultiprocessor(&per_cu, (const void*)hyb_fwd, NTHR, LDS_BYTES) != hipSuccess || per_cu < 1) {
            fprintf(stderr, "kernel_launch: occupancy query reports %d workgroups per CU; nothing launched\n", per_cu); (void)hipGetLastError(); grid = -1; return; }
        grid = cus;
    }
    if (grid < 0) return;
    (void)hipMemsetAsync((char*)d_ws + WS_CTL, 0, CTL_ZERO_BYTES, stream);
    Args a{};
    for (int i = 0; i < 25; ++i) a.in[i] = (const float*)d_in[i];
    a.out = (float*)d_out; a.ws = (unsigned char*)d_ws;
    hipLaunchKernelGGL(hyb_fwd, dim3(grid), dim3(NTHR), LDS_BYTES, stream, a);
}
```

```cpp
#include <hip/hip_runtime.h>
#include <cstdio>
#include <cstdint>
namespace pg8 {
#define PG8_LAS __attribute__((address_space(3)))
typedef unsigned short bf16_t;
typedef short bf16x8 __attribute__((ext_vector_type(8)));
typedef float f32x4 __attribute__((ext_vector_type(4)));
typedef unsigned u32x4 __attribute__((ext_vector_type(4)));
constexpr int BM = 256, BK = 64, HALF = 128, HTB = HALF * BK * 2  , STAGE_BYTES = 8 * HTB, NXCD = 8, WGM = 8;

__host__ __device__ __forceinline__ int lds_byte(int r, int c) { const int st = (r >> 4) * 2 + (c >> 5), rr = r & 15, cc = c & 31, ob = rr * 64 + cc * 2; return st * 1024 + (ob ^ (((ob >> 9) & 1) << 5)); }
__host__ __device__ __forceinline__ void stage_rc(int b, int& R, int& C) { const int st = b / 1024, sb = b % 1024, swz = sb ^ (((sb >> 9) & 1) << 5); R = (st >> 1) * 16 + swz / 64; C = (st & 1) * 32 + (swz % 64) / 2; }
__host__ __device__ __forceinline__ int perm32(int rho) { const int n = rho >> 4, i = rho & 15; return 8 * (i >> 2) + 4 * n + (i & 3); }

struct Unit { int pm, pn, kh; };
struct Gemm { const bf16_t* A; const bf16_t* Bt; int M, N, K, lda, Kh; };

struct StaticOrder {
    int nM, nN, nwg, G, c;
    __host__ __device__ void init(int M, int N, int G_, int c_) { nM = M / BM; nN = N / BM; nwg = nM * nN; G = G_; c = c_; }
    __host__ __device__ bool next(int i, Unit& u) const {
        const long L = (long)i * G + c; if (L >= nwg) return false;
        int wgid = (int)L; { const int q = nwg / NXCD, r = nwg % NXCD, xcd = wgid % NXCD, off = wgid / NXCD; wgid = (xcd < r ? xcd * (q + 1) : r * (q + 1) + (xcd - r) * q) + off; }
        const int nig = WGM * nN, gid = wgid / nig, fm = gid * WGM, gsz = (nM - fm) < WGM ? (nM - fm) : WGM;
        u.pm = fm + ((wgid % nig) % gsz); u.pn = (wgid % nig) / gsz; return true;
    }
    __device__ __forceinline__ void a_ready(const Unit&) const {}
    __device__ __forceinline__ void done(const Unit&) const {}
};

typedef float f32x2 __attribute__((ext_vector_type(2)));
typedef __bf16 bf16x2_t __attribute__((ext_vector_type(2)));
__device__ __forceinline__ unsigned cvt_pk_bf16(float lo, float hi) { const f32x2 v = {lo, hi}; return __builtin_bit_cast(unsigned, __builtin_convertvector(v, bf16x2_t)); }
__device__ __forceinline__ float silu_f(float x) { return x * __builtin_amdgcn_rcpf(1.0f + __expf(-x)); }
struct EpiSwiglu {
    static constexpr bool PERM = true, AFTER_DRAIN = false;
    bf16_t* O; int ldo;
    const float* rrow; const float* bias;
    __device__ __forceinline__ void operator()(const f32x4 (&acc)[2][2][4][2], const Unit& u, int wr, int wc, int fr, int fq) const {
        const int rowt = u.pm * BM, row0 = rowt + wr * 64 + fr, col0 = u.pn * HALF + wc * 32 + 8 * fq;
        const int grp = rowt >= 8192 ? 1 + ((rowt - 8192) >> 12) : 0;
        f32x4 bg[2], bu[2];
#pragma unroll
        for (int n = 0; n < 2; ++n) { bg[n] = (f32x4){0.f, 0.f, 0.f, 0.f}; bu[n] = bg[n];
            if (rrow) { const float* bp = bias + (size_t)grp * 5632 + u.pn * BM + wc * 32 + 8 * fq + 4 * n; bg[n] = *(const f32x4*)bp; bu[n] = *(const f32x4*)(bp + HALF); } }
#pragma unroll
        for (int ai = 0; ai < 2; ++ai)
#pragma unroll
            for (int m = 0; m < 4; ++m) { const int r = row0 + ai * HALF + m * 16; bf16_t* rowp = O + (size_t)r * ldo + col0;
                const float rs = rrow ? rrow[r] : 1.0f;
                const f32x4 g0 = acc[ai][0][m][0] * rs + bg[0], g1 = acc[ai][0][m][1] * rs + bg[1], u0 = acc[ai][1][m][0] * rs + bu[0], u1 = acc[ai][1][m][1] * rs + bu[1];
                u32x4 w;
                w.x = cvt_pk_bf16(silu_f(g0[0]) * u0[0], silu_f(g0[1]) * u0[1]); w.y = cvt_pk_bf16(silu_f(g0[2]) * u0[2], silu_f(g0[3]) * u0[3]);
                w.z = cvt_pk_bf16(silu_f(g1[0]) * u1[0], silu_f(g1[1]) * u1[1]); w.w = cvt_pk_bf16(silu_f(g1[2]) * u1[2], silu_f(g1[3]) * u1[3]);
                *(u32x4*)rowp = w; }
    }
};
struct EpiResid {
    static constexpr bool PERM = true, AFTER_DRAIN = false;
    const float* base0; const float* base1; float* out; const float* coef; float mul;
    unsigned* flag;
    bf16_t* hm; const float* gamma; const float* scn; float* sspa; float* sspb;
    __device__ __forceinline__ void operator()(const f32x4 (&acc)[2][2][4][2], const Unit& u, int wr, int wc, int fr, int fq) const {
        const int rowt = u.pm * BM; const bool lat = rowt >= 8192; const int grp = lat ? 1 + ((rowt - 8192) >> 12) : 0;
        const float* bp = lat ? base1 : base0; const int rsub = lat ? 8192 : 0;
        const int row0 = rowt + wr * 64 + fr, col0 = u.pn * BM + wc * 32 + 8 * fq;
        float* ssp = (u.pn < 2 ? sspa : sspb) + (u.pn & 1) * 4 + wc;
        float ss8[8];
#pragma unroll
        for (int k = 0; k < 8; ++k) ss8[k] = 0.f;
#pragma unroll
        for (int bj = 0; bj < 2; ++bj) {
            f32x4 cf[2], gm[2];
#pragma unroll
            for (int n = 0; n < 2; ++n) { cf[n] = *(const f32x4*)(coef + (size_t)grp * 9216 + col0 + bj * HALF + n * 4) * mul;
                gm[n] = hm ? *(const f32x4*)(gamma + col0 + bj * HALF + n * 4) * (*(const f32x4*)(scn + (size_t)grp * 9216 + col0 + bj * HALF + n * 4) + 1.0f) : cf[n]; }
#pragma unroll
            for (int ai = 0; ai < 2; ++ai)
#pragma unroll
                for (int m = 0; m < 4; ++m) { const int r = row0 + ai * HALF + m * 16; const float* bsrc = bp + (size_t)(r - rsub) * 1024 + col0 + bj * HALF; float* dst = out + (size_t)r * 1024 + col0 + bj * HALF;
                    const f32x4 h0 = *(const f32x4*)bsrc + cf[0] * acc[ai][bj][m][0], h1 = *(const f32x4*)(bsrc + 4) + cf[1] * acc[ai][bj][m][1];
                    *(f32x4*)dst = h0; *(f32x4*)(dst + 4) = h1;
                    if (hm) { ss8[ai * 4 + m] += ((h0[0] * h0[0] + h0[1] * h0[1]) + (h0[2] * h0[2] + h0[3] * h0[3])) + ((h1[0] * h1[0] + h1[1] * h1[1]) + (h1[2] * h1[2] + h1[3] * h1[3]));
                        const f32x4 a0 = h0 * gm[0], a1 = h1 * gm[1]; u32x4 w;
                        w.x = cvt_pk_bf16(a0[0], a0[1]); w.y = cvt_pk_bf16(a0[2], a0[3]); w.z = cvt_pk_bf16(a1[0], a1[1]); w.w = cvt_pk_bf16(a1[2], a1[3]);
                        *(u32x4*)(hm + (size_t)r * 1024 + col0 + bj * HALF) = w; }
                    if (m & 1) asm volatile("" ::: "memory"); }
        }
        if (hm) {
#pragma unroll
            for (int k = 0; k < 8; ++k) { float ss = ss8[k]; ss += __shfl_xor(ss, 16); ss += __shfl_xor(ss, 32); if (fq == 0) ssp[(size_t)(row0 + (k >> 2) * HALF + (k & 3) * 16) * 8] = ss; } }
    }
};
struct EpiQKV {
    static constexpr bool PERM = true, AFTER_DRAIN = false;
    bf16_t* O; int ldo; const float* rotc; const float* rots; const float* rrow; const float* bias;
    __device__ __forceinline__ void operator()(const f32x4 (&acc)[2][2][4][2], const Unit& u, int wr, int wc, int fr, int fq) const {
        const int rowt = u.pm * BM, row0 = rowt + wr * 64 + fr, pn = u.pn;
        const int grp = rowt >= 8192 ? 1 + ((rowt - 8192) >> 12) : 0;
        f32x4 bb[2][2];
#pragma unroll
        for (int bj = 0; bj < 2; ++bj)
#pragma unroll
            for (int n = 0; n < 2; ++n) bb[bj][n] = *(const f32x4*)(bias + (size_t)grp * 2560 + pn * BM + bj * HALF + wc * 32 + 8 * fq + 4 * n);
        if (pn < 2 || pn == 4 || pn == 5) {
            const bool isk = pn >= 4; const int hp = (pn & 1) * 2 + (wc >> 1); const int d1 = 32 * (wc & 1) + 8 * fq;
            const int colbase = (isk ? 1024 : 0) + hp * 128 + d1; const float sc = isk ? 0.08838834764831845f : 1.0f; const bool lat = rowt >= 8192;
#pragma unroll
            for (int ai = 0; ai < 2; ++ai)
#pragma unroll
                for (int m = 0; m < 4; ++m) { const int r = row0 + ai * HALF + m * 16;
                    const float rs = rrow[r];
                    f32x4 x1a = (acc[ai][0][m][0] * rs + bb[0][0]) * sc, x1b = (acc[ai][0][m][1] * rs + bb[0][1]) * sc, x2a = (acc[ai][1][m][0] * rs + bb[1][0]) * sc, x2b = (acc[ai][1][m][1] * rs + bb[1][1]) * sc;
                    if (lat) { const int t = (r - 8192) & 4095; const int pos = (wc & 1) ? (t & 63) : (t >> 6);
                        const float* cp = rotc + pos * 32 + 8 * fq; const float* sp = rots + pos * 32 + 8 * fq;
                        const f32x4 c0 = *(const f32x4*)cp, c1 = *(const f32x4*)(cp + 4), s0 = *(const f32x4*)sp, s1 = *(const f32x4*)(sp + 4);
                        const f32x4 o1a = x1a * c0 - x2a * s0, o2a = x1a * s0 + x2a * c0, o1b = x1b * c1 - x2b * s1, o2b = x1b * s1 + x2b * c1;
                        x1a = o1a; x2a = o2a; x1b = o1b; x2b = o2b; }
                    bf16_t* rowp = O + (size_t)r * ldo + colbase; u32x4 w;
                    w.x = cvt_pk_bf16(x1a[0], x1a[1]); w.y = cvt_pk_bf16(x1a[2], x1a[3]); w.z = cvt_pk_bf16(x1b[0], x1b[1]); w.w = cvt_pk_bf16(x1b[2], x1b[3]); *(u32x4*)rowp = w;
                    w.x = cvt_pk_bf16(x2a[0], x2a[1]); w.y = cvt_pk_bf16(x2a[2], x2a[3]); w.z = cvt_pk_bf16(x2b[0], x2b[1]); w.w = cvt_pk_bf16(x2b[2], x2b[3]); *(u32x4*)(rowp + 64) = w; }
        } else {
            const int col0 = pn * BM + wc * 32 + 8 * fq;
#pragma unroll
            for (int ai = 0; ai < 2; ++ai)
#pragma unroll
                for (int m = 0; m < 4; ++m) { const int r = row0 + ai * HALF + m * 16; bf16_t* rowp = O + (size_t)r * ldo + col0; const float rs = rrow[r];
#pragma unroll
                    for (int bj = 0; bj < 2; ++bj) { const f32x4 v0 = acc[ai][bj][m][0] * rs + bb[bj][0], v1 = acc[ai][bj][m][1] * rs + bb[bj][1]; u32x4 w;
                        w.x = cvt_pk_bf16(v0[0], v0[1]); w.y = cvt_pk_bf16(v0[2], v0[3]); w.z = cvt_pk_bf16(v1[0], v1[1]); w.w = cvt_pk_bf16(v1[2], v1[3]); *(u32x4*)(rowp + bj * HALF) = w; } }
        }
    }
};

struct EpiDelta {
    static constexpr bool PERM = true, AFTER_DRAIN = false;
    bf16_t* O; const float* coef; bf16_t* slabs; int t0, ntl, nfull, xi32;
    __device__ __forceinline__ void operator()(const f32x4 (&acc)[2][2][4][2], const Unit& u, int wr, int wc, int fr, int fq) const {
        const int rowt = u.pm * BM; const int grp = rowt >= 8192 ? 1 + ((rowt - 8192) >> 12) : 0;
        const int col0 = u.pn * BM + wc * 32 + 8 * fq, rl0 = wr * 64 + fr;
        bf16_t* tb; int ld;
        if (u.kh == 1) { tb = slabs + (size_t)(xi32 + u.pn * ntl + (u.pm - t0) - nfull) * 65536 + wc * 32 + 8 * fq; ld = 256; }
        else { tb = O + (size_t)rowt * 1024 + col0; ld = 1024; }
#pragma unroll
        for (int bj = 0; bj < 2; ++bj) {
            const f32x4 c0 = *(const f32x4*)(coef + (size_t)grp * 9216 + col0 + bj * HALF) * 0.5f, c1 = *(const f32x4*)(coef + (size_t)grp * 9216 + col0 + bj * HALF + 4) * 0.5f;
#pragma unroll
            for (int ai = 0; ai < 2; ++ai)
#pragma unroll
                for (int m = 0; m < 4; ++m) { const f32x4 v0 = acc[ai][bj][m][0] * c0, v1 = acc[ai][bj][m][1] * c1; u32x4 w;
                    w.x = cvt_pk_bf16(v0[0], v0[1]); w.y = cvt_pk_bf16(v0[2], v0[3]); w.z = cvt_pk_bf16(v1[0], v1[1]); w.w = cvt_pk_bf16(v1[2], v1[3]);
                    *(u32x4*)(tb + (size_t)(rl0 + ai * HALF + m * 16) * ld + bj * HALF) = w; }
        }
    }
};
struct SegOrder {
    int t0, ntl, nN, nloc, rank, nfull, seg;
    __device__ void init(int t0_, int t1_, int N, int nloc_, int rank_, int nfull_, int seg_) { t0 = t0_; ntl = t1_ - t0_; nN = N / BM; nloc = nloc_; rank = rank_; nfull = nfull_; seg = seg_; }
    __device__ bool next(int i, Unit& u) const { int L = i * nloc + rank; u.kh = 0;
        if (seg == 0) { if (L >= nfull) return false; }
        else { if (L >= 2 * (ntl * nN - nfull)) return false; u.kh = L & 1; L = nfull + (L >> 1); }
        u.pm = t0 + L % ntl; u.pn = L / ntl; return true; }
    __device__ __forceinline__ void a_ready(const Unit&) const {}
    __device__ __forceinline__ void done(const Unit&) const {}
};


struct AffOrder {
    int t0, ntl, nN, nloc, rank, split;
    __device__ void init(int t0_, int t1_, int N, int nloc_, int rank_, int split_ = 0) { t0 = t0_; ntl = t1_ - t0_; nN = N / BM; nloc = nloc_; rank = rank_; split = split_; }
    __device__ bool next(int i, Unit& u) const { int L = i * nloc + rank; const int nt_ = ntl * nN; if (L >= (split ? 2 * nt_ : nt_)) return false; u.kh = 0; if (L >= nt_) { L -= nt_; u.kh = 1; } u.pm = t0 + L % ntl; u.pn = L / ntl; return true; }
    __device__ __forceinline__ void a_ready(const Unit&) const {}
    __device__ __forceinline__ void done(const Unit&) const {}
};

template <class Epi, class Sched, bool ALIGN_EPI = false, bool SP2 = false>
__device__ __forceinline__ void gemm_phase(PG8_LAS unsigned char* lds, const Gemm g, const Sched& S, const Epi& E) {
    int tid_ = threadIdx.x; asm volatile("" : "+v"(tid_));
    const int tid = tid_, wid = __builtin_amdgcn_readfirstlane(tid >> 6), lane = tid & 63, wr = wid >> 2, wc = wid & 3, fr = lane & 15, fq = lane >> 4;
    const int K = g.K, nt = g.Kh / BK; const size_t khb = (size_t)g.Kh * 2;
    unsigned voffA[2], voffB[2];
#pragma unroll
    for (int i = 0; i < 2; ++i) { int R, C; stage_rc(tid * 16 + i * 8192, R, C); const int Rb = Epi::PERM ? ((R & ~31) + perm32(R & 31)) : R;
        voffA[i] = (unsigned)(R * g.lda + C) * 2u; voffB[i] = (unsigned)(Rb * K + C) * 2u; }
    const size_t kstep = (size_t)(BK * 2);
    const size_t hstep = (size_t)HALF * K * 2;
    const size_t tstep = 2 * hstep; const size_t hstepA = (size_t)HALF * g.lda * 2, tstepA = 2 * hstepA;
    const unsigned ldsw = (unsigned)wid * 1024u;
    const int aoff = lds_byte(wr * 64 + fr, fq * 8), boff = lds_byte(wc * 32 + fr, fq * 8);
#define PG8_SA(b, h) (((b) * 2 + (h)) * HTB)
#define PG8_SB(b, h) ((4 + (b) * 2 + (h)) * HTB)
#define PG8_STAGE(bufoff, gbase, voff) do { _Pragma("unroll") for (int _i = 0; _i < 2; ++_i) \
        __builtin_amdgcn_global_load_lds((const unsigned*)((const char*)(gbase) + (voff)[_i]), (PG8_LAS unsigned*)(lds + (bufoff) + ldsw + _i * 8192), 16, 0, 0); } while (0)
#define PG8_LDA(dst, b, h) do { _Pragma("unroll") for (int m = 0; m < 4; ++m) _Pragma("unroll") for (int k = 0; k < 2; ++k) dst[m][k] = *(const PG8_LAS bf16x8*)(lds + PG8_SA(b, h) + aoff + m * 2048 + k * 1024); } while (0)
#define PG8_LDB(dst, b, h) do { _Pragma("unroll") for (int n = 0; n < 2; ++n) _Pragma("unroll") for (int k = 0; k < 2; ++k) dst[n][k] = *(const PG8_LAS bf16x8*)(lds + PG8_SB(b, h) + boff + n * 2048 + k * 1024); } while (0)
#define PG8_MMA(ai, bj, At, Bt) do { __builtin_amdgcn_s_setprio(1); _Pragma("unroll") for (int m = 0; m < 4; ++m) _Pragma("unroll") for (int n = 0; n < 2; ++n) _Pragma("unroll") for (int k = 0; k < 2; ++k) \
        acc[ai][bj][m][n] = __builtin_amdgcn_mfma_f32_16x16x32_bf16(Bt[n][k], At[m][k], acc[ai][bj][m][n], 0, 0, 0); __builtin_amdgcn_s_setprio(0); } while (0)
#define PG8_WAIT_V(n) asm volatile("s_waitcnt vmcnt(" #n ")" ::: "memory")
#define PG8_WAIT_L(n) asm volatile("s_waitcnt lgkmcnt(" #n ")" ::: "memory")
#define PG8_BAR __builtin_amdgcn_s_barrier()
#define PG8_SCHED __builtin_amdgcn_sched_barrier(0)
    Unit cur, nxt; int ui = 0;
    if (!S.next(0, cur)) return;
    f32x4 acc[2][2][4][2];
#pragma unroll
    for (int a = 0; a < 2; ++a)
#pragma unroll
        for (int b = 0; b < 2; ++b)
#pragma unroll
            for (int m = 0; m < 4; ++m)
#pragma unroll
                for (int n = 0; n < 2; ++n) acc[a][b][m][n] = (f32x4){0.f, 0.f, 0.f, 0.f};
    bf16x8 At[4][2], B0[2][2], B1[2][2];
    const char* cA = (const char*)g.A + (size_t)cur.pm * tstepA + (size_t)cur.kh * khb; const char* cB = (const char*)g.Bt + (size_t)cur.pn * tstep + (size_t)cur.kh * khb;
    S.a_ready(cur);
    if constexpr (SP2) {
        PG8_STAGE(PG8_SB(0, 0), cB, voffB); PG8_STAGE(PG8_SB(0, 1), cB + hstep, voffB); PG8_STAGE(PG8_SA(0, 0), cA, voffA); PG8_STAGE(PG8_SA(0, 1), cA + hstepA, voffA);
        if (wr == 1) PG8_BAR;
        PG8_WAIT_V(2); PG8_BAR;
        PG8_STAGE(PG8_SB(1, 0), cB + kstep, voffB); PG8_STAGE(PG8_SA(1, 0), cA + kstep, voffA); PG8_STAGE(PG8_SB(1, 1), cB + hstep + kstep, voffB);
        PG8_WAIT_V(6); PG8_BAR;
    } else {
        PG8_STAGE(PG8_SB(0, 0), cB, voffB); PG8_STAGE(PG8_SA(0, 0), cA, voffA); PG8_STAGE(PG8_SB(0, 1), cB + hstep, voffB); PG8_STAGE(PG8_SA(0, 1), cA + hstepA, voffA);
        if (wr == 1) PG8_BAR;
        PG8_WAIT_V(4); PG8_BAR;
        PG8_STAGE(PG8_SB(1, 0), cB + kstep, voffB); PG8_STAGE(PG8_SA(1, 0), cA + kstep, voffA); PG8_STAGE(PG8_SB(1, 1), cB + hstep + kstep, voffB);
        PG8_WAIT_V(6); PG8_BAR;
    }
    for (;;) {
        const bool has_next = S.next(ui + 1, nxt);
        const char* nA = has_next ? (const char*)g.A + (size_t)nxt.pm * tstepA + (size_t)nxt.kh * khb : cA; const char* nB = has_next ? (const char*)g.Bt + (size_t)nxt.pn * tstep + (size_t)nxt.kh * khb : cB;
        for (int t = 0; t < nt; t += 2) {
            const bool last = (t == nt - 2);
            const char* a1 = cA + (size_t)(t + 1) * kstep;
            const char* a2 = last ? nA : cA + (size_t)(t + 2) * kstep; const char* b2 = last ? nB : cB + (size_t)(t + 2) * kstep;
            const char* a3 = a2 + kstep; const char* b3 = b2 + kstep;
            if (last && has_next) S.a_ready(nxt);
            if constexpr (SP2) {
            PG8_LDB(B0, 0, 0); PG8_LDB(B1, 0, 1); PG8_SCHED; PG8_LDA(At, 0, 0); PG8_STAGE(PG8_SA(1, 1), a1 + hstepA, voffA);
            PG8_WAIT_V(8); PG8_WAIT_L(0); PG8_BAR; PG8_MMA(0, 0, At, B0); PG8_MMA(0, 1, At, B1); PG8_BAR; PG8_SCHED;
            PG8_LDA(At, 0, 1); PG8_STAGE(PG8_SB(0, 0), b2, voffB); PG8_STAGE(PG8_SB(0, 1), b2 + hstep, voffB); PG8_STAGE(PG8_SA(0, 0), a2, voffA);
            PG8_WAIT_V(8); PG8_WAIT_L(0); PG8_BAR; PG8_MMA(1, 0, At, B0); PG8_MMA(1, 1, At, B1); PG8_BAR; PG8_SCHED;
            PG8_LDB(B0, 1, 0); PG8_LDB(B1, 1, 1); PG8_SCHED; PG8_LDA(At, 1, 0); PG8_STAGE(PG8_SA(0, 1), a2 + hstepA, voffA);
            PG8_WAIT_V(8); PG8_WAIT_L(0); PG8_BAR; PG8_MMA(0, 0, At, B0); PG8_MMA(0, 1, At, B1); PG8_BAR; PG8_SCHED;
            PG8_LDA(At, 1, 1); PG8_STAGE(PG8_SB(1, 0), b3, voffB); PG8_STAGE(PG8_SB(1, 1), b3 + hstep, voffB); PG8_STAGE(PG8_SA(1, 0), a3, voffA);
            PG8_WAIT_V(8); PG8_WAIT_L(0); PG8_BAR; PG8_MMA(1, 0, At, B0); PG8_MMA(1, 1, At, B1); PG8_BAR; PG8_SCHED;
            } else {
            PG8_LDB(B0, 0, 0); PG8_SCHED; PG8_LDA(At, 0, 0); PG8_STAGE(PG8_SA(1, 1), a1 + hstepA, voffA);
            PG8_WAIT_L(8); PG8_BAR; PG8_WAIT_L(0); PG8_MMA(0, 0, At, B0); PG8_BAR; PG8_SCHED;
            PG8_LDB(B1, 0, 1); PG8_STAGE(PG8_SB(0, 0), b2, voffB);
            PG8_BAR; PG8_WAIT_L(0); PG8_MMA(0, 1, At, B1); PG8_BAR;
            PG8_LDA(At, 0, 1); PG8_STAGE(PG8_SA(0, 0), a2, voffA);
            PG8_BAR; PG8_WAIT_L(0); PG8_MMA(1, 0, At, B0); PG8_BAR; PG8_SCHED;
            PG8_STAGE(PG8_SB(0, 1), b2 + hstep, voffB);
            PG8_WAIT_V(6); PG8_BAR; PG8_MMA(1, 1, At, B1); PG8_BAR;
            PG8_LDB(B0, 1, 0); PG8_SCHED; PG8_LDA(At, 1, 0); PG8_STAGE(PG8_SA(0, 1), a2 + hstepA, voffA);
            PG8_WAIT_L(8); PG8_BAR; PG8_WAIT_L(0); PG8_MMA(0, 0, At, B0); PG8_BAR; PG8_SCHED;
            PG8_LDB(B1, 1, 1); PG8_STAGE(PG8_SB(1, 0), b3, voffB);
            PG8_BAR; PG8_WAIT_L(0); PG8_MMA(0, 1, At, B1); PG8_BAR;
            PG8_LDA(At, 1, 1); PG8_STAGE(PG8_SA(1, 0), a3, voffA);
            PG8_BAR; PG8_WAIT_L(0); PG8_MMA(1, 0, At, B0); PG8_BAR; PG8_SCHED;
            PG8_STAGE(PG8_SB(1, 1), b3 + hstep, voffB);
            PG8_WAIT_V(6); PG8_BAR; PG8_MMA(1, 1, At, B1); PG8_BAR;
            }
        }
        if constexpr (ALIGN_EPI) { if (wr == 0) PG8_BAR; }
        if constexpr (!Epi::AFTER_DRAIN) { E(acc, cur, wr, wc, fr, fq); S.done(cur); }
        if (!has_next) break;
#pragma unroll
        for (int a = 0; a < 2; ++a)
#pragma unroll
            for (int b = 0; b < 2; ++b)
#pragma unroll
                for (int m = 0; m < 4; ++m)
#pragma unroll
                    for (int n = 0; n < 2; ++n) acc[a][b][m][n] = (f32x4){0.f, 0.f, 0.f, 0.f};
        cur = nxt; cA = nA; cB = nB; ++ui;
        if constexpr (ALIGN_EPI) { if (wr == 1) PG8_BAR; }
    }
    PG8_WAIT_V(0);
    if constexpr (!ALIGN_EPI) { if (wr == 0) PG8_BAR; }
    PG8_BAR;
    if constexpr (Epi::AFTER_DRAIN) { E.fused(acc, cur, wr, wc, fr, fq, lds, wid, lane); S.done(cur); }
#undef PG8_SA
#undef PG8_SB
#undef PG8_STAGE
#undef PG8_LDA
#undef PG8_LDB
#undef PG8_MMA
#undef PG8_WAIT_V
#undef PG8_WAIT_L
#undef PG8_BAR
#undef PG8_SCHED
}
}
#define GAS __attribute__((address_space(1)))
#define LAS __attribute__((address_space(3)))
typedef unsigned short bf16;
typedef unsigned v4u __attribute__((ext_vector_type(4)));
typedef float f32x4 __attribute__((ext_vector_type(4)));
typedef short bf16x8 __attribute__((ext_vector_type(8)));
typedef GAS unsigned gu32;
typedef GAS unsigned long long gu64;
#define RLX_AGENT __ATOMIC_RELAXED, __HIP_MEMORY_SCOPE_AGENT
#define LDS_WAIT() asm volatile("s_waitcnt lgkmcnt(0)" ::: "memory")
#define VM_WAIT() asm volatile("s_waitcnt vmcnt(0)" ::: "memory")
__device__ __forceinline__ unsigned long long rt() { return __builtin_amdgcn_s_memrealtime(); }
__device__ __forceinline__ unsigned f2bf(float f) { unsigned u = __builtin_bit_cast(unsigned, f); return (u + 0x7fffu + ((u >> 16) & 1u)) >> 16; }
__device__ __forceinline__ unsigned pk2(float lo, float hi) { return f2bf(lo) | (f2bf(hi) << 16); }

#define XB_TMO      128
#define XB_XCNT(j)  (256  + 64 * (j))
#define XB_XSUB(j)  (1280 + 64 * (j))
#define XB_XGEN(j)  (2304 + 64 * (j))
#define XB_TOP      3328
#define XB_TOPGEN   3392
#define XCD_BAR_WORDS 3456
#define XB_SPIN_CAP (1u << 18)

__device__ __forceinline__ unsigned xb_ld(unsigned* p)              { return __hip_atomic_load(p, __ATOMIC_RELAXED, __HIP_MEMORY_SCOPE_AGENT); }
__device__ __forceinline__ unsigned xb_add(unsigned* p, unsigned v) { return __hip_atomic_fetch_add(p, v, __ATOMIC_RELAXED, __HIP_MEMORY_SCOPE_AGENT); }
__device__ __forceinline__ unsigned xb_xcc_id() { return (unsigned)__builtin_amdgcn_s_getreg((3 << 11) | 20) & 0xFu; }
#define XB_SPIN(cond, bar) do { unsigned _sp = 0; while (cond) { __builtin_amdgcn_s_sleep(1); \
    if ((++_sp & 255u) == 0u) { if (xb_ld(&(bar)[XB_TMO])) break; if (_sp > XB_SPIN_CAP) { atomicAdd(&(bar)[XB_TMO], 1u); break; } } } } while (0)

struct XcdBarrier {
    unsigned* bar; unsigned x;
    volatile LAS unsigned* st;
};

__device__ __forceinline__ XcdBarrier xcd_barrier_post(unsigned* bar, volatile LAS unsigned* st) {
    XcdBarrier b; b.bar = bar; b.x = xb_xcc_id(); b.st = st;
    if (threadIdx.x == 0) (void)xb_add(&bar[XB_XCNT(b.x)], 1u);
    return b;
}
__device__ __forceinline__ void xcd_barrier_complete(unsigned* bar, unsigned x, unsigned& nloc, unsigned& nx) {
    const unsigned G = gridDim.x * gridDim.y * gridDim.z;
    unsigned sum, cnt, mine, sp = 0u;
    for (;;) {
        sum = 0u; cnt = 0u; mine = 0u;
#pragma unroll
        for (unsigned j = 0; j < 16; ++j) { const unsigned c = xb_ld(&bar[XB_XCNT(j)]); sum += c; cnt += (c > 0u) ? 1u : 0u; mine = (j == x) ? c : mine; }
        if (sum == G) break;
        __builtin_amdgcn_s_sleep(1);
        if ((++sp & 255u) == 0u) { if (xb_ld(&bar[XB_TMO])) break; if (sp > XB_SPIN_CAP) { atomicAdd(&bar[XB_TMO], 1u); break; } }
    }
    nloc = mine > 0u ? mine : 1u; nx = cnt > 0u ? cnt : 1u;
}

__device__ __forceinline__ void xcd_barrier(const XcdBarrier& b) {
    asm volatile("s_waitcnt vmcnt(0)" ::: "memory");
    __syncthreads();
    if (threadIdx.x == 0) {
        unsigned* bar = b.bar;
        __builtin_amdgcn_s_waitcnt(0);
        unsigned nloc = b.st[0], nx = b.st[1];
        if (nloc == 0u) { xcd_barrier_complete(bar, b.x, nloc, nx); b.st[0] = nloc; b.st[1] = nx; }
        const unsigned old = xb_add(&bar[XB_XSUB(b.x)], 1u);
        const unsigned gen = old / nloc;
        if (old + 1u == (gen + 1u) * nloc) {
            __builtin_amdgcn_fence(__ATOMIC_RELEASE, "agent");
            asm volatile("s_waitcnt vmcnt(0)" ::: "memory");
            const unsigned og = xb_add(&bar[XB_TOP], 1u);
            const unsigned tg = og / nx;
            if (og + 1u == (tg + 1u) * nx) xb_add(&bar[XB_TOPGEN], 1u);
            else XB_SPIN(xb_ld(&bar[XB_TOPGEN]) == tg, bar);
            __builtin_amdgcn_fence(__ATOMIC_ACQUIRE, "agent");
            xb_add(&bar[XB_XGEN(b.x)], 1u);
            asm volatile("s_waitcnt vmcnt(0)" ::: "memory");
        } else {
            XB_SPIN(xb_ld(&bar[XB_XGEN(b.x)]) == gen, bar);
            __builtin_amdgcn_fence(__ATOMIC_ACQUIRE, "agent");
            asm volatile("s_waitcnt vmcnt(0)" ::: "memory");
        }
    }
    __syncthreads();
}

constexpr int NWAVES = 8, NTHR = 512;
constexpr int D = 1024, MCTX = 8192, MLAT = 16384, M = MCTX + MLAT, FF = 2816, NUP = 2 * FF, NIN = 2560, NMOD = 9 * D;
constexpr int LDQ = FF;
constexpr int NITEM = (M / 128) * 4;
constexpr float EPS = 1e-6f;
constexpr size_t MiB = 1u << 20;
constexpr size_t WS_CTL = 0, CTL_ZERO_BYTES = 65536;
constexpr size_t WS_MODS = 65536, WS_ROTC = 262144, WS_ROTS = 262144 + 8192;
constexpr size_t WS_BIASQ = 288 * 1024, WS_BIAS3 = 352 * 1024, WS_RROW = 512 * 1024;
constexpr size_t WS_SSPA = 42 * MiB + 262144, WS_SSPB = 255 * MiB;
constexpr size_t WS_W13A = 1 * MiB, WS_W13B = 12 * MiB, WS_W2A = 23 * MiB, WS_W2B = 29 * MiB, WS_WIN = 35 * MiB, WS_WOUT = 40 * MiB, WS_POOLW = 42 * MiB;
constexpr size_t WS_ABUF = 43 * MiB;
constexpr size_t WS_HBUF = 91 * MiB;
constexpr size_t WS_SLAT = 223 * MiB;
constexpr size_t WS_END = 255 * MiB;
constexpr int CW_BAR = 4096, CW_RANK = 8192, CW_LBAR = 10240, CW_SPLIT = 12288;
constexpr int LDS_BYTES = 147456, MISC_OFF = LDS_BYTES - 256;
constexpr int OUT_SF = M * D, OUT_SB = M * D + 32 * 4 * 128 * 128;
constexpr int RS = 272;

__device__ __forceinline__ float wave_sum(float v) {
#pragma unroll
    for (int o = 1; o < 64; o <<= 1) v += __shfl_xor(v, o);
    return v;
}
__device__ __forceinline__ unsigned cvtpk(float lo, float hi) { return pg8::cvt_pk_bf16(lo, hi); }
__device__ __forceinline__ float bflo(unsigned w) { return __uint_as_float(w << 16); }
__device__ __forceinline__ float bfhi(unsigned w) { return __uint_as_float(w & 0xffff0000u); }
#define EX2(x) __builtin_amdgcn_exp2f(x)
__device__ __forceinline__ v4u ld16_sc1(const void* p) {
    const unsigned long long a = __hip_atomic_load((const unsigned long long*)p, __ATOMIC_RELAXED, __HIP_MEMORY_SCOPE_AGENT), b = __hip_atomic_load((const unsigned long long*)p + 1, __ATOMIC_RELAXED, __HIP_MEMORY_SCOPE_AGENT);
    return (v4u){(unsigned)a, (unsigned)(a >> 32), (unsigned)b, (unsigned)(b >> 32)};
}
#define MFMA16(x, y, c) __builtin_amdgcn_mfma_f32_16x16x32_bf16((x), (y), (c), 0, 0, 0)

struct Args { const float* in[25]; float* out; unsigned char* ws; };

__device__ __forceinline__ void p0_transpose_item(const float* W, int K, int N, bf16* WT, int dst_row0, LAS float* scr, int k0, int n0, int lane) {
#pragma unroll 8
    for (int i = 0; i < 32; ++i) { const int kk = 2 * i + (lane >> 5); scr[kk * 33 + (lane & 31)] = W[(size_t)(k0 + kk) * N + n0 + (lane & 31)]; }
    LDS_WAIT(); asm volatile("" ::: "memory");
    const int c = lane & 7;
#pragma unroll
    for (int j = 0; j < 4; ++j) { const int n = (lane >> 3) + 8 * j; const LAS float* s = scr + (8 * c) * 33 + n;
        v4u o; o.x = pk2(s[0 * 33], s[1 * 33]); o.y = pk2(s[2 * 33], s[3 * 33]); o.z = pk2(s[4 * 33], s[5 * 33]); o.w = pk2(s[6 * 33], s[7 * 33]);
        *(GAS v4u*)(WT + (size_t)(dst_row0 + n) * K + k0 + 8 * c) = o; }
    LDS_WAIT(); asm volatile("" ::: "memory");
}
__device__ __forceinline__ int map_in(int c) {
    if (c < 1024) { const int base = c < 512 ? 0 : 1024, cc = c & 511, h = cc >> 7, d = cc & 127; return base + 256 * (h >> 1) + 128 * (d >> 6) + 64 * (h & 1) + (d & 63); }
    if (c < 1536) return 1536 + (c - 1024);
    if (c < 2048) return 512 + (c - 1536);
    return c;
}

template <bool FINAL>
__device__ __forceinline__ void norm_rows(const float* src0, const float* src1, const float* gamma, const float* mods, int sh_off, int sc_off, bf16* A, float* outF, int row_lo, int row_hi, int lw, int NLW, int lane) {
    for (int row = row_lo + lw; row < row_hi; row += NLW) {
        const bool lat = row >= MCTX; const int grp = lat ? 1 + ((row - MCTX) >> 12) : 0;
        const f32x4* xr = (const f32x4*)((lat ? src1 + (size_t)(row - MCTX) * D : src0 + (size_t)row * D)) + lane;
        f32x4 v[4]; float s = 0.f;
#pragma unroll
        for (int j = 0; j < 4; ++j) { v[j] = xr[64 * j]; s += (v[j].x * v[j].x + v[j].y * v[j].y) + (v[j].z * v[j].z + v[j].w * v[j].w); }
        const float r = 1.0f / sqrtf(wave_sum(s) * (1.f / D) + EPS);
#pragma unroll
        for (int j = 0; j < 4; ++j) { const int col = 4 * (lane + 64 * j); const f32x4 g = *(const f32x4*)(gamma + col);
            if (FINAL) { *(f32x4*)(outF + (size_t)row * D + col) = v[j] * r * g; }
            else { const f32x4 sc = *(const f32x4*)(mods + (size_t)grp * NMOD + sc_off + col), sh = *(const f32x4*)(mods + (size_t)grp * NMOD + sh_off + col);
                const f32x4 a = (v[j] * r * g) * (sc + 1.0f) + sh;
                *(unsigned long long*)(A + (size_t)row * D + col) = (unsigned long long)cvtpk(a.x, a.y) | ((unsigned long long)cvtpk(a.z, a.w) << 32); } }
    }
}

__device__ __forceinline__ void final_rows(float* out, const bf16* d3, const bf16* slabs, int t0, int ntl, int nfull, int xi32, const float* gamma, int row_lo, int row_hi, int lw, int NLW, int lane) {
    for (int row = row_lo + lw; row < row_hi; row += NLW) {
        f32x4* xr = (f32x4*)(out + (size_t)row * D) + lane; const unsigned long long* dr = (const unsigned long long*)(d3 + (size_t)row * D) + lane;
        const int pml = (row >> 8) - t0, rl = row & 255;
        f32x4 v[4]; unsigned long long dv[4], sv[4]; float s = 0.f;
#pragma unroll
        for (int j = 0; j < 4; ++j) { v[j] = xr[64 * j]; dv[j] = dr[64 * j]; const int L = j * ntl + pml; sv[j] = 0ull;
            if (L >= nfull) sv[j] = *((const unsigned long long*)(slabs + (size_t)(xi32 + L - nfull) * 65536 + rl * 256) + lane); }
#pragma unroll
        for (int j = 0; j < 4; ++j) { const unsigned lo = (unsigned)dv[j], hi = (unsigned)(dv[j] >> 32), lo2 = (unsigned)sv[j], hi2 = (unsigned)(sv[j] >> 32);
            v[j] = v[j] + ((f32x4){bflo(lo), bfhi(lo), bflo(hi), bfhi(hi)} + (f32x4){bflo(lo2), bfhi(lo2), bflo(hi2), bfhi(hi2)});
            s += (v[j].x * v[j].x + v[j].y * v[j].y) + (v[j].z * v[j].z + v[j].w * v[j].w); }
        const float r = 1.0f / sqrtf(wave_sum(s) * (1.f / D) + EPS);
#pragma unroll
        for (int j = 0; j < 4; ++j) { const f32x4 g = *(const f32x4*)(gamma + 4 * (lane + 64 * j)); xr[64 * j] = v[j] * r * g; }
    }
}

__device__ __forceinline__ void stage_nat(LAS unsigned char* dst, const bf16* src, int ld, int tid) {
#pragma unroll
    for (int i = 0; i < 4; ++i) { const int c = tid + NTHR * i, row = c >> 4, cc = c & 15; *(LAS v4u*)(dst + row * RS + cc * 16) = *(const v4u*)(src + (size_t)row * ld + cc * 8); }
}


__device__ __forceinline__ void stage_zero(LAS unsigned char* dst, int tid) {
#pragma unroll
    for (int i = 0; i < 4; ++i) { const int c = tid + NTHR * i, row = c >> 4, cc = c & 15; *(LAS v4u*)(dst + row * RS + cc * 16) = (v4u){0u, 0u, 0u, 0u}; }
}


__device__ __forceinline__ void xcc_barrier(unsigned* lw, unsigned nloc, unsigned* tmo) {
    asm volatile("s_waitcnt vmcnt(0)" ::: "memory");
    __syncthreads();
    if (threadIdx.x == 0) {
        const unsigned old = xb_add(lw, 1u), gen = old / nloc;
        if (old + 1u == (gen + 1u) * nloc) xb_add(lw + 64, 1u);
        else XB_SPIN(xb_ld(lw + 64) == gen, tmo);
        __builtin_amdgcn_fence(__ATOMIC_ACQUIRE, "agent");
        asm volatile("s_waitcnt vmcnt(0)" ::: "memory");
    }
    __syncthreads();
}

__global__ void __launch_bounds__(NTHR, 2) hyb_fwd(Args args) {
    extern __shared__ __attribute__((aligned(16))) unsigned char lds_raw[];
    LAS unsigned char* lds = (LAS unsigned char*)lds_raw;
    volatile LAS unsigned* MISC = (volatile LAS unsigned*)(lds + MISC_OFF);
    const int tid = threadIdx.x, lane = tid & 63, wave = __builtin_amdgcn_readfirstlane(tid >> 6), fr = lane & 15, fq = lane >> 4;
    const int G = gridDim.x, bx = blockIdx.x;
    const int gw = bx * NWAVES + wave, NGW = G * NWAVES;
    unsigned char* ws = args.ws;
    if (tid < 64) MISC[tid] = 0u;
    __syncthreads();
    XcdBarrier bar = xcd_barrier_post((unsigned*)(ws + WS_CTL) + CW_BAR, MISC + 8);
    if (tid == 0) MISC[16] = __hip_atomic_fetch_add((unsigned*)(ws + WS_CTL) + CW_RANK + 64 * bar.x, 1u, __ATOMIC_RELAXED, __HIP_MEMORY_SCOPE_AGENT);

    const float* x_ctx = args.in[0]; const float* x_lat = args.in[1];
    float* mods = (float*)(ws + WS_MODS); float* rotc = (float*)(ws + WS_ROTC); float* rots = (float*)(ws + WS_ROTS);
    bf16* W13A = (bf16*)(ws + WS_W13A); bf16* W13B = (bf16*)(ws + WS_W13B); bf16* W2A = (bf16*)(ws + WS_W2A); bf16* W2B = (bf16*)(ws + WS_W2B);
    bf16* WIN = (bf16*)(ws + WS_WIN); bf16* WOUT = (bf16*)(ws + WS_WOUT); bf16* POOLW = (bf16*)(ws + WS_POOLW);
    bf16* ABUF = (bf16*)(ws + WS_ABUF); bf16* HBUF = (bf16*)(ws + WS_HBUF); bf16* SBUF = ABUF; bf16* QKV = HBUF; bf16* SLAT = (bf16*)(ws + WS_SLAT);
    float* out = args.out;
    float* biasq = (float*)(ws + WS_BIASQ); float* bias3 = (float*)(ws + WS_BIAS3); float* rrow = (float*)(ws + WS_RROW); float* sspa = (float*)(ws + WS_SSPA); float* sspb = (float*)(ws + WS_SSPB);

    {
        LAS float* scr = (LAS float*)(lds + wave * 16384);
        constexpr int I_W1 = 16 * 88, I_W2 = 44 * 32, I_IN = 16 * 80, I_OUT = 16 * 32, I_POOL = 32;
        constexpr int NITEMS = 4 * I_W1 + 2 * I_W2 + I_IN + I_OUT + I_POOL;
        for (int it = gw; it < NITEMS; it += NGW) {
            int r = it;
            if (r < 4 * I_W1) { const int which = r / I_W1; r -= which * I_W1; const int kb = r / 88, nb = r % 88, n0 = 32 * nb;
                const float* src = args.in[which == 0 ? 9 : which == 1 ? 10 : which == 2 ? 21 : 22]; bf16* dst = which < 2 ? W13A : W13B;
                p0_transpose_item(src, D, FF, dst, 256 * (n0 >> 7) + 128 * (which & 1) + (n0 & 127), scr, 64 * kb, n0, lane); continue; }
            r -= 4 * I_W1;
            if (r < 2 * I_W2) { const int which = r / I_W2; r -= which * I_W2; const int kb = r / 32, nb = r % 32;
                p0_transpose_item(args.in[which ? 23 : 11], FF, D, which ? W2B : W2A, 32 * nb, scr, 64 * kb, 32 * nb, lane); continue; }
            r -= 2 * I_W2;
            if (r < I_IN) { const int kb = r / 80, nb = r % 80; p0_transpose_item(args.in[13], D, NIN, WIN, map_in(32 * nb), scr, 64 * kb, 32 * nb, lane); continue; }
            r -= I_IN;
            if (r < I_OUT) { const int kb = r / 32, nb = r % 32; p0_transpose_item(args.in[19], D, D, WOUT, 32 * nb, scr, 64 * kb, 32 * nb, lane); continue; }
            r -= I_OUT;
            { const int g = r >> 3, kb = (r >> 2) & 1, nb = r & 3; p0_transpose_item(args.in[17] + g * 16384, 128, 128, POOLW + g * 16384, 32 * nb, scr, 64 * kb, 32 * nb, lane); }
        }
        for (int i = bx * NTHR + tid; i < 2 * 2097152 / 4; i += G * NTHR) *(f32x4*)(out + OUT_SF + 4 * i) = (f32x4){0.f, 0.f, 0.f, 0.f};
        { const int gt = bx * NTHR + tid;
          if (gt < 2048) { const int pos = gt >> 5, f = gt & 31; double fr_ = 1.0; for (int i = 0; i < f; ++i) fr_ *= 0.7498942093324559;
              const double a = (double)pos * fr_; const double n = __builtin_rint(a * 0.15915494309189535); const double rr = a - n * 6.283185307179586; const double r2 = rr * rr;
              double cs = 1.0, sn = 1.0;
              for (int k = 13; k >= 1; --k) { cs = 1.0 - cs * r2 / (double)((2 * k - 1) * (2 * k)); sn = 1.0 - sn * r2 / (double)((2 * k) * (2 * k + 1)); }
              rotc[gt] = (float)cs; rots[gt] = (float)(sn * rr); } }
        __syncthreads();
        LAS float* scond = (LAS float*)lds;
        LAS float* red = (LAS float*)(lds + 5 * 1024 * 4);
        for (int i = tid; i < 5 * D; i += NTHR) { const int g = i >> 10, k = i & 1023; const float cv = g == 0 ? args.in[5][k] : args.in[4][(g - 1) * D + k]; scond[i] = cv / (1.0f + expf(-cv)); }
        __syncthreads();
        const float* ada_w = args.in[6]; const float* ada_b = args.in[7];
        for (int it = bx; it < NMOD / 32; it += G) {
            const int c0 = 32 * it, col = lane & 31, kp = lane >> 5; float a0 = 0.f, a1 = 0.f, a2 = 0.f, a3 = 0.f, a4 = 0.f;
#pragma unroll 8
            for (int i = 0; i < 64; ++i) { const int k = 128 * wave + 2 * i + kp; const float wv = ada_w[(size_t)k * NMOD + c0 + col];
                a0 += scond[k] * wv; a1 += scond[1024 + k] * wv; a2 += scond[2048 + k] * wv; a3 += scond[3072 + k] * wv; a4 += scond[4096 + k] * wv; }
            a0 += __shfl_xor(a0, 32); a1 += __shfl_xor(a1, 32); a2 += __shfl_xor(a2, 32); a3 += __shfl_xor(a3, 32); a4 += __shfl_xor(a4, 32);
            if (lane < 32) { LAS float* rp = red + wave * 160 + col; rp[0] = a0; rp[32] = a1; rp[64] = a2; rp[96] = a3; rp[128] = a4; }
            __syncthreads();
            if (tid < 160) { float s = 0.f;
#pragma unroll
                for (int w = 0; w < 8; ++w) s += red[w * 160 + tid];
                const int g = tid >> 5, cc = tid & 31; mods[(size_t)g * NMOD + c0 + cc] = s + ada_b[c0 + cc]; }
            __syncthreads();
        }
    }
    xcd_barrier(bar);

    if (tid == 0) { unsigned xi_ = 0, nx_ = 0; unsigned* bw = (unsigned*)(ws + WS_CTL) + CW_BAR;
        for (unsigned j = 0; j < 16; ++j) { const unsigned c = xb_ld(&bw[XB_XCNT(j)]); if (c) { if (j < bar.x) ++xi_; ++nx_; } }
        MISC[17] = xi_; MISC[18] = nx_; MISC[19] = xb_ld(&bw[XB_XCNT(bar.x)]); }
    __syncthreads();
    const int rank = __builtin_amdgcn_readfirstlane((int)MISC[16]), xi = __builtin_amdgcn_readfirstlane((int)MISC[17]), nx = __builtin_amdgcn_readfirstlane((int)MISC[18]), nloc = __builtin_amdgcn_readfirstlane((int)MISC[19]);
    const int t0 = (96 * xi) / nx, t1 = (96 * (xi + 1)) / nx;
    const int lwv = rank * NWAVES + wave, NLW = nloc * NWAVES;
    unsigned* const lbw = (unsigned*)(ws + WS_CTL) + CW_LBAR + 128 * bar.x;
#define LOCAL_BAR() xcc_barrier(lbw, (unsigned)nloc, (unsigned*)(ws + WS_CTL) + CW_BAR)
    const int nitl = (t1 - t0) * 8;

    for (int rw = gw; rw < NIN + NUP; rw += NGW) {
        const bool isq = rw < NIN; const int n = isq ? rw : rw - NIN; const bf16* wrow = (isq ? WIN : W13B) + (size_t)n * D + 16 * lane;
        const v4u w0 = *(const v4u*)wrow, w1 = *(const v4u*)(wrow + 8); float wv[16];
#pragma unroll
        for (int q = 0; q < 4; ++q) { wv[2 * q] = bflo(w0[q]); wv[2 * q + 1] = bfhi(w0[q]); wv[8 + 2 * q] = bflo(w1[q]); wv[8 + 2 * q + 1] = bfhi(w1[q]); }
        const float* shp = mods + (isq ? 3072 : 6144) + 16 * lane;
#pragma unroll
        for (int g = 0; g < 5; ++g) { float a = 0.f;
#pragma unroll
            for (int q = 0; q < 4; ++q) { const f32x4 sv = *(const f32x4*)(shp + (size_t)g * NMOD + 4 * q); a += (sv[0] * wv[4 * q] + sv[1] * wv[4 * q + 1]) + (sv[2] * wv[4 * q + 2] + sv[3] * wv[4 * q + 3]); }
            a = wave_sum(a); if (lane == 0) (isq ? biasq + g * NIN : bias3 + g * NUP)[n] = a; }
    }
    norm_rows<false>(x_ctx, x_lat, args.in[8], mods, 0, 1024, ABUF, nullptr, 256 * t0, 256 * t1, lwv, NLW, lane);
    xcd_barrier(bar);

    { pg8::Gemm g{ABUF, W13A, M, NUP, D, D, D}; pg8::AffOrder S; S.init(t0, t1, NUP, nloc, rank); pg8::EpiSwiglu E{HBUF, FF, nullptr, nullptr};
      pg8::gemm_phase<pg8::EpiSwiglu, pg8::AffOrder, true, true>(lds, g, S, E); }
    LOCAL_BAR();
    { pg8::Gemm g{HBUF, W2A, M, D, FF, FF, FF}; pg8::AffOrder S; S.init(t0, t1, D, nloc, rank, 0); pg8::EpiResid E{x_ctx, x_lat, out, mods + 2048, 0.5f, nullptr, ABUF, args.in[12], mods + 4096, sspa, sspb};
      pg8::gemm_phase<pg8::EpiResid, pg8::AffOrder, true, true>(lds, g, S, E); }
    LOCAL_BAR();
    for (int r = 256 * t0 + rank * NTHR + tid; r < 256 * t1; r += nloc * NTHR) { const f32x4 a0 = *(const f32x4*)(sspa + (size_t)r * 8), a1 = *(const f32x4*)(sspa + (size_t)r * 8 + 4), b0 = *(const f32x4*)(sspb + (size_t)r * 8), b1 = *(const f32x4*)(sspb + (size_t)r * 8 + 4);
        const float ssq = (((a0[0] + a0[1]) + (a0[2] + a0[3])) + ((a1[0] + a1[1]) + (a1[2] + a1[3]))) + (((b0[0] + b0[1]) + (b0[2] + b0[3])) + ((b1[0] + b1[1]) + (b1[2] + b1[3])));
        rrow[r] = 1.0f / sqrtf(ssq * (1.f / D) + EPS); }
    LOCAL_BAR();
    { pg8::Gemm g{ABUF, WIN, M, NIN, D, D, D}; pg8::AffOrder S; S.init(t0, t1, NIN, nloc, rank); pg8::EpiQKV E{QKV, LDQ, rotc, rots, rrow, biasq};
      pg8::gemm_phase<pg8::EpiQKV, pg8::AffOrder, true, true>(lds, g, S, E); }
    LOCAL_BAR();

    {
        LAS unsigned char* KT = lds; LAS unsigned char* VFT = lds + 128 * RS; LAS unsigned char* VBT = lds + 2 * 128 * RS;
        for (int li = rank; li < nitl; li += nloc) {
            const int item = 8 * t0 + li, cg = item >> 2, h = item & 3, row0 = cg * 128;
            const float l2f = -expf(args.in[14][h]) * 1.4426950408889634f, l2b = -expf(args.in[15][h]) * 1.4426950408889634f;
            const int jp = 16 * (wave & 3) + (lane & 15), j0 = 2 * jp;
            const float wf0 = EX2(l2f * (float)(127 - j0)), wf1 = EX2(l2f * (float)(126 - j0)), wb0 = EX2(l2b * (float)j0), wb1 = EX2(l2b * (float)(j0 + 1));
#pragma unroll
            for (int pass = 0; pass < 2; ++pass) {
                const int c0 = 8 * (4 * (wave >> 2) + (lane >> 4) + 8 * pass);
                const bf16* kr = QKV + (size_t)(row0 + j0) * LDQ + 1024 + h * 128 + c0; const bf16* vr = kr + 512;
                const v4u ka = *(const v4u*)kr, kb = *(const v4u*)(kr + LDQ), va = *(const v4u*)vr, vb = *(const v4u*)(vr + LDQ);
#pragma unroll
                for (int q = 0; q < 4; ++q) {
                    const unsigned a = ka[q], b = kb[q], c = va[q], d = vb[q];
                    const int r0 = (c0 + 2 * q) * RS + jp * 4, r1 = r0 + RS;
                    *(LAS unsigned*)(KT + r0) = (a & 0xffffu) | (b << 16); *(LAS unsigned*)(KT + r1) = (a >> 16) | (b & 0xffff0000u);
                    const float v00 = bflo(c), v01 = bfhi(c), v10 = bflo(d), v11 = bfhi(d);
                    *(LAS unsigned*)(VFT + r0) = cvtpk(v00 * wf0, v10 * wf1); *(LAS unsigned*)(VFT + r1) = cvtpk(v01 * wf0, v11 * wf1);
                    *(LAS unsigned*)(VBT + r0) = cvtpk(v00 * wb0, v10 * wb1); *(LAS unsigned*)(VBT + r1) = cvtpk(v01 * wb0, v11 * wb1);
                }
            }
            __syncthreads();
            f32x4 af[8], ab[8];
#pragma unroll
            for (int dt = 0; dt < 8; ++dt) { af[dt] = (f32x4){0.f, 0.f, 0.f, 0.f}; ab[dt] = (f32x4){0.f, 0.f, 0.f, 0.f}; }
#pragma unroll
            for (int kk = 0; kk < 4; ++kk) {
                const int ko = (32 * kk + 8 * fq) * 2;
                const bf16x8 yf = *(const LAS bf16x8*)(VFT + (16 * wave + fr) * RS + ko), yb = *(const LAS bf16x8*)(VBT + (16 * wave + fr) * RS + ko);
#pragma unroll
                for (int dt = 0; dt < 8; ++dt) { const bf16x8 xk = *(const LAS bf16x8*)(KT + (16 * dt + fr) * RS + ko); af[dt] = MFMA16(xk, yf, af[dt]); ab[dt] = MFMA16(xk, yb, ab[dt]); }
            }
            bf16* sf = SBUF + ((size_t)item * 2) * 16384 + (16 * wave + fr) * 128 + 4 * fq; bf16* sb = sf + 16384;
#pragma unroll
            for (int dt = 0; dt < 8; ++dt) {
                *(unsigned long long*)(sf + 16 * dt) = (unsigned long long)cvtpk(af[dt][0], af[dt][1]) | ((unsigned long long)cvtpk(af[dt][2], af[dt][3]) << 32);
                *(unsigned long long*)(sb + 16 * dt) = (unsigned long long)cvtpk(ab[dt][0], ab[dt][1]) | ((unsigned long long)cvtpk(ab[dt][2], ab[dt][3]) << 32);
            }
            if (item < 256) {
                const int nch = cg & 1, bh = (cg >> 1) * 4 + h;
                const float sfw = nch == 0 ? exp2f(l2f * 128.0f) : 1.0f, sbw = nch == 1 ? exp2f(l2b * 128.0f) : 1.0f;
                float* cf = out + OUT_SF + (size_t)bh * 16384 + (4 * fq) * 128 + 16 * wave + fr; float* cb = out + OUT_SB + (size_t)bh * 16384 + (4 * fq) * 128 + 16 * wave + fr;
#pragma unroll
                for (int dt = 0; dt < 8; ++dt)
#pragma unroll
                    for (int i = 0; i < 4; ++i) { unsafeAtomicAdd(cf + (16 * dt + i) * 128, af[dt][i] * sfw); unsafeAtomicAdd(cb + (16 * dt + i) * 128, ab[dt][i] * sbw); }
            }
            __syncthreads();
        }
    }
    xcd_barrier(bar);

    {
        const int gt = bx * NTHR + tid, GT = G * NTHR;
        for (int task = gt; task < 4 * 4 * 2 * 2048; task += GT) {
            const int e8 = task & 2047, dir = (task >> 11) & 1, h = (task >> 12) & 3, b = task >> 14;
            float carry[8];
            { const float* s0 = args.in[dir ? 3 : 2] + ((size_t)b * 4 + h) * 16384; const int dv = e8 >> 4, dk0 = (e8 & 15) * 8;
#pragma unroll
              for (int e = 0; e < 8; ++e) carry[e] = s0[(dk0 + e) * 128 + dv]; }
            const float gC = exp2f(-expf(args.in[dir ? 15 : 14][h]) * 1.4426950408889634f * 128.0f);
            for (int sb = 0; sb < 32; sb += 8) {
                v4u kv[8];
#pragma unroll
                for (int i = 0; i < 8; ++i) { const int n = dir ? 31 - (sb + i) : sb + i; kv[i] = *(const v4u*)(SBUF + (((size_t)(64 + 32 * b + n) * 4 + h) * 2 + dir) * 16384 + e8 * 8); }
#pragma unroll
                for (int i = 0; i < 8; ++i) { const int n = dir ? 31 - (sb + i) : sb + i;
                    v4u o; o.x = cvtpk(carry[0], carry[1]); o.y = cvtpk(carry[2], carry[3]); o.z = cvtpk(carry[4], carry[5]); o.w = cvtpk(carry[6], carry[7]);
                    *(v4u*)(SLAT + (((size_t)(32 * b + n) * 4 + h) * 2 + dir) * 16384 + e8 * 8) = o;
#pragma unroll
                    for (int q = 0; q < 4; ++q) { carry[2 * q] = carry[2 * q] * gC + bflo(kv[i][q]); carry[2 * q + 1] = carry[2 * q + 1] * gC + bfhi(kv[i][q]); } }
            }
        }
    }
    xcd_barrier(bar);

    {
        LAS unsigned char* KP = lds; LAS unsigned char* VT = lds + 128 * RS; LAS unsigned char* SFT = lds + 2 * 128 * RS; LAS unsigned char* SBT = lds + 3 * 128 * RS;
        LAS unsigned char* US = lds; LAS unsigned char* WT = lds + 2 * 128 * RS;
        for (int li = rank; li < nitl; li += nloc) {
            const int item = 8 * t0 + li, cg = item >> 2, h = item & 3, row0 = cg * 128;
            const bool lat = cg >= 64; const int n = lat ? (cg - 64) & 31 : cg & 1, L = lat ? 4096 : 256, seq_row0 = row0 - n * 128;
            const float l2f = -expf(args.in[14][h]) * 1.4426950408889634f, l2b = -expf(args.in[15][h]) * 1.4426950408889634f;
            stage_nat(KP, QKV + (size_t)row0 * LDQ + 1024 + h * 128, LDQ, tid);
            if (lat) { stage_nat(SFT, SLAT + ((size_t)(item - 256) * 2) * 16384, 128, tid); stage_nat(SBT, SLAT + ((size_t)(item - 256) * 2 + 1) * 16384, 128, tid); }
            else if (n == 0) { stage_zero(SFT, tid); stage_nat(SBT, SBUF + ((size_t)(item + 4) * 2 + 1) * 16384, 128, tid); }
            else { stage_nat(SFT, SBUF + ((size_t)(item - 4) * 2) * 16384, 128, tid); stage_zero(SBT, tid); }
            { const int jp = 16 * (wave & 3) + (lane & 15), j0 = 2 * jp;
#pragma unroll
              for (int pass = 0; pass < 2; ++pass) { const int c0 = 8 * (4 * (wave >> 2) + (lane >> 4) + 8 * pass);
                  const bf16* vr = QKV + (size_t)(row0 + j0) * LDQ + 1536 + h * 128 + c0; const v4u va = *(const v4u*)vr, vb = *(const v4u*)(vr + LDQ);
#pragma unroll
                  for (int q = 0; q < 4; ++q) { const unsigned a = va[q], b = vb[q]; const int r0 = (c0 + 2 * q) * RS + jp * 4;
                      *(LAS unsigned*)(VT + r0) = (a & 0xffffu) | (b << 16); *(LAS unsigned*)(VT + r0 + RS) = (a >> 16) | (b & 0xffff0000u); } } }
            const int il = 16 * wave + fr, row = row0 + il;
            bf16x8 yq[4];
#pragma unroll
            for (int kk = 0; kk < 4; ++kk) yq[kk] = *(const bf16x8*)(QKV + (size_t)row * LDQ + h * 128 + 32 * kk + 8 * fq);
            __syncthreads();
            f32x4 sc[8];
#pragma unroll
            for (int jt = 0; jt < 8; ++jt) { sc[jt] = (f32x4){0.f, 0.f, 0.f, 0.f};
#pragma unroll
                for (int kk = 0; kk < 4; ++kk) sc[jt] = MFMA16(*(const LAS bf16x8*)(KP + (16 * jt + fr) * RS + (32 * kk + 8 * fq) * 2), yq[kk], sc[jt]); }
#pragma unroll
            for (int jt = 0; jt < 8; ++jt)
#pragma unroll
                for (int i = 0; i < 4; ++i) { const int j = 16 * jt + 4 * fq + i, dl = il - j; const float w = dl > 0 ? EX2(l2f * (float)dl) : (dl < 0 ? EX2(l2b * (float)(-dl)) : 2.0f); sc[jt][i] *= w; }
            __syncthreads();
#pragma unroll
            for (int jt = 0; jt < 8; ++jt) *(LAS unsigned long long*)(KP + il * RS + (16 * jt + 4 * fq) * 2) = (unsigned long long)cvtpk(sc[jt][0], sc[jt][1]) | ((unsigned long long)cvtpk(sc[jt][2], sc[jt][3]) << 32);
            __syncthreads();
            f32x4 oi[8];
#pragma unroll
            for (int dt = 0; dt < 8; ++dt) oi[dt] = (f32x4){0.f, 0.f, 0.f, 0.f};
            const float cfw = EX2(l2f * (float)(il + 1)), cbw = EX2(l2b * (float)(128 - il));
#pragma unroll 1
            for (int kk = 0; kk < 4; ++kk) { const int ko = (32 * kk + 8 * fq) * 2; const bf16x8 yp = *(const LAS bf16x8*)(KP + il * RS + ko);
                const v4u qw = *(const v4u*)(QKV + (size_t)row * LDQ + h * 128 + 32 * kk + 8 * fq); v4u qf, qb;
#pragma unroll
                for (int q = 0; q < 4; ++q) { const float lo = bflo(qw[q]), hi = bfhi(qw[q]); qf[q] = cvtpk(lo * cfw, hi * cfw); qb[q] = cvtpk(lo * cbw, hi * cbw); }
                const bf16x8 yqf = __builtin_bit_cast(bf16x8, qf), yqb = __builtin_bit_cast(bf16x8, qb);
#pragma unroll
                for (int dt = 0; dt < 8; ++dt) { const int ro = (16 * dt + fr) * RS + ko;
                    oi[dt] = MFMA16(*(const LAS bf16x8*)(VT + ro), yp, oi[dt]); oi[dt] = MFMA16(*(const LAS bf16x8*)(SFT + ro), yqf, oi[dt]); oi[dt] = MFMA16(*(const LAS bf16x8*)(SBT + ro), yqb, oi[dt]); } }
            float ss = 0.f;
#pragma unroll
            for (int dt = 0; dt < 8; ++dt) ss += (oi[dt][0] * oi[dt][0] + oi[dt][1] * oi[dt][1]) + (oi[dt][2] * oi[dt][2] + oi[dt][3] * oi[dt][3]);
            ss += __shfl_xor(ss, 16); ss += __shfl_xor(ss, 32);
            const float rn = 1.0f / sqrtf(ss * (1.0f / 128.0f) + EPS);
            { bf16* qrow = QKV + (size_t)row * LDQ + h * 128 + 4 * fq; const bf16* grow = qrow + 512; const float* gn = args.in[16] + h * 128 + 4 * fq;
#pragma unroll
              for (int dt = 0; dt < 8; ++dt) { const unsigned long long gw_ = *(const unsigned long long*)(grow + 16 * dt); const f32x4 g4 = *(const f32x4*)(gn + 16 * dt);
                  const unsigned g01 = (unsigned)gw_, g23 = (unsigned)(gw_ >> 32);
                  const float r0 = oi[dt][0] * rn * g4[0] * pg8::silu_f(bflo(g01)), r1 = oi[dt][1] * rn * g4[1] * pg8::silu_f(bfhi(g01));
                  const float r2 = oi[dt][2] * rn * g4[2] * pg8::silu_f(bflo(g23)), r3 = oi[dt][3] * rn * g4[3] * pg8::silu_f(bfhi(g23));
                  *(unsigned long long*)(qrow + 16 * dt) = (unsigned long long)cvtpk(r0, r1) | ((unsigned long long)cvtpk(r2, r3) << 32); } }
            __syncthreads();
            { const int half = 1 << h;
              for (int c = tid; c < 144 * 16; c += NTHR) { const int lr = c >> 4, cc = c & 15, pos = n * 128 - 8 + lr; v4u v = (v4u){0u, 0u, 0u, 0u};
                  if (pos >= 0 && pos < L) v = *(const v4u*)(QKV + (size_t)(seq_row0 + pos) * LDQ + 2048 + h * 128 + cc * 8);
                  *(LAS v4u*)(US + lr * RS + cc * 16) = v; }
              stage_nat(WT, POOLW + h * 16384, 128, tid);
              __syncthreads();
              const int pos = n * 128 + il, lo = pos - half > 0 ? pos - half : 0, hi = pos + half < L ? pos + half : L; const float inv = 1.0f / (float)(hi - lo);
              bf16x8 yd[4];
#pragma unroll
              for (int kk = 0; kk < 4; ++kk) { const int co = (32 * kk + 8 * fq) * 2; float s[8];
#pragma unroll
                  for (int e = 0; e < 8; ++e) s[e] = 0.f;
                  for (int dd = -half; dd < half; ++dd) { const v4u v = *(const LAS v4u*)(US + (il + 8 + dd) * RS + co);
#pragma unroll
                      for (int q = 0; q < 4; ++q) { s[2 * q] += bflo(v[q]); s[2 * q + 1] += bfhi(v[q]); } }
                  const v4u cv = *(const LAS v4u*)(US + (il + 8) * RS + co); v4u dq;
#pragma unroll
                  for (int q = 0; q < 4; ++q) dq[q] = cvtpk(s[2 * q] * inv - bflo(cv[q]), s[2 * q + 1] * inv - bfhi(cv[q]));
                  yd[kk] = __builtin_bit_cast(bf16x8, dq); }
              f32x4 po[8];
#pragma unroll
              for (int dt = 0; dt < 8; ++dt) { po[dt] = (f32x4){0.f, 0.f, 0.f, 0.f};
#pragma unroll
                  for (int kk = 0; kk < 4; ++kk) po[dt] = MFMA16(*(const LAS bf16x8*)(WT + (16 * dt + fr) * RS + (32 * kk + 8 * fq) * 2), yd[kk], po[dt]); }
              bf16* prow = QKV + (size_t)row * LDQ + 512 + h * 128 + 4 * fq; const float* ps = args.in[18] + h * 128 + 4 * fq;
#pragma unroll
              for (int dt = 0; dt < 8; ++dt) { const f32x4 p4 = *(const f32x4*)(ps + 16 * dt);
                  *(unsigned long long*)(prow + 16 * dt) = (unsigned long long)cvtpk(po[dt][0] * p4[0], po[dt][1] * p4[1]) | ((unsigned long long)cvtpk(po[dt][2] * p4[2], po[dt][3] * p4[3]) << 32); }
            }
            __syncthreads();
        }
    }
    xcd_barrier(bar);

    { pg8::Gemm g{QKV, WOUT, M, D, D, LDQ, D}; pg8::AffOrder S; S.init(t0, t1, D, nloc, rank, 0); pg8::EpiResid E{out, out + (size_t)MCTX * D, out, mods + 5120, 1.0f, nullptr, ABUF, args.in[20], mods + 7168, sspa, sspb};
      pg8::gemm_phase<pg8::EpiResid, pg8::AffOrder, true, true>(lds, g, S, E); }
    LOCAL_BAR();
    for (int r = 256 * t0 + rank * NTHR + tid; r < 256 * t1; r += nloc * NTHR) { const f32x4 a0 = *(const f32x4*)(sspa + (size_t)r * 8), a1 = *(const f32x4*)(sspa + (size_t)r * 8 + 4), b0 = *(const f32x4*)(sspb + (size_t)r * 8), b1 = *(const f32x4*)(sspb + (size_t)r * 8 + 4);
        const float ssq = (((a0[0] + a0[1]) + (a0[2] + a0[3])) + ((a1[0] + a1[1]) + (a1[2] + a1[3]))) + (((b0[0] + b0[1]) + (b0[2] + b0[3])) + ((b1[0] + b1[1]) + (b1[2] + b1[3])));
        rrow[r] = 1.0f / sqrtf(ssq * (1.f / D) + EPS); }
    LOCAL_BAR();
    { pg8::Gemm g{ABUF, W13B, M, NUP, D, D, D}; pg8::AffOrder S; S.init(t0, t1, NUP, nloc, rank); pg8::EpiSwiglu E{HBUF, FF, rrow, bias3};
      pg8::gemm_phase<pg8::EpiSwiglu, pg8::AffOrder, true, true>(lds, g, S, E); }
    LOCAL_BAR();
    { const int ntot = (t1 - t0) * (D / 256), tail_raw = ntot % nloc; const bool split_ok = tail_raw > 0 && tail_raw <= 32 && xi < 8;
      const int nfull = split_ok ? ntot - tail_raw : ntot, xi32 = xi * 32;
      pg8::EpiDelta E{ABUF, mods + 8192, SLAT, t0, t1 - t0, nfull, xi32};
      { pg8::Gemm g{HBUF, W2B, M, D, FF, FF, FF}; pg8::SegOrder S; S.init(t0, t1, D, nloc, rank, nfull, 0); pg8::gemm_phase<pg8::EpiDelta, pg8::SegOrder, true, true>(lds, g, S, E); }
      { pg8::Gemm g{HBUF, W2B, M, D, FF, FF, FF / 2}; pg8::SegOrder S; S.init(t0, t1, D, nloc, rank, nfull, 1); pg8::gemm_phase<pg8::EpiDelta, pg8::SegOrder, true, true>(lds, g, S, E); }
      LOCAL_BAR();
      final_rows(out, ABUF, SLAT, t0, t1 - t0, nfull, xi32, args.in[24], 256 * t0, 256 * t1, lwv, NLW, lane); }
}

extern "C" void kernel_launch(void* const* d_in, const int* in_sizes, int n_in, void* d_out, int out_size, void* d_ws, size_t ws_size, hipStream_t stream) {
    static int grid = 0;
    if (grid == 0) {
        if (n_in != 25 || in_sizes[0] != MCTX * D || in_sizes[1] != MLAT * D || out_size != M * D + 2 * 32 * 4 * 128 * 128 || ws_size < 256 * MiB) {
            fprintf(stderr, "kernel_launch: unexpected shapes (n_in %d, out %d, ws %zu); nothing launched\n", n_in, out_size, ws_size); grid = -1; return; }
        int dev = 0, cus = 0, per_cu = 0;
        if (hipGetDevice(&dev) != hipSuccess || hipDeviceGetAttribute(&cus, hipDeviceAttributeMultiprocessorCount, dev) != hipSuccess) { grid = -1; return; }
        if (hipFuncSetAttribute((const void*)hyb_fwd, hipFuncAttributeMaxDynamicSharedMemorySize, LDS_BYTES) != hipSuccess) { fprintf(stderr, "kernel_launch: hipFuncSetAttribute failed\n"); grid = -1; return; }
        if (hipOccupancyMaxActiveBlocksPerMultiprocessor(&per_cu, (const void*)hyb_fwd, NTHR, LDS_BYTES) != hipSuccess || per_cu < 1) {
            fprintf(stderr, "kernel_launch: occupancy query reports %d workgroups per CU; nothing launched\n", per_cu); (void)hipGetLastError(); grid = -1; return; }
        grid = cus;
    }
    if (grid < 0) return;
    (void)hipMemsetAsync((char*)d_ws + WS_CTL, 0, CTL_ZERO_BYTES, stream);
    Args a{};
    for (int i = 0; i < 25; ++i) a.in[i] = (const float*)d_in[i];
    a.out = (float*)d_out; a.ws = (unsigned char*)d_ws;
    hipLaunchKernelGGL(hyb_fwd, dim3(grid), dim3(NTHR), LDS_BYTES, stream, a);
}
```

```cpp
#include <hip/hip_runtime.h>
#include <cstdio>
#include <cstdint>
namespace pg8 {
#define PG8_LAS __attribute__((address_space(3)))
typedef unsigned short bf16_t;
typedef short bf16x8 __attribute__((ext_vector_type(8)));
typedef float f32x4 __attribute__((ext_vector_type(4)));
typedef unsigned u32x4 __attribute__((ext_vector_type(4)));
constexpr int BM = 256, BK = 64, HALF = 128, HTB = HALF * BK * 2  , STAGE_BYTES = 8 * HTB, NXCD = 8, WGM = 8;

__host__ __device__ __forceinline__ int lds_byte(int r, int c) { const int st = (r >> 4) * 2 + (c >> 5), rr = r & 15, cc = c & 31, ob = rr * 64 + cc * 2; return st * 1024 + (ob ^ (((ob >> 9) & 1) << 5)); }
__host__ __device__ __forceinline__ void stage_rc(int b, int& R, int& C) { const int st = b / 1024, sb = b % 1024, swz = sb ^ (((sb >> 9) & 1) << 5); R = (st >> 1) * 16 + swz / 64; C = (st & 1) * 32 + (swz % 64) / 2; }
__host__ __device__ __forceinline__ int perm32(int rho) { const int n = rho >> 4, i = rho & 15; return 8 * (i >> 2) + 4 * n + (i & 3); }

struct Unit { int pm, pn, kh; };
struct Gemm { const bf16_t* A; const bf16_t* Bt; int M, N, K, lda, Kh; };

struct StaticOrder {
    int nM, nN, nwg, G, c;
    __host__ __device__ void init(int M, int N, int G_, int c_) { nM = M / BM; nN = N / BM; nwg = nM * nN; G = G_; c = c_; }
    __host__ __device__ bool next(int i, Unit& u) const {
        const long L = (long)i * G + c; if (L >= nwg) return false;
        int wgid = (int)L; { const int q = nwg / NXCD, r = nwg % NXCD, xcd = wgid % NXCD, off = wgid / NXCD; wgid = (xcd < r ? xcd * (q + 1) : r * (q + 1) + (xcd - r) * q) + off; }
        const int nig = WGM * nN, gid = wgid / nig, fm = gid * WGM, gsz = (nM - fm) < WGM ? (nM - fm) : WGM;
        u.pm = fm + ((wgid % nig) % gsz); u.pn = (wgid % nig) / gsz; return true;
    }
    __device__ __forceinline__ void a_ready(const Unit&) const {}
    __device__ __forceinline__ void done(const Unit&) const {}
};

typedef float f32x2 __attribute__((ext_vector_type(2)));
typedef __bf16 bf16x2_t __attribute__((ext_vector_type(2)));
__device__ __forceinline__ unsigned cvt_pk_bf16(float lo, float hi) { const f32x2 v = {lo, hi}; return __builtin_bit_cast(unsigned, __builtin_convertvector(v, bf16x2_t)); }
__device__ __forceinline__ float silu_f(float x) { return x * __builtin_amdgcn_rcpf(1.0f + __expf(-x)); }
struct EpiSwiglu {
    static constexpr bool PERM = true, AFTER_DRAIN = false;
    bf16_t* O; int ldo;
    const float* rrow; const float* bias;
    __device__ __forceinline__ void operator()(const f32x4 (&acc)[2][2][4][2], const Unit& u, int wr, int wc, int fr, int fq) const {
        const int rowt = u.pm * BM, row0 = rowt + wr * 64 + fr, col0 = u.pn * HALF + wc * 32 + 8 * fq;
        const int grp = rowt >= 8192 ? 1 + ((rowt - 8192) >> 12) : 0;
        f32x4 bg[2], bu[2];
#pragma unroll
        for (int n = 0; n < 2; ++n) { bg[n] = (f32x4){0.f, 0.f, 0.f, 0.f}; bu[n] = bg[n];
            if (rrow) { const float* bp = bias + (size_t)grp * 5632 + u.pn * BM + wc * 32 + 8 * fq + 4 * n; bg[n] = *(const f32x4*)bp; bu[n] = *(const f32x4*)(bp + HALF); } }
#pragma unroll
        for (int ai = 0; ai < 2; ++ai)
#pragma unroll
            for (int m = 0; m < 4; ++m) { const int r = row0 + ai * HALF + m * 16; bf16_t* rowp = O + (size_t)r * ldo + col0;
                const float rs = rrow ? rrow[r] : 1.0f;
                const f32x4 g0 = acc[ai][0][m][0] * rs + bg[0], g1 = acc[ai][0][m][1] * rs + bg[1], u0 = acc[ai][1][m][0] * rs + bu[0], u1 = acc[ai][1][m][1] * rs + bu[1];
                u32x4 w;
                w.x = cvt_pk_bf16(silu_f(g0[0]) * u0[0], silu_f(g0[1]) * u0[1]); w.y = cvt_pk_bf16(silu_f(g0[2]) * u0[2], silu_f(g0[3]) * u0[3]);
                w.z = cvt_pk_bf16(silu_f(g1[0]) * u1[0], silu_f(g1[1]) * u1[1]); w.w = cvt_pk_bf16(silu_f(g1[2]) * u1[2], silu_f(g1[3]) * u1[3]);
                *(u32x4*)rowp = w; }
    }
};
struct EpiResid {
    static constexpr bool PERM = true, AFTER_DRAIN = false;
    const float* base0; const float* base1; const bf16_t* baseb; bf16_t* hb; const float* coef; int mul2;
    bf16_t* hm; const float* gamma; const float* scn; float* sspa; float* sspb;
    __device__ __forceinline__ void operator()(const f32x4 (&acc)[2][2][4][2], const Unit& u, int wr_in, int wc_in, int fr_in, int fq_in) const {
        int tid_ = threadIdx.x; asm volatile("" : "+v"(tid_));
        const int lane_ = tid_ & 63, wid_ = __builtin_amdgcn_readfirstlane(tid_ >> 6), wr = wid_ >> 2, wc = wid_ & 3, fr = lane_ & 15, fq = lane_ >> 4;
        const float mulv = 0.5f * (float)mul2; const bf16_t* const baseb_ = baseb; bf16_t* const hb_ = hb;
        const int rowt = u.pm * BM; const bool lat = rowt >= 8192; const int grp = lat ? 1 + ((rowt - 8192) >> 12) : 0;
        const float* bp = lat ? base1 : base0; const int rsub = lat ? 8192 : 0;
        const int row0 = rowt + wr * 64 + fr, col0 = u.pn * BM + wc * 32 + 8 * fq;
        float* ssp = (u.pn < 2 ? sspa : sspb) + (u.pn & 1) * 4 + wc;
        float ss8[8];
#pragma unroll
        for (int k = 0; k < 8; ++k) ss8[k] = 0.f;
#pragma unroll
        for (int bj = 0; bj < 2; ++bj) {
            f32x4 cf[2], gm[2];
#pragma unroll
            for (int n = 0; n < 2; ++n) { cf[n] = *(const f32x4*)(coef + (size_t)grp * 9216 + col0 + bj * HALF + n * 4) * mulv;
                gm[n] = *(const f32x4*)(gamma + col0 + bj * HALF + n * 4) * (*(const f32x4*)(scn + (size_t)grp * 9216 + col0 + bj * HALF + n * 4) + 1.0f); }
#pragma unroll
            for (int ai = 0; ai < 2; ++ai)
#pragma unroll
                for (int m = 0; m < 4; ++m) { const int r = row0 + ai * HALF + m * 16;
                    f32x4 b0, b1;
                    if (baseb_) { const u32x4 pw = *(const u32x4*)(baseb_ + (size_t)r * 2048 + col0 + bj * HALF);
                        b0 = (f32x4){__uint_as_float(pw.x << 16), __uint_as_float(pw.x & 0xffff0000u), __uint_as_float(pw.y << 16), __uint_as_float(pw.y & 0xffff0000u)};
                        b1 = (f32x4){__uint_as_float(pw.z << 16), __uint_as_float(pw.z & 0xffff0000u), __uint_as_float(pw.w << 16), __uint_as_float(pw.w & 0xffff0000u)}; }
                    else { const float* bsrc = bp + (size_t)(r - rsub) * 1024 + col0 + bj * HALF; b0 = *(const f32x4*)bsrc; b1 = *(const f32x4*)(bsrc + 4); }
                    const f32x4 h0 = b0 + cf[0] * acc[ai][bj][m][0], h1 = b1 + cf[1] * acc[ai][bj][m][1];
                    { u32x4 w; w.x = cvt_pk_bf16(h0[0], h0[1]); w.y = cvt_pk_bf16(h0[2], h0[3]); w.z = cvt_pk_bf16(h1[0], h1[1]); w.w = cvt_pk_bf16(h1[2], h1[3]);
                      *(u32x4*)(hb_ + (size_t)r * 2048 + col0 + bj * HALF) = w; }
                    ss8[ai * 4 + m] += ((h0[0] * h0[0] + h0[1] * h0[1]) + (h0[2] * h0[2] + h0[3] * h0[3])) + ((h1[0] * h1[0] + h1[1] * h1[1]) + (h1[2] * h1[2] + h1[3] * h1[3]));
                    { const f32x4 a0 = h0 * gm[0], a1 = h1 * gm[1]; u32x4 w;
                      w.x = cvt_pk_bf16(a0[0], a0[1]); w.y = cvt_pk_bf16(a0[2], a0[3]); w.z = cvt_pk_bf16(a1[0], a1[1]); w.w = cvt_pk_bf16(a1[2], a1[3]);
                      *(u32x4*)(hm + (size_t)r * 1024 + col0 + bj * HALF) = w; }
                    if (m & 1) asm volatile("" ::: "memory"); }
        }
#pragma unroll
        for (int k = 0; k < 8; ++k) { float ss = ss8[k]; ss += __shfl_xor(ss, 16); ss += __shfl_xor(ss, 32); if (fq == 0) ssp[(size_t)(row0 + (k >> 2) * HALF + (k & 3) * 16) * 8] = ss; }
    }
};
struct EpiQKV {
    static constexpr bool PERM = true, AFTER_DRAIN = false;
    bf16_t* O; int ldo; const float* rotc; const float* rots; const float* rrow; const float* bias;
    __device__ __forceinline__ void operator()(const f32x4 (&acc)[2][2][4][2], const Unit& u, int wr, int wc, int fr, int fq) const {
        const int rowt = u.pm * BM, row0 = rowt + wr * 64 + fr, pn = u.pn;
        const int grp = rowt >= 8192 ? 1 + ((rowt - 8192) >> 12) : 0;
        f32x4 bb[2][2];
#pragma unroll
        for (int bj = 0; bj < 2; ++bj)
#pragma unroll
            for (int n = 0; n < 2; ++n) bb[bj][n] = *(const f32x4*)(bias + (size_t)grp * 2560 + pn * BM + bj * HALF + wc * 32 + 8 * fq + 4 * n);
        if (pn < 2 || pn == 4 || pn == 5) {
            const bool isk = pn >= 4; const int hp = (pn & 1) * 2 + (wc >> 1); const int d1 = 32 * (wc & 1) + 8 * fq;
            const int colbase = (isk ? 1024 : 0) + hp * 128 + d1; const float sc = isk ? 0.08838834764831845f : 1.0f; const bool lat = rowt >= 8192;
#pragma unroll
            for (int ai = 0; ai < 2; ++ai)
#pragma unroll
                for (int m = 0; m < 4; ++m) { const int r = row0 + ai * HALF + m * 16;
                    const float rs = rrow[r];
                    f32x4 x1a = (acc[ai][0][m][0] * rs + bb[0][0]) * sc, x1b = (acc[ai][0][m][1] * rs + bb[0][1]) * sc, x2a = (acc[ai][1][m][0] * rs + bb[1][0]) * sc, x2b = (acc[ai][1][m][1] * rs + bb[1][1]) * sc;
                    if (lat) { const int t = (r - 8192) & 4095; const int pos = (wc & 1) ? (t & 63) : (t >> 6);
                        const float* cp = rotc + pos * 32 + 8 * fq; const float* sp = rots + pos * 32 + 8 * fq;
                        const f32x4 c0 = *(const f32x4*)cp, c1 = *(const f32x4*)(cp + 4), s0 = *(const f32x4*)sp, s1 = *(const f32x4*)(sp + 4);
                        const f32x4 o1a = x1a * c0 - x2a * s0, o2a = x1a * s0 + x2a * c0, o1b = x1b * c1 - x2b * s1, o2b = x1b * s1 + x2b * c1;
                        x1a = o1a; x2a = o2a; x1b = o1b; x2b = o2b; }
                    bf16_t* rowp = O + (size_t)r * ldo + colbase; u32x4 w;
                    w.x = cvt_pk_bf16(x1a[0], x1a[1]); w.y = cvt_pk_bf16(x1a[2], x1a[3]); w.z = cvt_pk_bf16(x1b[0], x1b[1]); w.w = cvt_pk_bf16(x1b[2], x1b[3]); *(u32x4*)rowp = w;
                    w.x = cvt_pk_bf16(x2a[0], x2a[1]); w.y = cvt_pk_bf16(x2a[2], x2a[3]); w.z = cvt_pk_bf16(x2b[0], x2b[1]); w.w = cvt_pk_bf16(x2b[2], x2b[3]); *(u32x4*)(rowp + 64) = w; }
        } else {
            const int col0 = pn * BM + wc * 32 + 8 * fq;
#pragma unroll
            for (int ai = 0; ai < 2; ++ai)
#pragma unroll
                for (int m = 0; m < 4; ++m) { const int r = row0 + ai * HALF + m * 16; bf16_t* rowp = O + (size_t)r * ldo + col0; const float rs = rrow[r];
#pragma unroll
                    for (int bj = 0; bj < 2; ++bj) { const f32x4 v0 = acc[ai][bj][m][0] * rs + bb[bj][0], v1 = acc[ai][bj][m][1] * rs + bb[bj][1]; u32x4 w;
                        w.x = cvt_pk_bf16(v0[0], v0[1]); w.y = cvt_pk_bf16(v0[2], v0[3]); w.z = cvt_pk_bf16(v1[0], v1[1]); w.w = cvt_pk_bf16(v1[2], v1[3]); *(u32x4*)(rowp + bj * HALF) = w; } }
        }
    }
};

struct EpiDelta {
    static constexpr bool PERM = true, AFTER_DRAIN = false;
    bf16_t* O; const float* coef; bf16_t* slabs; int t0, ntl, nfull, xi32;
    __device__ __forceinline__ void operator()(const f32x4 (&acc)[2][2][4][2], const Unit& u, int wr, int wc, int fr, int fq) const {
        const int rowt = u.pm * BM; const int grp = rowt >= 8192 ? 1 + ((rowt - 8192) >> 12) : 0;
        const int col0 = u.pn * BM + wc * 32 + 8 * fq, rl0 = wr * 64 + fr;
        bf16_t* tb; int ld;
        if (u.kh == 1) { tb = slabs + (size_t)(xi32 + u.pn * ntl + (u.pm - t0) - nfull) * 65536 + wc * 32 + 8 * fq; ld = 256; }
        else { tb = O + (size_t)rowt * 1024 + col0; ld = 1024; }
#pragma unroll
        for (int bj = 0; bj < 2; ++bj) {
            const f32x4 c0 = *(const f32x4*)(coef + (size_t)grp * 9216 + col0 + bj * HALF) * 0.5f, c1 = *(const f32x4*)(coef + (size_t)grp * 9216 + col0 + bj * HALF + 4) * 0.5f;
#pragma unroll
            for (int ai = 0; ai < 2; ++ai)
#pragma unroll
                for (int m = 0; m < 4; ++m) { const f32x4 v0 = acc[ai][bj][m][0] * c0, v1 = acc[ai][bj][m][1] * c1; u32x4 w;
                    w.x = cvt_pk_bf16(v0[0], v0[1]); w.y = cvt_pk_bf16(v0[2], v0[3]); w.z = cvt_pk_bf16(v1[0], v1[1]); w.w = cvt_pk_bf16(v1[2], v1[3]);
                    *(u32x4*)(tb + (size_t)(rl0 + ai * HALF + m * 16) * ld + bj * HALF) = w; }
        }
    }
};
struct SegOrder {
    int t0, ntl, nN, nloc, rank, nfull, seg;
    __device__ void init(int t0_, int t1_, int N, int nloc_, int rank_, int nfull_, int seg_) { t0 = t0_; ntl = t1_ - t0_; nN = N / BM; nloc = nloc_; rank = rank_; nfull = nfull_; seg = seg_; }
    __device__ bool next(int i, Unit& u) const { int L = i * nloc + rank; u.kh = 0;
        if (seg == 0) { if (L >= nfull) return false; }
        else { if (L >= 2 * (ntl * nN - nfull)) return false; u.kh = L & 1; L = nfull + (L >> 1); }
        u.pm = t0 + L % ntl; u.pn = L / ntl; return true; }
    __device__ __forceinline__ void a_ready(const Unit&) const {}
    __device__ __forceinline__ void done(const Unit&) const {}
};


struct AffOrder {
    int t0, ntl, nN, nloc, rank, split;
    __device__ void init(int t0_, int t1_, int N, int nloc_, int rank_, int split_ = 0) { t0 = t0_; ntl = t1_ - t0_; nN = N / BM; nloc = nloc_; rank = rank_; split = split_; }
    __device__ bool next(int i, Unit& u) const { int L = i * nloc + rank; const int nt_ = ntl * nN; if (L >= (split ? 2 * nt_ : nt_)) return false; u.kh = 0; if (L >= nt_) { L -= nt_; u.kh = 1; } u.pm = t0 + L % ntl; u.pn = L / ntl; return true; }
    __device__ __forceinline__ void a_ready(const Unit&) const {}
    __device__ __forceinline__ void done(const Unit&) const {}
};

template <class Epi, class Sched, bool ALIGN_EPI = false, bool SP2 = false>
__device__ __forceinline__ void gemm_phase(PG8_LAS unsigned char* lds, const Gemm g, const Sched& S, const Epi& E) {
    int tid_ = threadIdx.x; asm volatile("" : "+v"(tid_));
    const int tid = tid_, wid = __builtin_amdgcn_readfirstlane(tid >> 6), lane = tid & 63, wr = wid >> 2, wc = wid & 3, fr = lane & 15, fq = lane >> 4;
    const int K = g.K, nt = g.Kh / BK; const size_t khb = (size_t)g.Kh * 2;
    unsigned voffA[2], voffB[2];
#pragma unroll
    for (int i = 0; i < 2; ++i) { int R, C; stage_rc(tid * 16 + i * 8192, R, C); const int Rb = Epi::PERM ? ((R & ~31) + perm32(R & 31)) : R;
        voffA[i] = (unsigned)(R * g.lda + C) * 2u; voffB[i] = (unsigned)(Rb * K + C) * 2u; }
    const size_t kstep = (size_t)(BK * 2);
    const size_t hstep = (size_t)HALF * K * 2;
    const size_t tstep = 2 * hstep; const size_t hstepA = (size_t)HALF * g.lda * 2, tstepA = 2 * hstepA;
    const unsigned ldsw = (unsigned)wid * 1024u;
    const int aoff = lds_byte(wr * 64 + fr, fq * 8), boff = lds_byte(wc * 32 + fr, fq * 8);
#define PG8_SA(b, h) (((b) * 2 + (h)) * HTB)
#define PG8_SB(b, h) ((4 + (b) * 2 + (h)) * HTB)
#define PG8_STAGE(bufoff, gbase, voff) do { _Pragma("unroll") for (int _i = 0; _i < 2; ++_i) \
        __builtin_amdgcn_global_load_lds((const unsigned*)((const char*)(gbase) + (voff)[_i]), (PG8_LAS unsigned*)(lds + (bufoff) + ldsw + _i * 8192), 16, 0, 0); } while (0)
#define PG8_LDA(dst, b, h) do { _Pragma("unroll") for (int m = 0; m < 4; ++m) _Pragma("unroll") for (int k = 0; k < 2; ++k) dst[m][k] = *(const PG8_LAS bf16x8*)(lds + PG8_SA(b, h) + aoff + m * 2048 + k * 1024); } while (0)
#define PG8_LDB(dst, b, h) do { _Pragma("unroll") for (int n = 0; n < 2; ++n) _Pragma("unroll") for (int k = 0; k < 2; ++k) dst[n][k] = *(const PG8_LAS bf16x8*)(lds + PG8_SB(b, h) + boff + n * 2048 + k * 1024); } while (0)
#define PG8_MMA(ai, bj, At, Bt) do { __builtin_amdgcn_s_setprio(1); _Pragma("unroll") for (int m = 0; m < 4; ++m) _Pragma("unroll") for (int n = 0; n < 2; ++n) _Pragma("unroll") for (int k = 0; k < 2; ++k) \
        acc[ai][bj][m][n] = __builtin_amdgcn_mfma_f32_16x16x32_bf16(Bt[n][k], At[m][k], acc[ai][bj][m][n], 0, 0, 0); __builtin_amdgcn_s_setprio(0); } while (0)
#define PG8_WAIT_V(n) asm volatile("s_waitcnt vmcnt(" #n ")" ::: "memory")
#define PG8_WAIT_L(n) asm volatile("s_waitcnt lgkmcnt(" #n ")" ::: "memory")
#define PG8_BAR __builtin_amdgcn_s_barrier()
#define PG8_SCHED __builtin_amdgcn_sched_barrier(0)
    Unit cur, nxt; int ui = 0;
    if (!S.next(0, cur)) return;
    f32x4 acc[2][2][4][2];
#pragma unroll
    for (int a = 0; a < 2; ++a)
#pragma unroll
        for (int b = 0; b < 2; ++b)
#pragma unroll
            for (int m = 0; m < 4; ++m)
#pragma unroll
                for (int n = 0; n < 2; ++n) acc[a][b][m][n] = (f32x4){0.f, 0.f, 0.f, 0.f};
    bf16x8 At[4][2], B0[2][2], B1[2][2];
    const char* cA = (const char*)g.A + (size_t)cur.pm * tstepA + (size_t)cur.kh * khb; const char* cB = (const char*)g.Bt + (size_t)cur.pn * tstep + (size_t)cur.kh * khb;
    S.a_ready(cur);
    if constexpr (SP2) {
        PG8_STAGE(PG8_SB(0, 0), cB, voffB); PG8_STAGE(PG8_SB(0, 1), cB + hstep, voffB); PG8_STAGE(PG8_SA(0, 0), cA, voffA); PG8_STAGE(PG8_SA(0, 1), cA + hstepA, voffA);
        if (wr == 1) PG8_BAR;
        PG8_WAIT_V(2); PG8_BAR;
        PG8_STAGE(PG8_SB(1, 0), cB + kstep, voffB); PG8_STAGE(PG8_SA(1, 0), cA + kstep, voffA); PG8_STAGE(PG8_SB(1, 1), cB + hstep + kstep, voffB);
        PG8_WAIT_V(6); PG8_BAR;
    } else {
        PG8_STAGE(PG8_SB(0, 0), cB, voffB); PG8_STAGE(PG8_SA(0, 0), cA, voffA); PG8_STAGE(PG8_SB(0, 1), cB + hstep, voffB); PG8_STAGE(PG8_SA(0, 1), cA + hstepA, voffA);
        if (wr == 1) PG8_BAR;
        PG8_WAIT_V(4); PG8_BAR;
        PG8_STAGE(PG8_SB(1, 0), cB + kstep, voffB); PG8_STAGE(PG8_SA(1, 0), cA + kstep, voffA); PG8_STAGE(PG8_SB(1, 1), cB + hstep + kstep, voffB);
        PG8_WAIT_V(6); PG8_BAR;
    }
    for (;;) {
        const bool has_next = S.next(ui + 1, nxt);
        const char* nA = has_next ? (const char*)g.A + (size_t)nxt.pm * tstepA + (size_t)nxt.kh * khb : cA; const char* nB = has_next ? (const char*)g.Bt + (size_t)nxt.pn * tstep + (size_t)nxt.kh * khb : cB;
        for (int t = 0; t < nt; t += 2) {
            const bool last = (t == nt - 2);
            const char* a1 = cA + (size_t)(t + 1) * kstep;
            const char* a2 = last ? nA : cA + (size_t)(t + 2) * kstep; const char* b2 = last ? nB : cB + (size_t)(t + 2) * kstep;
            const char* a3 = a2 + kstep; const char* b3 = b2 + kstep;
            if (last && has_next) S.a_ready(nxt);
            if constexpr (SP2) {
            PG8_LDB(B0, 0, 0); PG8_LDB(B1, 0, 1); PG8_SCHED; PG8_LDA(At, 0, 0); PG8_STAGE(PG8_SA(1, 1), a1 + hstepA, voffA);
            PG8_WAIT_V(8); PG8_WAIT_L(0); PG8_BAR; PG8_MMA(0, 0, At, B0); PG8_MMA(0, 1, At, B1); PG8_BAR; PG8_SCHED;
            PG8_LDA(At, 0, 1); PG8_STAGE(PG8_SB(0, 0), b2, voffB); PG8_STAGE(PG8_SB(0, 1), b2 + hstep, voffB); PG8_STAGE(PG8_SA(0, 0), a2, voffA);
            PG8_WAIT_V(8); PG8_WAIT_L(0); PG8_BAR; PG8_MMA(1, 0, At, B0); PG8_MMA(1, 1, At, B1); PG8_BAR; PG8_SCHED;
            PG8_LDB(B0, 1, 0); PG8_LDB(B1, 1, 1); PG8_SCHED; PG8_LDA(At, 1, 0); PG8_STAGE(PG8_SA(0, 1), a2 + hstepA, voffA);
            PG8_WAIT_V(8); PG8_WAIT_L(0); PG8_BAR; PG8_MMA(0, 0, At, B0); PG8_MMA(0, 1, At, B1); PG8_BAR; PG8_SCHED;
            PG8_LDA(At, 1, 1); PG8_STAGE(PG8_SB(1, 0), b3, voffB); PG8_STAGE(PG8_SB(1, 1), b3 + hstep, voffB); PG8_STAGE(PG8_SA(1, 0), a3, voffA);
            PG8_WAIT_V(8); PG8_WAIT_L(0); PG8_BAR; PG8_MMA(1, 0, At, B0); PG8_MMA(1, 1, At, B1); PG8_BAR; PG8_SCHED;
            } else {
            PG8_LDB(B0, 0, 0); PG8_SCHED; PG8_LDA(At, 0, 0); PG8_STAGE(PG8_SA(1, 1), a1 + hstepA, voffA);
            PG8_WAIT_L(8); PG8_BAR; PG8_WAIT_L(0); PG8_MMA(0, 0, At, B0); PG8_BAR; PG8_SCHED;
            PG8_LDB(B1, 0, 1); PG8_STAGE(PG8_SB(0, 0), b2, voffB);
            PG8_BAR; PG8_WAIT_L(0); PG8_MMA(0, 1, At, B1); PG8_BAR;
            PG8_LDA(At, 0, 1); PG8_STAGE(PG8_SA(0, 0), a2, voffA);
            PG8_BAR; PG8_WAIT_L(0); PG8_MMA(1, 0, At, B0); PG8_BAR; PG8_SCHED;
            PG8_STAGE(PG8_SB(0, 1), b2 + hstep, voffB);
            PG8_WAIT_V(6); PG8_BAR; PG8_MMA(1, 1, At, B1); PG8_BAR;
            PG8_LDB(B0, 1, 0); PG8_SCHED; PG8_LDA(At, 1, 0); PG8_STAGE(PG8_SA(0, 1), a2 + hstepA, voffA);
            PG8_WAIT_L(8); PG8_BAR; PG8_WAIT_L(0); PG8_MMA(0, 0, At, B0); PG8_BAR; PG8_SCHED;
            PG8_LDB(B1, 1, 1); PG8_STAGE(PG8_SB(1, 0), b3, voffB);
            PG8_BAR; PG8_WAIT_L(0); PG8_MMA(0, 1, At, B1); PG8_BAR;
            PG8_LDA(At, 1, 1); PG8_STAGE(PG8_SA(1, 0), a3, voffA);
            PG8_BAR; PG8_WAIT_L(0); PG8_MMA(1, 0, At, B0); PG8_BAR; PG8_SCHED;
            PG8_STAGE(PG8_SB(1, 1), b3 + hstep, voffB);
            PG8_WAIT_V(6); PG8_BAR; PG8_MMA(1, 1, At, B1); PG8_BAR;
            }
        }
        if constexpr (ALIGN_EPI) { if (wr == 0) PG8_BAR; }
        if constexpr (!Epi::AFTER_DRAIN) { E(acc, cur, wr, wc, fr, fq); S.done(cur); }
        if (!has_next) break;
#pragma unroll
        for (int a = 0; a < 2; ++a)
#pragma unroll
            for (int b = 0; b < 2; ++b)
#pragma unroll
                for (int m = 0; m < 4; ++m)
#pragma unroll
                    for (int n = 0; n < 2; ++n) acc[a][b][m][n] = (f32x4){0.f, 0.f, 0.f, 0.f};
        cur = nxt; cA = nA; cB = nB; ++ui;
        if constexpr (ALIGN_EPI) { if (wr == 1) PG8_BAR; }
    }
    PG8_WAIT_V(0);
    if constexpr (!ALIGN_EPI) { if (wr == 0) PG8_BAR; }
    PG8_BAR;
    if constexpr (Epi::AFTER_DRAIN) { E.fused(acc, cur, wr, wc, fr, fq, lds, wid, lane); S.done(cur); }
#undef PG8_SA
#undef PG8_SB
#undef PG8_STAGE
#undef PG8_LDA
#undef PG8_LDB
#undef PG8_MMA
#undef PG8_WAIT_V
#undef PG8_WAIT_L
#undef PG8_BAR
#undef PG8_SCHED
}
}
#define GAS __attribute__((address_space(1)))
#define LAS __attribute__((address_space(3)))
typedef unsigned short bf16;
typedef unsigned v4u __attribute__((ext_vector_type(4)));
typedef float f32x4 __attribute__((ext_vector_type(4)));
typedef short bf16x8 __attribute__((ext_vector_type(8)));
typedef GAS unsigned gu32;
typedef GAS unsigned long long gu64;
#define RLX_AGENT __ATOMIC_RELAXED, __HIP_MEMORY_SCOPE_AGENT
#define LDS_WAIT() asm volatile("s_waitcnt lgkmcnt(0)" ::: "memory")
#define VM_WAIT() asm volatile("s_waitcnt vmcnt(0)" ::: "memory")
__device__ __forceinline__ unsigned long long rt() { return __builtin_amdgcn_s_memrealtime(); }
__device__ __forceinline__ unsigned f2bf(float f) { unsigned u = __builtin_bit_cast(unsigned, f); return (u + 0x7fffu + ((u >> 16) & 1u)) >> 16; }
__device__ __forceinline__ unsigned pk2(float lo, float hi) { return f2bf(lo) | (f2bf(hi) << 16); }

#define XB_TMO      128
#define XB_XCNT(j)  (256  + 64 * (j))
#define XB_XSUB(j)  (1280 + 64 * (j))
#define XB_XGEN(j)  (2304 + 64 * (j))
#define XB_TOP      3328
#define XB_TOPGEN   3392
#define XCD_BAR_WORDS 3456
#define XB_SPIN_CAP (1u << 18)

__device__ __forceinline__ unsigned xb_ld(unsigned* p)              { return __hip_atomic_load(p, __ATOMIC_RELAXED, __HIP_MEMORY_SCOPE_AGENT); }
__device__ __forceinline__ unsigned xb_add(unsigned* p, unsigned v) { return __hip_atomic_fetch_add(p, v, __ATOMIC_RELAXED, __HIP_MEMORY_SCOPE_AGENT); }
__device__ __forceinline__ unsigned xb_xcc_id() { return (unsigned)__builtin_amdgcn_s_getreg((3 << 11) | 20) & 0xFu; }
#define XB_SPIN(cond, bar) do { unsigned _sp = 0; while (cond) { __builtin_amdgcn_s_sleep(1); \
    if ((++_sp & 255u) == 0u) { if (xb_ld(&(bar)[XB_TMO])) break; if (_sp > XB_SPIN_CAP) { atomicAdd(&(bar)[XB_TMO], 1u); break; } } } } while (0)

struct XcdBarrier {
    unsigned* bar; unsigned x;
    volatile LAS unsigned* st;
};

__device__ __forceinline__ XcdBarrier xcd_barrier_post(unsigned* bar, volatile LAS unsigned* st) {
    XcdBarrier b; b.bar = bar; b.x = xb_xcc_id(); b.st = st;
    if (threadIdx.x == 0) (void)xb_add(&bar[XB_XCNT(b.x)], 1u);
    return b;
}
__device__ __forceinline__ void xcd_barrier_complete(unsigned* bar, unsigned x, unsigned& nloc, unsigned& nx) {
    const unsigned G = gridDim.x * gridDim.y * gridDim.z;
    unsigned sum, cnt, mine, sp = 0u;
    for (;;) {
        sum = 0u; cnt = 0u; mine = 0u;
#pragma unroll
        for (unsigned j = 0; j < 16; ++j) { const unsigned c = xb_ld(&bar[XB_XCNT(j)]); sum += c; cnt += (c > 0u) ? 1u : 0u; mine = (j == x) ? c : mine; }
        if (sum == G) break;
        __builtin_amdgcn_s_sleep(1);
        if ((++sp & 255u) == 0u) { if (xb_ld(&bar[XB_TMO])) break; if (sp > XB_SPIN_CAP) { atomicAdd(&bar[XB_TMO], 1u); break; } }
    }
    nloc = mine > 0u ? mine : 1u; nx = cnt > 0u ? cnt : 1u;
}

__device__ __forceinline__ void xcd_barrier(const XcdBarrier& b) {
    asm volatile("s_waitcnt vmcnt(0)" ::: "memory");
    __syncthreads();
    if (threadIdx.x == 0) {
        unsigned* bar = b.bar;
        __builtin_amdgcn_s_waitcnt(0);
        unsigned nloc = b.st[0], nx = b.st[1];
        if (nloc == 0u) { xcd_barrier_complete(bar, b.x, nloc, nx); b.st[0] = nloc; b.st[1] = nx; }
        const unsigned old = xb_add(&bar[XB_XSUB(b.x)], 1u);
        const unsigned gen = old / nloc;
        if (old + 1u == (gen + 1u) * nloc) {
            __builtin_amdgcn_fence(__ATOMIC_RELEASE, "agent");
            asm volatile("s_waitcnt vmcnt(0)" ::: "memory");
            const unsigned og = xb_add(&bar[XB_TOP], 1u);
            const unsigned tg = og / nx;
            if (og + 1u == (tg + 1u) * nx) xb_add(&bar[XB_TOPGEN], 1u);
            else XB_SPIN(xb_ld(&bar[XB_TOPGEN]) == tg, bar);
            __builtin_amdgcn_fence(__ATOMIC_ACQUIRE, "agent");
            xb_add(&bar[XB_XGEN(b.x)], 1u);
            asm volatile("s_waitcnt vmcnt(0)" ::: "memory");
        } else {
            XB_SPIN(xb_ld(&bar[XB_XGEN(b.x)]) == gen, bar);
            __builtin_amdgcn_fence(__ATOMIC_ACQUIRE, "agent");
            asm volatile("s_waitcnt vmcnt(0)" ::: "memory");
        }
    }
    __syncthreads();
}

constexpr int NWAVES = 8, NTHR = 512;
constexpr int D = 1024, MCTX = 8192, MLAT = 16384, M = MCTX + MLAT, FF = 2816, NUP = 2 * FF, NIN = 2560, NMOD = 9 * D;
constexpr int LDQ = FF;
constexpr int NITEM = (M / 128) * 4;
constexpr float EPS = 1e-6f;
constexpr size_t MiB = 1u << 20;
constexpr size_t WS_CTL = 0, CTL_ZERO_BYTES = 65536;
constexpr size_t WS_MODS = 65536, WS_ROTC = 262144, WS_ROTS = 262144 + 8192;
constexpr size_t WS_BIASQ = 288 * 1024, WS_BIAS3 = 352 * 1024, WS_RROW = 512 * 1024;
constexpr size_t WS_SSPA = 42 * MiB + 262144, WS_SSPB = 255 * MiB;
constexpr size_t WS_W13A = 1 * MiB, WS_W13B = 12 * MiB, WS_W2A = 23 * MiB, WS_W2B = 29 * MiB, WS_WIN = 35 * MiB, WS_WOUT = 40 * MiB, WS_POOLW = 42 * MiB;
constexpr size_t WS_ABUF = 43 * MiB;
constexpr size_t WS_HBUF = 91 * MiB;
constexpr size_t WS_SLAT = 223 * MiB;
constexpr size_t WS_END = 255 * MiB;
constexpr int CW_BAR = 4096, CW_RANK = 8192, CW_LBAR = 10240, CW_SPLIT = 12288;
constexpr int LDS_BYTES = 147456, MISC_OFF = LDS_BYTES - 256;
constexpr int OUT_SF = M * D, OUT_SB = M * D + 32 * 4 * 128 * 128;
constexpr int RS = 272;

__device__ __forceinline__ float wave_sum(float v) {
#pragma unroll
    for (int o = 1; o < 64; o <<= 1) v += __shfl_xor(v, o);
    return v;
}
__device__ __forceinline__ unsigned cvtpk(float lo, float hi) { return pg8::cvt_pk_bf16(lo, hi); }
__device__ __forceinline__ float bflo(unsigned w) { return __uint_as_float(w << 16); }
__device__ __forceinline__ float bfhi(unsigned w) { return __uint_as_float(w & 0xffff0000u); }
#define EX2(x) __builtin_amdgcn_exp2f(x)
__device__ __forceinline__ v4u ld16_sc1(const void* p) {
    const unsigned long long a = __hip_atomic_load((const unsigned long long*)p, __ATOMIC_RELAXED, __HIP_MEMORY_SCOPE_AGENT), b = __hip_atomic_load((const unsigned long long*)p + 1, __ATOMIC_RELAXED, __HIP_MEMORY_SCOPE_AGENT);
    return (v4u){(unsigned)a, (unsigned)(a >> 32), (unsigned)b, (unsigned)(b >> 32)};
}
#define MFMA16(x, y, c) __builtin_amdgcn_mfma_f32_16x16x32_bf16((x), (y), (c), 0, 0, 0)

#define LANE_VARS int tid_o_ = threadIdx.x; asm volatile("" : "+v"(tid_o_)); const int tid = tid_o_, lane = tid & 63, fr = lane & 15, fq = lane >> 4; (void)fr; (void)fq
struct Args { const float* in[25]; float* out; unsigned char* ws; };

__device__ __forceinline__ void p0_transpose_item(const float* W, int K, int N, bf16* WT, int dst_row0, LAS float* scr, int k0, int n0, int lane) {
#pragma unroll 8
    for (int i = 0; i < 32; ++i) { const int kk = 2 * i + (lane >> 5); scr[kk * 33 + (lane & 31)] = W[(size_t)(k0 + kk) * N + n0 + (lane & 31)]; }
    LDS_WAIT(); asm volatile("" ::: "memory");
    const int c = lane & 7;
#pragma unroll
    for (int j = 0; j < 4; ++j) { const int n = (lane >> 3) + 8 * j; const LAS float* s = scr + (8 * c) * 33 + n;
        v4u o; o.x = pk2(s[0 * 33], s[1 * 33]); o.y = pk2(s[2 * 33], s[3 * 33]); o.z = pk2(s[4 * 33], s[5 * 33]); o.w = pk2(s[6 * 33], s[7 * 33]);
        *(GAS v4u*)(WT + (size_t)(dst_row0 + n) * K + k0 + 8 * c) = o; }
    LDS_WAIT(); asm volatile("" ::: "memory");
}
__device__ __forceinline__ int map_in(int c) {
    if (c < 1024) { const int base = c < 512 ? 0 : 1024, cc = c & 511, h = cc >> 7, d = cc & 127; return base + 256 * (h >> 1) + 128 * (d >> 6) + 64 * (h & 1) + (d & 63); }
    if (c < 1536) return 1536 + (c - 1024);
    if (c < 2048) return 512 + (c - 1536);
    return c;
}

template <bool FINAL>
__device__ __forceinline__ void norm_rows(const float* src0, const float* src1, const float* gamma, const float* mods, int sh_off, int sc_off, bf16* A, float* outF, int row_lo, int row_hi, int lw, int NLW, int lane) {
    for (int row = row_lo + lw; row < row_hi; row += NLW) {
        const bool lat = row >= MCTX; const int grp = lat ? 1 + ((row - MCTX) >> 12) : 0;
        const f32x4* xr = (const f32x4*)((lat ? src1 + (size_t)(row - MCTX) * D : src0 + (size_t)row * D)) + lane;
        f32x4 v[4]; float s = 0.f;
#pragma unroll
        for (int j = 0; j < 4; ++j) { v[j] = xr[64 * j]; s += (v[j].x * v[j].x + v[j].y * v[j].y) + (v[j].z * v[j].z + v[j].w * v[j].w); }
        const float r = 1.0f / sqrtf(wave_sum(s) * (1.f / D) + EPS);
#pragma unroll
        for (int j = 0; j < 4; ++j) { const int col = 4 * (lane + 64 * j); const f32x4 g = *(const f32x4*)(gamma + col);
            if (FINAL) { *(f32x4*)(outF + (size_t)row * D + col) = v[j] * r * g; }
            else { const f32x4 sc = *(const f32x4*)(mods + (size_t)grp * NMOD + sc_off + col), sh = *(const f32x4*)(mods + (size_t)grp * NMOD + sh_off + col);
                const f32x4 a = (v[j] * r * g) * (sc + 1.0f) + sh;
                *(unsigned long long*)(A + (size_t)row * D + col) = (unsigned long long)cvtpk(a.x, a.y) | ((unsigned long long)cvtpk(a.z, a.w) << 32); } }
    }
}

__device__ __forceinline__ void final_rows(float* out, const bf16* d3, const bf16* slabs, int t0, int ntl, int nfull, int xi32, const float* gamma, int row_lo, int row_hi, int lw, int NLW, int lane) {
    for (int row = row_lo + lw; row < row_hi; row += NLW) {
        f32x4* xr = (f32x4*)(out + (size_t)row * D) + lane; const unsigned long long* hr = (const unsigned long long*)(out + (size_t)row * D) + lane;
        const unsigned long long* dr = (const unsigned long long*)(d3 + (size_t)row * D) + lane;
        const int pml = (row >> 8) - t0, rl = row & 255;
        f32x4 v[4]; unsigned long long dv[4], sv[4]; float s = 0.f;
#pragma unroll
        for (int j = 0; j < 4; ++j) { { const unsigned long long hw = hr[64 * j]; const unsigned lo = (unsigned)hw, hi = (unsigned)(hw >> 32); v[j] = (f32x4){bflo(lo), bfhi(lo), bflo(hi), bfhi(hi)}; } dv[j] = dr[64 * j]; const int L = j * ntl + pml; sv[j] = 0ull;
            if (L >= nfull) sv[j] = *((const unsigned long long*)(slabs + (size_t)(xi32 + L - nfull) * 65536 + rl * 256) + lane); }
#pragma unroll
        for (int j = 0; j < 4; ++j) { const unsigned lo = (unsigned)dv[j], hi = (unsigned)(dv[j] >> 32), lo2 = (unsigned)sv[j], hi2 = (unsigned)(sv[j] >> 32);
            v[j] = v[j] + ((f32x4){bflo(lo), bfhi(lo), bflo(hi), bfhi(hi)} + (f32x4){bflo(lo2), bfhi(lo2), bflo(hi2), bfhi(hi2)});
            s += (v[j].x * v[j].x + v[j].y * v[j].y) + (v[j].z * v[j].z + v[j].w * v[j].w); }
        const float r = 1.0f / sqrtf(wave_sum(s) * (1.f / D) + EPS);
#pragma unroll
        for (int j = 0; j < 4; ++j) { const f32x4 g = *(const f32x4*)(gamma + 4 * (lane + 64 * j)); xr[64 * j] = v[j] * r * g; }
    }
}

__device__ __forceinline__ void stage_nat(LAS unsigned char* dst, const bf16* src, int ld, int tid) {
#pragma unroll
    for (int i = 0; i < 4; ++i) { const int c = tid + NTHR * i, row = c >> 4, cc = c & 15; *(LAS v4u*)(dst + row * RS + cc * 16) = *(const v4u*)(src + (size_t)row * ld + cc * 8); }
}


__device__ __forceinline__ void stage_zero(LAS unsigned char* dst, int tid) {
#pragma unroll
    for (int i = 0; i < 4; ++i) { const int c = tid + NTHR * i, row = c >> 4, cc = c & 15; *(LAS v4u*)(dst + row * RS + cc * 16) = (v4u){0u, 0u, 0u, 0u}; }
}


__device__ __forceinline__ void xcc_barrier(unsigned* lw, unsigned nloc, unsigned* tmo) {
    asm volatile("s_waitcnt vmcnt(0)" ::: "memory");
    __syncthreads();
    if (threadIdx.x == 0) {
        const unsigned old = xb_add(lw, 1u), gen = old / nloc;
        if (old + 1u == (gen + 1u) * nloc) xb_add(lw + 64, 1u);
        else XB_SPIN(xb_ld(lw + 64) == gen, tmo);
        __builtin_amdgcn_fence(__ATOMIC_ACQUIRE, "agent");
        asm volatile("s_waitcnt vmcnt(0)" ::: "memory");
    }
    __syncthreads();
}

__global__ void __launch_bounds__(NTHR, 2) hyb_fwd(Args args) {
    extern __shared__ __attribute__((aligned(16))) unsigned char lds_raw[];
    LAS unsigned char* lds = (LAS unsigned char*)lds_raw;
    volatile LAS unsigned* MISC = (volatile LAS unsigned*)(lds + MISC_OFF);
    const int tid = threadIdx.x, lane = tid & 63, wave = __builtin_amdgcn_readfirstlane(tid >> 6), fr = lane & 15, fq = lane >> 4;
    const int G = gridDim.x, bx = blockIdx.x;
    const int gw = bx * NWAVES + wave, NGW = G * NWAVES;
    unsigned char* ws = args.ws;
    if (tid < 64) MISC[tid] = 0u;
    __syncthreads();
    XcdBarrier bar = xcd_barrier_post((unsigned*)(ws + WS_CTL) + CW_BAR, MISC + 8);
    if (tid == 0) MISC[16] = __hip_atomic_fetch_add((unsigned*)(ws + WS_CTL) + CW_RANK + 64 * bar.x, 1u, __ATOMIC_RELAXED, __HIP_MEMORY_SCOPE_AGENT);

    const float* x_ctx = args.in[0]; const float* x_lat = args.in[1];
    float* mods = (float*)(ws + WS_MODS); float* rotc = (float*)(ws + WS_ROTC); float* rots = (float*)(ws + WS_ROTS);
    bf16* W13A = (bf16*)(ws + WS_W13A); bf16* W13B = (bf16*)(ws + WS_W13B); bf16* W2A = (bf16*)(ws + WS_W2A); bf16* W2B = (bf16*)(ws + WS_W2B);
    bf16* WIN = (bf16*)(ws + WS_WIN); bf16* WOUT = (bf16*)(ws + WS_WOUT); bf16* POOLW = (bf16*)(ws + WS_POOLW);
    bf16* ABUF = (bf16*)(ws + WS_ABUF); bf16* HBUF = (bf16*)(ws + WS_HBUF); bf16* SBUF = ABUF; bf16* QKV = HBUF; bf16* SLAT = (bf16*)(ws + WS_SLAT);
    float* out = args.out;
    float* biasq = (float*)(ws + WS_BIASQ); float* bias3 = (float*)(ws + WS_BIAS3); float* rrow = (float*)(ws + WS_RROW); float* sspa = (float*)(ws + WS_SSPA); float* sspb = (float*)(ws + WS_SSPB);

    {
        LANE_VARS;
        LAS float* scr = (LAS float*)(lds + wave * 16384);
        constexpr int I_W1 = 16 * 88, I_W2 = 44 * 32, I_IN = 16 * 80, I_OUT = 16 * 32, I_POOL = 32;
        constexpr int NITEMS = 4 * I_W1 + 2 * I_W2 + I_IN + I_OUT + I_POOL;
        for (int it = gw; it < NITEMS; it += NGW) {
            int r = it;
            if (r < 4 * I_W1) { const int which = r / I_W1; r -= which * I_W1; const int kb = r / 88, nb = r % 88, n0 = 32 * nb;
                const float* src = args.in[which == 0 ? 9 : which == 1 ? 10 : which == 2 ? 21 : 22]; bf16* dst = which < 2 ? W13A : W13B;
                p0_transpose_item(src, D, FF, dst, 256 * (n0 >> 7) + 128 * (which & 1) + (n0 & 127), scr, 64 * kb, n0, lane); continue; }
            r -= 4 * I_W1;
            if (r < 2 * I_W2) { const int which = r / I_W2; r -= which * I_W2; const int kb = r / 32, nb = r % 32;
                p0_transpose_item(args.in[which ? 23 : 11], FF, D, which ? W2B : W2A, 32 * nb, scr, 64 * kb, 32 * nb, lane); continue; }
            r -= 2 * I_W2;
            if (r < I_IN) { const int kb = r / 80, nb = r % 80; p0_transpose_item(args.in[13], D, NIN, WIN, map_in(32 * nb), scr, 64 * kb, 32 * nb, lane); continue; }
            r -= I_IN;
            if (r < I_OUT) { const int kb = r / 32, nb = r % 32; p0_transpose_item(args.in[19], D, D, WOUT, 32 * nb, scr, 64 * kb, 32 * nb, lane); continue; }
            r -= I_OUT;
            { const int g = r >> 3, kb = (r >> 2) & 1, nb = r & 3; p0_transpose_item(args.in[17] + g * 16384, 128, 128, POOLW + g * 16384, 32 * nb, scr, 64 * kb, 32 * nb, lane); }
        }
        for (int i = bx * NTHR + tid; i < 2 * 2097152 / 4; i += G * NTHR) *(f32x4*)(out + OUT_SF + 4 * i) = (f32x4){0.f, 0.f, 0.f, 0.f};
        { const int gt = bx * NTHR + tid;
          if (gt < 2048) { const int pos = gt >> 5, f = gt & 31; double fr_ = 1.0; for (int i = 0; i < f; ++i) fr_ *= 0.7498942093324559;
              const double a = (double)pos * fr_; const double n = __builtin_rint(a * 0.15915494309189535); const double rr = a - n * 6.283185307179586; const double r2 = rr * rr;
              double cs = 1.0, sn = 1.0;
              for (int k = 13; k >= 1; --k) { cs = 1.0 - cs * r2 / (double)((2 * k - 1) * (2 * k)); sn = 1.0 - sn * r2 / (double)((2 * k) * (2 * k + 1)); }
              rotc[gt] = (float)cs; rots[gt] = (float)(sn * rr); } }
        __syncthreads();
        LAS float* scond = (LAS float*)lds;
        LAS float* red = (LAS float*)(lds + 5 * 1024 * 4);
        for (int i = tid; i < 5 * D; i += NTHR) { const int g = i >> 10, k = i & 1023; const float cv = g == 0 ? args.in[5][k] : args.in[4][(g - 1) * D + k]; scond[i] = cv / (1.0f + expf(-cv)); }
        __syncthreads();
        const float* ada_w = args.in[6]; const float* ada_b = args.in[7];
        for (int it = bx; it < NMOD / 32; it += G) {
            const int c0 = 32 * it, col = lane & 31, kp = lane >> 5; float a0 = 0.f, a1 = 0.f, a2 = 0.f, a3 = 0.f, a4 = 0.f;
#pragma unroll 8
            for (int i = 0; i < 64; ++i) { const int k = 128 * wave + 2 * i + kp; const float wv = ada_w[(size_t)k * NMOD + c0 + col];
                a0 += scond[k] * wv; a1 += scond[1024 + k] * wv; a2 += scond[2048 + k] * wv; a3 += scond[3072 + k] * wv; a4 += scond[4096 + k] * wv; }
            a0 += __shfl_xor(a0, 32); a1 += __shfl_xor(a1, 32); a2 += __shfl_xor(a2, 32); a3 += __shfl_xor(a3, 32); a4 += __shfl_xor(a4, 32);
            if (lane < 32) { LAS float* rp = red + wave * 160 + col; rp[0] = a0; rp[32] = a1; rp[64] = a2; rp[96] = a3; rp[128] = a4; }
            __syncthreads();
            if (tid < 160) { float s = 0.f;
#pragma unroll
                for (int w = 0; w < 8; ++w) s += red[w * 160 + tid];
                const int g = tid >> 5, cc = tid & 31; mods[(size_t)g * NMOD + c0 + cc] = s + ada_b[c0 + cc]; }
            __syncthreads();
        }
    }
    xcd_barrier(bar);

    if (threadIdx.x == 0) { unsigned xi_ = 0, nx_ = 0; unsigned* bw = (unsigned*)(ws + WS_CTL) + CW_BAR;
        for (unsigned j = 0; j < 16; ++j) { const unsigned c = xb_ld(&bw[XB_XCNT(j)]); if (c) { if (j < bar.x) ++xi_; ++nx_; } }
        MISC[17] = xi_; MISC[18] = nx_; MISC[19] = xb_ld(&bw[XB_XCNT(bar.x)]); }
    __syncthreads();
    const int rank = __builtin_amdgcn_readfirstlane((int)MISC[16]), xi = __builtin_amdgcn_readfirstlane((int)MISC[17]), nx = __builtin_amdgcn_readfirstlane((int)MISC[18]), nloc = __builtin_amdgcn_readfirstlane((int)MISC[19]);
    const int t0 = (96 * xi) / nx, t1 = (96 * (xi + 1)) / nx;
    const int lwv = rank * NWAVES + wave, NLW = nloc * NWAVES;
    unsigned* const lbw = (unsigned*)(ws + WS_CTL) + CW_LBAR + 128 * bar.x;
#define LOCAL_BAR() xcc_barrier(lbw, (unsigned)nloc, (unsigned*)(ws + WS_CTL) + CW_BAR)
    const int nitl = (t1 - t0) * 8;

    { LANE_VARS;
    for (int rw = gw; rw < NIN + NUP; rw += NGW) {
        const bool isq = rw < NIN; const int n = isq ? rw : rw - NIN; const bf16* wrow = (isq ? WIN : W13B) + (size_t)n * D + 16 * lane;
        const v4u w0 = *(const v4u*)wrow, w1 = *(const v4u*)(wrow + 8); float wv[16];
#pragma unroll
        for (int q = 0; q < 4; ++q) { wv[2 * q] = bflo(w0[q]); wv[2 * q + 1] = bfhi(w0[q]); wv[8 + 2 * q] = bflo(w1[q]); wv[8 + 2 * q + 1] = bfhi(w1[q]); }
        const float* shp = mods + (isq ? 3072 : 6144) + 16 * lane;
#pragma unroll
        for (int g = 0; g < 5; ++g) { float a = 0.f;
#pragma unroll
            for (int q = 0; q < 4; ++q) { const f32x4 sv = *(const f32x4*)(shp + (size_t)g * NMOD + 4 * q); a += (sv[0] * wv[4 * q] + sv[1] * wv[4 * q + 1]) + (sv[2] * wv[4 * q + 2] + sv[3] * wv[4 * q + 3]); }
            a = wave_sum(a); if (lane == 0) (isq ? biasq + g * NIN : bias3 + g * NUP)[n] = a; }
    }
    norm_rows<false>(x_ctx, x_lat, args.in[8], mods, 0, 1024, ABUF, nullptr, 256 * t0, 256 * t1, lwv, NLW, lane); }
    xcd_barrier(bar);

    { pg8::Gemm g{ABUF, W13A, M, NUP, D, D, D}; pg8::AffOrder S; S.init(t0, t1, NUP, nloc, rank); pg8::EpiSwiglu E{HBUF, FF, nullptr, nullptr};
      pg8::gemm_phase<pg8::EpiSwiglu, pg8::AffOrder, true, true>(lds, g, S, E); }
    LOCAL_BAR();
    { pg8::Gemm g{HBUF, W2A, M, D, FF, FF, FF}; pg8::AffOrder S; S.init(t0, t1, D, nloc, rank, 0); pg8::EpiResid E{x_ctx, x_lat, nullptr, (bf16*)out, mods + 2048, 1, ABUF, args.in[12], mods + 4096, sspa, sspb};
      pg8::gemm_phase<pg8::EpiResid, pg8::AffOrder, true, true>(lds, g, S, E); }
    LOCAL_BAR();
    { int tt_ = threadIdx.x; asm volatile("" : "+v"(tt_));
    for (int r = 256 * t0 + rank * NTHR + tt_; r < 256 * t1; r += nloc * NTHR) { const f32x4 a0 = *(const f32x4*)(sspa + (size_t)r * 8), a1 = *(const f32x4*)(sspa + (size_t)r * 8 + 4), b0 = *(const f32x4*)(sspb + (size_t)r * 8), b1 = *(const f32x4*)(sspb + (size_t)r * 8 + 4);
        const float ssq = (((a0[0] + a0[1]) + (a0[2] + a0[3])) + ((a1[0] + a1[1]) + (a1[2] + a1[3]))) + (((b0[0] + b0[1]) + (b0[2] + b0[3])) + ((b1[0] + b1[1]) + (b1[2] + b1[3])));
        rrow[r] = 1.0f / sqrtf(ssq * (1.f / D) + EPS); } }
    LOCAL_BAR();
    { pg8::Gemm g{ABUF, WIN, M, NIN, D, D, D}; pg8::AffOrder S; S.init(t0, t1, NIN, nloc, rank); pg8::EpiQKV E{QKV, LDQ, rotc, rots, rrow, biasq};
      pg8::gemm_phase<pg8::EpiQKV, pg8::AffOrder, true, true>(lds, g, S, E); }
    LOCAL_BAR();

    {
        LANE_VARS;
        LAS unsigned char* KT = lds; LAS unsigned char* VFT = lds + 128 * RS; LAS unsigned char* VBT = lds + 2 * 128 * RS;
        for (int li = rank; li < nitl; li += nloc) {
            const int item = 8 * t0 + li, cg = item >> 2, h = item & 3, row0 = cg * 128;
            const float l2f = -expf(args.in[14][h]) * 1.4426950408889634f, l2b = -expf(args.in[15][h]) * 1.4426950408889634f;
            const int jp = 16 * (wave & 3) + (lane & 15), j0 = 2 * jp;
            const float wf0 = EX2(l2f * (float)(127 - j0)), wf1 = EX2(l2f * (float)(126 - j0)), wb0 = EX2(l2b * (float)j0), wb1 = EX2(l2b * (float)(j0 + 1));
#pragma unroll
            for (int pass = 0; pass < 2; ++pass) {
                const int c0 = 8 * (4 * (wave >> 2) + (lane >> 4) + 8 * pass);
                const bf16* kr = QKV + (size_t)(row0 + j0) * LDQ + 1024 + h * 128 + c0; const bf16* vr = kr + 512;
                const v4u ka = *(const v4u*)kr, kb = *(const v4u*)(kr + LDQ), va = *(const v4u*)vr, vb = *(const v4u*)(vr + LDQ);
#pragma unroll
                for (int q = 0; q < 4; ++q) {
                    const unsigned a = ka[q], b = kb[q], c = va[q], d = vb[q];
                    const int r0 = (c0 + 2 * q) * RS + jp * 4, r1 = r0 + RS;
                    *(LAS unsigned*)(KT + r0) = (a & 0xffffu) | (b << 16); *(LAS unsigned*)(KT + r1) = (a >> 16) | (b & 0xffff0000u);
                    const float v00 = bflo(c), v01 = bfhi(c), v10 = bflo(d), v11 = bfhi(d);
                    *(LAS unsigned*)(VFT + r0) = cvtpk(v00 * wf0, v10 * wf1); *(LAS unsigned*)(VFT + r1) = cvtpk(v01 * wf0, v11 * wf1);
                    *(LAS unsigned*)(VBT + r0) = cvtpk(v00 * wb0, v10 * wb1); *(LAS unsigned*)(VBT + r1) = cvtpk(v01 * wb0, v11 * wb1);
                }
            }
            __syncthreads();
            f32x4 af[8], ab[8];
#pragma unroll
            for (int dt = 0; dt < 8; ++dt) { af[dt] = (f32x4){0.f, 0.f, 0.f, 0.f}; ab[dt] = (f32x4){0.f, 0.f, 0.f, 0.f}; }
#pragma unroll
            for (int kk = 0; kk < 4; ++kk) {
                const int ko = (32 * kk + 8 * fq) * 2;
                const bf16x8 yf = *(const LAS bf16x8*)(VFT + (16 * wave + fr) * RS + ko), yb = *(const LAS bf16x8*)(VBT + (16 * wave + fr) * RS + ko);
#pragma unroll
                for (int dt = 0; dt < 8; ++dt) { const bf16x8 xk = *(const LAS bf16x8*)(KT + (16 * dt + fr) * RS + ko); af[dt] = MFMA16(xk, yf, af[dt]); ab[dt] = MFMA16(xk, yb, ab[dt]); }
            }
            bf16* sf = SBUF + ((size_t)item * 2) * 16384 + (16 * wave + fr) * 128 + 4 * fq; bf16* sb = sf + 16384;
#pragma unroll
            for (int dt = 0; dt < 8; ++dt) {
                *(unsigned long long*)(sf + 16 * dt) = (unsigned long long)cvtpk(af[dt][0], af[dt][1]) | ((unsigned long long)cvtpk(af[dt][2], af[dt][3]) << 32);
                *(unsigned long long*)(sb + 16 * dt) = (unsigned long long)cvtpk(ab[dt][0], ab[dt][1]) | ((unsigned long long)cvtpk(ab[dt][2], ab[dt][3]) << 32);
            }
            if (item < 256) {
                const int nch = cg & 1, bh = (cg >> 1) * 4 + h;
                const float sfw = nch == 0 ? exp2f(l2f * 128.0f) : 1.0f, sbw = nch == 1 ? exp2f(l2b * 128.0f) : 1.0f;
                float* cf = out + OUT_SF + (size_t)bh * 16384 + (4 * fq) * 128 + 16 * wave + fr; float* cb = out + OUT_SB + (size_t)bh * 16384 + (4 * fq) * 128 + 16 * wave + fr;
#pragma unroll
                for (int dt = 0; dt < 8; ++dt)
#pragma unroll
                    for (int i = 0; i < 4; ++i) { unsafeAtomicAdd(cf + (16 * dt + i) * 128, af[dt][i] * sfw); unsafeAtomicAdd(cb + (16 * dt + i) * 128, ab[dt][i] * sbw); }
            }
            __syncthreads();
        }
    }
    xcd_barrier(bar);

    {
        LANE_VARS;
        const int gt = bx * NTHR + tid, GT = G * NTHR;
        for (int task = gt; task < 4 * 4 * 2 * 2048; task += GT) {
            const int e8 = task & 2047, dir = (task >> 11) & 1, h = (task >> 12) & 3, b = task >> 14;
            float carry[8];
            { const float* s0 = args.in[dir ? 3 : 2] + ((size_t)b * 4 + h) * 16384; const int dv = e8 >> 4, dk0 = (e8 & 15) * 8;
#pragma unroll
              for (int e = 0; e < 8; ++e) carry[e] = s0[(dk0 + e) * 128 + dv]; }
            const float gC = exp2f(-expf(args.in[dir ? 15 : 14][h]) * 1.4426950408889634f * 128.0f);
            for (int sb = 0; sb < 32; sb += 8) {
                v4u kv[8];
#pragma unroll
                for (int i = 0; i < 8; ++i) { const int n = dir ? 31 - (sb + i) : sb + i; kv[i] = *(const v4u*)(SBUF + (((size_t)(64 + 32 * b + n) * 4 + h) * 2 + dir) * 16384 + e8 * 8); }
#pragma unroll
                for (int i = 0; i < 8; ++i) { const int n = dir ? 31 - (sb + i) : sb + i;
                    v4u o; o.x = cvtpk(carry[0], carry[1]); o.y = cvtpk(carry[2], carry[3]); o.z = cvtpk(carry[4], carry[5]); o.w = cvtpk(carry[6], carry[7]);
                    *(v4u*)(SLAT + (((size_t)(32 * b + n) * 4 + h) * 2 + dir) * 16384 + e8 * 8) = o;
#pragma unroll
                    for (int q = 0; q < 4; ++q) { carry[2 * q] = carry[2 * q] * gC + bflo(kv[i][q]); carry[2 * q + 1] = carry[2 * q + 1] * gC + bfhi(kv[i][q]); } }
            }
        }
    }
    xcd_barrier(bar);

    {
        LANE_VARS;
        LAS unsigned char* KP = lds; LAS unsigned char* VT = lds + 128 * RS; LAS unsigned char* SFT = lds + 2 * 128 * RS; LAS unsigned char* SBT = lds + 3 * 128 * RS;
        LAS unsigned char* US = lds; LAS unsigned char* WT = lds + 2 * 128 * RS;
        for (int li = rank; li < nitl; li += nloc) {
            const int item = 8 * t0 + li, cg = item >> 2, h = item & 3, row0 = cg * 128;
            const bool lat = cg >= 64; const int n = lat ? (cg - 64) & 31 : cg & 1, L = lat ? 4096 : 256, seq_row0 = row0 - n * 128;
            const float l2f = -expf(args.in[14][h]) * 1.4426950408889634f, l2b = -expf(args.in[15][h]) * 1.4426950408889634f;
            stage_nat(KP, QKV + (size_t)row0 * LDQ + 1024 + h * 128, LDQ, tid);
            if (lat) { stage_nat(SFT, SLAT + ((size_t)(item - 256) * 2) * 16384, 128, tid); stage_nat(SBT, SLAT + ((size_t)(item - 256) * 2 + 1) * 16384, 128, tid); }
            else if (n == 0) { stage_zero(SFT, tid); stage_nat(SBT, SBUF + ((size_t)(item + 4) * 2 + 1) * 16384, 128, tid); }
            else { stage_nat(SFT, SBUF + ((size_t)(item - 4) * 2) * 16384, 128, tid); stage_zero(SBT, tid); }
            { const int jp = 16 * (wave & 3) + (lane & 15), j0 = 2 * jp;
#pragma unroll
              for (int pass = 0; pass < 2; ++pass) { const int c0 = 8 * (4 * (wave >> 2) + (lane >> 4) + 8 * pass);
                  const bf16* vr = QKV + (size_t)(row0 + j0) * LDQ + 1536 + h * 128 + c0; const v4u va = *(const v4u*)vr, vb = *(const v4u*)(vr + LDQ);
#pragma unroll
                  for (int q = 0; q < 4; ++q) { const unsigned a = va[q], b = vb[q]; const int r0 = (c0 + 2 * q) * RS + jp * 4;
                      *(LAS unsigned*)(VT + r0) = (a & 0xffffu) | (b << 16); *(LAS unsigned*)(VT + r0 + RS) = (a >> 16) | (b & 0xffff0000u); } } }
            const int il = 16 * wave + fr, row = row0 + il;
            bf16x8 yq[4];
#pragma unroll
            for (int kk = 0; kk < 4; ++kk) yq[kk] = *(const bf16x8*)(QKV + (size_t)row * LDQ + h * 128 + 32 * kk + 8 * fq);
            __syncthreads();
            f32x4 sc[8];
#pragma unroll
            for (int jt = 0; jt < 8; ++jt) { sc[jt] = (f32x4){0.f, 0.f, 0.f, 0.f};
#pragma unroll
                for (int kk = 0; kk < 4; ++kk) sc[jt] = MFMA16(*(const LAS bf16x8*)(KP + (16 * jt + fr) * RS + (32 * kk + 8 * fq) * 2), yq[kk], sc[jt]); }
#pragma unroll
            for (int jt = 0; jt < 8; ++jt)
#pragma unroll
                for (int i = 0; i < 4; ++i) { const int j = 16 * jt + 4 * fq + i, dl = il - j; const float w = dl > 0 ? EX2(l2f * (float)dl) : (dl < 0 ? EX2(l2b * (float)(-dl)) : 2.0f); sc[jt][i] *= w; }
            __syncthreads();
#pragma unroll
            for (int jt = 0; jt < 8; ++jt) *(LAS unsigned long long*)(KP + il * RS + (16 * jt + 4 * fq) * 2) = (unsigned long long)cvtpk(sc[jt][0], sc[jt][1]) | ((unsigned long long)cvtpk(sc[jt][2], sc[jt][3]) << 32);
            __syncthreads();
            f32x4 oi[8];
#pragma unroll
            for (int dt = 0; dt < 8; ++dt) oi[dt] = (f32x4){0.f, 0.f, 0.f, 0.f};
            const float cfw = EX2(l2f * (float)(il + 1)), cbw = EX2(l2b * (float)(128 - il));
#pragma unroll 1
            for (int kk = 0; kk < 4; ++kk) { const int ko = (32 * kk + 8 * fq) * 2; const bf16x8 yp = *(const LAS bf16x8*)(KP + il * RS + ko);
                const v4u qw = *(const v4u*)(QKV + (size_t)row * LDQ + h * 128 + 32 * kk + 8 * fq); v4u qf, qb;
#pragma unroll
                for (int q = 0; q < 4; ++q) { const float lo = bflo(qw[q]), hi = bfhi(qw[q]); qf[q] = cvtpk(lo * cfw, hi * cfw); qb[q] = cvtpk(lo * cbw, hi * cbw); }
                const bf16x8 yqf = __builtin_bit_cast(bf16x8, qf), yqb = __builtin_bit_cast(bf16x8, qb);
#pragma unroll
                for (int dt = 0; dt < 8; ++dt) { const int ro = (16 * dt + fr) * RS + ko;
                    oi[dt] = MFMA16(*(const LAS bf16x8*)(VT + ro), yp, oi[dt]); oi[dt] = MFMA16(*(const LAS bf16x8*)(SFT + ro), yqf, oi[dt]); oi[dt] = MFMA16(*(const LAS bf16x8*)(SBT + ro), yqb, oi[dt]); } }
            float ss = 0.f;
#pragma unroll
            for (int dt = 0; dt < 8; ++dt) ss += (oi[dt][0] * oi[dt][0] + oi[dt][1] * oi[dt][1]) + (oi[dt][2] * oi[dt][2] + oi[dt][3] * oi[dt][3]);
            ss += __shfl_xor(ss, 16); ss += __shfl_xor(ss, 32);
            const float rn = 1.0f / sqrtf(ss * (1.0f / 128.0f) + EPS);
            { bf16* qrow = QKV + (size_t)row * LDQ + h * 128 + 4 * fq; const bf16* grow = qrow + 512; const float* gn = args.in[16] + h * 128 + 4 * fq;
#pragma unroll
              for (int dt = 0; dt < 8; ++dt) { const unsigned long long gw_ = *(const unsigned long long*)(grow + 16 * dt); const f32x4 g4 = *(const f32x4*)(gn + 16 * dt);
                  const unsigned g01 = (unsigned)gw_, g23 = (unsigned)(gw_ >> 32);
                  const float r0 = oi[dt][0] * rn * g4[0] * pg8::silu_f(bflo(g01)), r1 = oi[dt][1] * rn * g4[1] * pg8::silu_f(bfhi(g01));
                  const float r2 = oi[dt][2] * rn * g4[2] * pg8::silu_f(bflo(g23)), r3 = oi[dt][3] * rn * g4[3] * pg8::silu_f(bfhi(g23));
                  *(unsigned long long*)(qrow + 16 * dt) = (unsigned long long)cvtpk(r0, r1) | ((unsigned long long)cvtpk(r2, r3) << 32); } }
            __syncthreads();
            { const int half = 1 << h;
              for (int c = tid; c < 144 * 16; c += NTHR) { const int lr = c >> 4, cc = c & 15, pos = n * 128 - 8 + lr; v4u v = (v4u){0u, 0u, 0u, 0u};
                  if (pos >= 0 && pos < L) v = *(const v4u*)(QKV + (size_t)(seq_row0 + pos) * LDQ + 2048 + h * 128 + cc * 8);
                  *(LAS v4u*)(US + lr * RS + cc * 16) = v; }
              stage_nat(WT, POOLW + h * 16384, 128, tid);
              __syncthreads();
              const int pos = n * 128 + il, lo = pos - half > 0 ? pos - half : 0, hi = pos + half < L ? pos + half : L; const float inv = 1.0f / (float)(hi - lo);
              bf16x8 yd[4];
#pragma unroll
              for (int kk = 0; kk < 4; ++kk) { const int co = (32 * kk + 8 * fq) * 2; float s[8];
#pragma unroll
                  for (int e = 0; e < 8; ++e) s[e] = 0.f;
                  for (int dd = -half; dd < half; ++dd) { const v4u v = *(const LAS v4u*)(US + (il + 8 + dd) * RS + co);
#pragma unroll
                      for (int q = 0; q < 4; ++q) { s[2 * q] += bflo(v[q]); s[2 * q + 1] += bfhi(v[q]); } }
                  const v4u cv = *(const LAS v4u*)(US + (il + 8) * RS + co); v4u dq;
#pragma unroll
                  for (int q = 0; q < 4; ++q) dq[q] = cvtpk(s[2 * q] * inv - bflo(cv[q]), s[2 * q + 1] * inv - bfhi(cv[q]));
                  yd[kk] = __builtin_bit_cast(bf16x8, dq); }
              f32x4 po[8];
#pragma unroll
              for (int dt = 0; dt < 8; ++dt) { po[dt] = (f32x4){0.f, 0.f, 0.f, 0.f};
#pragma unroll
                  for (int kk = 0; kk < 4; ++kk) po[dt] = MFMA16(*(const LAS bf16x8*)(WT + (16 * dt + fr) * RS + (32 * kk + 8 * fq) * 2), yd[kk], po[dt]); }
              bf16* prow = QKV + (size_t)row * LDQ + 512 + h * 128 + 4 * fq; const float* ps = args.in[18] + h * 128 + 4 * fq;
#pragma unroll
              for (int dt = 0; dt < 8; ++dt) { const f32x4 p4 = *(const f32x4*)(ps + 16 * dt);
                  *(unsigned long long*)(prow + 16 * dt) = (unsigned long long)cvtpk(po[dt][0] * p4[0], po[dt][1] * p4[1]) | ((unsigned long long)cvtpk(po[dt][2] * p4[2], po[dt][3] * p4[3]) << 32); }
            }
            __syncthreads();
        }
    }
    xcd_barrier(bar);

    { pg8::Gemm g{QKV, WOUT, M, D, D, LDQ, D}; pg8::AffOrder S; S.init(t0, t1, D, nloc, rank, 0); pg8::EpiResid E{nullptr, nullptr, (const bf16*)out, (bf16*)out, mods + 5120, 2, ABUF, args.in[20], mods + 7168, sspa, sspb};
      pg8::gemm_phase<pg8::EpiResid, pg8::AffOrder, true, true>(lds, g, S, E); }
    LOCAL_BAR();
    { int tt_ = threadIdx.x; asm volatile("" : "+v"(tt_));
    for (int r = 256 * t0 + rank * NTHR + tt_; r < 256 * t1; r += nloc * NTHR) { const f32x4 a0 = *(const f32x4*)(sspa + (size_t)r * 8), a1 = *(const f32x4*)(sspa + (size_t)r * 8 + 4), b0 = *(const f32x4*)(sspb + (size_t)r * 8), b1 = *(const f32x4*)(sspb + (size_t)r * 8 + 4);
        const float ssq = (((a0[0] + a0[1]) + (a0[2] + a0[3])) + ((a1[0] + a1[1]) + (a1[2] + a1[3]))) + (((b0[0] + b0[1]) + (b0[2] + b0[3])) + ((b1[0] + b1[1]) + (b1[2] + b1[3])));
        rrow[r] = 1.0f / sqrtf(ssq * (1.f / D) + EPS); } }
    LOCAL_BAR();
    { pg8::Gemm g{ABUF, W13B, M, NUP, D, D, D}; pg8::AffOrder S; S.init(t0, t1, NUP, nloc, rank); pg8::EpiSwiglu E{HBUF, FF, rrow, bias3};
      pg8::gemm_phase<pg8::EpiSwiglu, pg8::AffOrder, true, true>(lds, g, S, E); }
    LOCAL_BAR();
    { const int ntot = (t1 - t0) * (D / 256), tail_raw = ntot % nloc; const bool split_ok = tail_raw > 0 && tail_raw <= 32 && xi < 8;
      const int nfull = split_ok ? ntot - tail_raw : ntot, xi32 = xi * 32;
      pg8::EpiDelta E{ABUF, mods + 8192, SLAT, t0, t1 - t0, nfull, xi32};
      { pg8::Gemm g{HBUF, W2B, M, D, FF, FF, FF}; pg8::SegOrder S; S.init(t0, t1, D, nloc, rank, nfull, 0); pg8::gemm_phase<pg8::EpiDelta, pg8::SegOrder, true, true>(lds, g, S, E); }
      { pg8::Gemm g{HBUF, W2B, M, D, FF, FF, FF / 2}; pg8::SegOrder S; S.init(t0, t1, D, nloc, rank, nfull, 1); pg8::gemm_phase<pg8::EpiDelta, pg8::SegOrder, true, true>(lds, g, S, E); }
      LOCAL_BAR();
      final_rows(out, ABUF, SLAT, t0, t1 - t0, nfull, xi32, args.in[24], 256 * t0, 256 * t1, lwv, NLW, (int)(threadIdx.x & 63)); }
}

extern "C" void kernel_launch(void* const* d_in, const int* in_sizes, int n_in, void* d_out, int out_size, void* d_ws, size_t ws_size, hipStream_t stream) {
    static int grid = 0;
    if (grid == 0) {
        if (n_in != 25 || in_sizes[0] != MCTX * D || in_sizes[1] != MLAT * D || out_size != M * D + 2 * 32 * 4 * 128 * 128 || ws_size < 256 * MiB) {
            fprintf(stderr, "kernel_launch: unexpected shapes (n_in %d, out %d, ws %zu); nothing launched\n", n_in, out_size, ws_size); grid = -1; return; }
        int dev = 0, cus = 0, per_cu = 0;
        if (hipGetDevice(&dev) != hipSuccess || hipDeviceGetAttribute(&cus, hipDeviceAttributeMultiprocessorCount, dev) != hipSuccess) { grid = -1; return; }
        if (hipFuncSetAttribute((const void*)hyb_fwd, hipFuncAttributeMaxDynamicSharedMemorySize, LDS_BYTES) != hipSuccess) { fprintf(stderr, "kernel_launch: hipFuncSetAttribute failed\n"); grid = -1; return; }
        if (hipOccupancyMaxActiveBlocksPerMultiprocessor(&per_cu, (const void*)hyb_fwd, NTHR, LDS_BYTES) != hipSuccess || per_cu < 1) {
            fprintf(stderr, "kernel_launch: occupancy query reports %d workgroups per CU; nothing launched\n", per_cu); (void)hipGetLastError(); grid = -1; return; }
        grid = cus;
    }
    if (grid < 0) return;
    (void)hipMemsetAsync((char*)d_ws + WS_CTL, 0, CTL_ZERO_BYTES, stream);
    Args a{};
    for (int i = 0; i < 25; ++i) a.in[i] = (const float*)d_in[i];
    a.out = (float*)d_out; a.ws = (unsigned char*)d_ws;
    hipLaunchKernelGGL(hyb_fwd, dim3(grid), dim3(NTHR), LDS_BYTES, stream, a);
}
```

```cpp
#include <hip/hip_runtime.h>
#include <cstdio>
#include <cstdint>
namespace pg8 {
#define PG8_LAS __attribute__((address_space(3)))
typedef unsigned short bf16_t;
typedef short bf16x8 __attribute__((ext_vector_type(8)));
typedef float f32x4 __attribute__((ext_vector_type(4)));
typedef unsigned u32x4 __attribute__((ext_vector_type(4)));
constexpr int BM = 256, BK = 64, HALF = 128, HTB = HALF * BK * 2  , STAGE_BYTES = 8 * HTB, NXCD = 8, WGM = 8;

__host__ __device__ __forceinline__ int lds_byte(int r, int c) { const int st = (r >> 4) * 2 + (c >> 5), rr = r & 15, cc = c & 31, ob = rr * 64 + cc * 2; return st * 1024 + (ob ^ (((ob >> 9) & 1) << 5)); }
__host__ __device__ __forceinline__ void stage_rc(int b, int& R, int& C) { const int st = b / 1024, sb = b % 1024, swz = sb ^ (((sb >> 9) & 1) << 5); R = (st >> 1) * 16 + swz / 64; C = (st & 1) * 32 + (swz % 64) / 2; }
__host__ __device__ __forceinline__ int perm32(int rho) { const int n = rho >> 4, i = rho & 15; return 8 * (i >> 2) + 4 * n + (i & 3); }

struct Unit { int pm, pn, kh; };
struct Gemm { const bf16_t* A; const bf16_t* Bt; int M, N, K, lda, Kh; };

struct StaticOrder {
    int nM, nN, nwg, G, c;
    __host__ __device__ void init(int M, int N, int G_, int c_) { nM = M / BM; nN = N / BM; nwg = nM * nN; G = G_; c = c_; }
    __host__ __device__ bool next(int i, Unit& u) const {
        const long L = (long)i * G + c; if (L >= nwg) return false;
        int wgid = (int)L; { const int q = nwg / NXCD, r = nwg % NXCD, xcd = wgid % NXCD, off = wgid / NXCD; wgid = (xcd < r ? xcd * (q + 1) : r * (q + 1) + (xcd - r) * q) + off; }
        const int nig = WGM * nN, gid = wgid / nig, fm = gid * WGM, gsz = (nM - fm) < WGM ? (nM - fm) : WGM;
        u.pm = fm + ((wgid % nig) % gsz); u.pn = (wgid % nig) / gsz; return true;
    }
    __device__ __forceinline__ void a_ready(const Unit&) const {}
    __device__ __forceinline__ void done(const Unit&) const {}
};

typedef float f32x2 __attribute__((ext_vector_type(2)));
typedef __bf16 bf16x2_t __attribute__((ext_vector_type(2)));
__device__ __forceinline__ unsigned cvt_pk_bf16(float lo, float hi) { const f32x2 v = {lo, hi}; return __builtin_bit_cast(unsigned, __builtin_convertvector(v, bf16x2_t)); }
__device__ __forceinline__ float silu_f(float x) { return x * __builtin_amdgcn_rcpf(1.0f + __expf(-x)); }
struct EpiSwiglu {
    static constexpr bool PERM = true, AFTER_DRAIN = false;
    bf16_t* O; int ldo;
    const float* rrow; const float* bias;
    __device__ __forceinline__ void operator()(const f32x4 (&acc)[2][2][4][2], const Unit& u, int wr, int wc, int fr, int fq) const {
        const int rowt = u.pm * BM, row0 = rowt + wr * 64 + fr, col0 = u.pn * HALF + wc * 32 + 8 * fq;
        const int grp = rowt >= 8192 ? 1 + ((rowt - 8192) >> 12) : 0;
        f32x4 bg[2], bu[2];
#pragma unroll
        for (int n = 0; n < 2; ++n) { bg[n] = (f32x4){0.f, 0.f, 0.f, 0.f}; bu[n] = bg[n];
            if (rrow) { const float* bp = bias + (size_t)grp * 5632 + u.pn * BM + wc * 32 + 8 * fq + 4 * n; bg[n] = *(const f32x4*)bp; bu[n] = *(const f32x4*)(bp + HALF); } }
#pragma unroll
        for (int ai = 0; ai < 2; ++ai)
#pragma unroll
            for (int m = 0; m < 4; ++m) { const int r = row0 + ai * HALF + m * 16; bf16_t* rowp = O + (size_t)r * ldo + col0;
                const float rs = rrow ? rrow[r] : 1.0f;
                const f32x4 g0 = acc[ai][0][m][0] * rs + bg[0], g1 = acc[ai][0][m][1] * rs + bg[1], u0 = acc[ai][1][m][0] * rs + bu[0], u1 = acc[ai][1][m][1] * rs + bu[1];
                u32x4 w;
                w.x = cvt_pk_bf16(silu_f(g0[0]) * u0[0], silu_f(g0[1]) * u0[1]); w.y = cvt_pk_bf16(silu_f(g0[2]) * u0[2], silu_f(g0[3]) * u0[3]);
                w.z = cvt_pk_bf16(silu_f(g1[0]) * u1[0], silu_f(g1[1]) * u1[1]); w.w = cvt_pk_bf16(silu_f(g1[2]) * u1[2], silu_f(g1[3]) * u1[3]);
                *(u32x4*)rowp = w; }
    }
};
struct EpiResid {
    static constexpr bool PERM = true, AFTER_DRAIN = false;
    const float* base0; const float* base1; const bf16_t* baseb; bf16_t* hb; const float* coef; int mul2;
    bf16_t* hm; const float* gamma; const float* scn; float* sspa; float* sspb;
    __device__ __forceinline__ void operator()(const f32x4 (&acc)[2][2][4][2], const Unit& u, int wr_in, int wc_in, int fr_in, int fq_in) const {
        int tid_ = threadIdx.x; asm volatile("" : "+v"(tid_));
        const int lane_ = tid_ & 63, wid_ = __builtin_amdgcn_readfirstlane(tid_ >> 6), wr = wid_ >> 2, wc = wid_ & 3, fr = lane_ & 15, fq = lane_ >> 4;
        const float mulv = 0.5f * (float)mul2; const bf16_t* const baseb_ = baseb; bf16_t* const hb_ = hb;
        const int rowt = u.pm * BM; const bool lat = rowt >= 8192; const int grp = lat ? 1 + ((rowt - 8192) >> 12) : 0;
        const float* bp = lat ? base1 : base0; const int rsub = lat ? 8192 : 0;
        const int row0 = rowt + wr * 64 + fr, col0 = u.pn * BM + wc * 32 + 8 * fq;
        float* ssp = (u.pn < 2 ? sspa : sspb) + (u.pn & 1) * 4 + wc;
        float ss8[8];
#pragma unroll
        for (int k = 0; k < 8; ++k) ss8[k] = 0.f;
#pragma unroll
        for (int bj = 0; bj < 2; ++bj) {
            f32x4 cf[2], gm[2];
#pragma unroll
            for (int n = 0; n < 2; ++n) { cf[n] = *(const f32x4*)(coef + (size_t)grp * 9216 + col0 + bj * HALF + n * 4) * mulv;
                gm[n] = *(const f32x4*)(gamma + col0 + bj * HALF + n * 4) * (*(const f32x4*)(scn + (size_t)grp * 9216 + col0 + bj * HALF + n * 4) + 1.0f); }
#pragma unroll
            for (int ai = 0; ai < 2; ++ai)
#pragma unroll
                for (int m = 0; m < 4; ++m) { const int r = row0 + ai * HALF + m * 16;
                    f32x4 b0, b1;
                    if (baseb_) { const u32x4 pw = *(const u32x4*)(baseb_ + (size_t)r * 2048 + col0 + bj * HALF);
                        b0 = (f32x4){__uint_as_float(pw.x << 16), __uint_as_float(pw.x & 0xffff0000u), __uint_as_float(pw.y << 16), __uint_as_float(pw.y & 0xffff0000u)};
                        b1 = (f32x4){__uint_as_float(pw.z << 16), __uint_as_float(pw.z & 0xffff0000u), __uint_as_float(pw.w << 16), __uint_as_float(pw.w & 0xffff0000u)}; }
                    else { const float* bsrc = bp + (size_t)(r - rsub) * 1024 + col0 + bj * HALF; b0 = *(const f32x4*)bsrc; b1 = *(const f32x4*)(bsrc + 4); }
                    const f32x4 h0 = b0 + cf[0] * acc[ai][bj][m][0], h1 = b1 + cf[1] * acc[ai][bj][m][1];
                    { u32x4 w; w.x = cvt_pk_bf16(h0[0], h0[1]); w.y = cvt_pk_bf16(h0[2], h0[3]); w.z = cvt_pk_bf16(h1[0], h1[1]); w.w = cvt_pk_bf16(h1[2], h1[3]);
                      *(u32x4*)(hb_ + (size_t)r * 2048 + col0 + bj * HALF) = w; }
                    ss8[ai * 4 + m] += ((h0[0] * h0[0] + h0[1] * h0[1]) + (h0[2] * h0[2] + h0[3] * h0[3])) + ((h1[0] * h1[0] + h1[1] * h1[1]) + (h1[2] * h1[2] + h1[3] * h1[3]));
                    { const f32x4 a0 = h0 * gm[0], a1 = h1 * gm[1]; u32x4 w;
                      w.x = cvt_pk_bf16(a0[0], a0[1]); w.y = cvt_pk_bf16(a0[2], a0[3]); w.z = cvt_pk_bf16(a1[0], a1[1]); w.w = cvt_pk_bf16(a1[2], a1[3]);
                      *(u32x4*)(hm + (size_t)r * 1024 + col0 + bj * HALF) = w; }
                    if (m & 1) asm volatile("" ::: "memory"); }
        }
#pragma unroll
        for (int k = 0; k < 8; ++k) { float ss = ss8[k]; ss += __shfl_xor(ss, 16); ss += __shfl_xor(ss, 32); if (fq == 0) ssp[(size_t)(row0 + (k >> 2) * HALF + (k & 3) * 16) * 8] = ss; }
    }
};
struct EpiQKV {
    static constexpr bool PERM = true, AFTER_DRAIN = false;
    bf16_t* O; int ldo; const float* rotc; const float* rots; const float* rrow; const float* bias;
    __device__ __forceinline__ void operator()(const f32x4 (&acc)[2][2][4][2], const Unit& u, int wr, int wc, int fr, int fq) const {
        const int rowt = u.pm * BM, row0 = rowt + wr * 64 + fr, pn = u.pn;
        const int grp = rowt >= 8192 ? 1 + ((rowt - 8192) >> 12) : 0;
        f32x4 bb[2][2];
#pragma unroll
        for (int bj = 0; bj < 2; ++bj)
#pragma unroll
            for (int n = 0; n < 2; ++n) bb[bj][n] = *(const f32x4*)(bias + (size_t)grp * 2560 + pn * BM + bj * HALF + wc * 32 + 8 * fq + 4 * n);
        if (pn < 2 || pn == 4 || pn == 5) {
            const bool isk = pn >= 4; const int hp = (pn & 1) * 2 + (wc >> 1); const int d1 = 32 * (wc & 1) + 8 * fq;
            const int colbase = (isk ? 1024 : 0) + hp * 128 + d1; const float sc = isk ? 0.08838834764831845f : 1.0f; const bool lat = rowt >= 8192;
#pragma unroll
            for (int ai = 0; ai < 2; ++ai)
#pragma unroll
                for (int m = 0; m < 4; ++m) { const int r = row0 + ai * HALF + m * 16;
                    const float rs = rrow[r];
                    f32x4 x1a = (acc[ai][0][m][0] * rs + bb[0][0]) * sc, x1b = (acc[ai][0][m][1] * rs + bb[0][1]) * sc, x2a = (acc[ai][1][m][0] * rs + bb[1][0]) * sc, x2b = (acc[ai][1][m][1] * rs + bb[1][1]) * sc;
                    if (lat) { const int t = (r - 8192) & 4095; const int pos = (wc & 1) ? (t & 63) : (t >> 6);
                        const float* cp = rotc + pos * 32 + 8 * fq; const float* sp = rots + pos * 32 + 8 * fq;
                        const f32x4 c0 = *(const f32x4*)cp, c1 = *(const f32x4*)(cp + 4), s0 = *(const f32x4*)sp, s1 = *(const f32x4*)(sp + 4);
                        const f32x4 o1a = x1a * c0 - x2a * s0, o2a = x1a * s0 + x2a * c0, o1b = x1b * c1 - x2b * s1, o2b = x1b * s1 + x2b * c1;
                        x1a = o1a; x2a = o2a; x1b = o1b; x2b = o2b; }
                    bf16_t* rowp = O + (size_t)r * ldo + colbase; u32x4 w;
                    w.x = cvt_pk_bf16(x1a[0], x1a[1]); w.y = cvt_pk_bf16(x1a[2], x1a[3]); w.z = cvt_pk_bf16(x1b[0], x1b[1]); w.w = cvt_pk_bf16(x1b[2], x1b[3]); *(u32x4*)rowp = w;
                    w.x = cvt_pk_bf16(x2a[0], x2a[1]); w.y = cvt_pk_bf16(x2a[2], x2a[3]); w.z = cvt_pk_bf16(x2b[0], x2b[1]); w.w = cvt_pk_bf16(x2b[2], x2b[3]); *(u32x4*)(rowp + 64) = w; }
        } else {
            const int col0 = pn * BM + wc * 32 + 8 * fq;
#pragma unroll
            for (int ai = 0; ai < 2; ++ai)
#pragma unroll
                for (int m = 0; m < 4; ++m) { const int r = row0 + ai * HALF + m * 16; bf16_t* rowp = O + (size_t)r * ldo + col0; const float rs = rrow[r];
#pragma unroll
                    for (int bj = 0; bj < 2; ++bj) { const f32x4 v0 = acc[ai][bj][m][0] * rs + bb[bj][0], v1 = acc[ai][bj][m][1] * rs + bb[bj][1]; u32x4 w;
                        w.x = cvt_pk_bf16(v0[0], v0[1]); w.y = cvt_pk_bf16(v0[2], v0[3]); w.z = cvt_pk_bf16(v1[0], v1[1]); w.w = cvt_pk_bf16(v1[2], v1[3]); *(u32x4*)(rowp + bj * HALF) = w; } }
        }
    }
};

struct EpiDelta {
    static constexpr bool PERM = true, AFTER_DRAIN = false;
    bf16_t* O; const float* coef; bf16_t* slabs; int t0, ntl, nfull, xi32;
    __device__ __forceinline__ void operator()(const f32x4 (&acc)[2][2][4][2], const Unit& u, int wr, int wc, int fr, int fq) const {
        const int rowt = u.pm * BM; const int grp = rowt >= 8192 ? 1 + ((rowt - 8192) >> 12) : 0;
        const int col0 = u.pn * BM + wc * 32 + 8 * fq, rl0 = wr * 64 + fr;
        bf16_t* tb; int ld;
        if (u.kh == 1) { tb = slabs + (size_t)(xi32 + u.pn * ntl + (u.pm - t0) - nfull) * 65536 + wc * 32 + 8 * fq; ld = 256; }
        else { tb = O + (size_t)rowt * 1024 + col0; ld = 1024; }
#pragma unroll
        for (int bj = 0; bj < 2; ++bj) {
            const f32x4 c0 = *(const f32x4*)(coef + (size_t)grp * 9216 + col0 + bj * HALF) * 0.5f, c1 = *(const f32x4*)(coef + (size_t)grp * 9216 + col0 + bj * HALF + 4) * 0.5f;
#pragma unroll
            for (int ai = 0; ai < 2; ++ai)
#pragma unroll
                for (int m = 0; m < 4; ++m) { const f32x4 v0 = acc[ai][bj][m][0] * c0, v1 = acc[ai][bj][m][1] * c1; u32x4 w;
                    w.x = cvt_pk_bf16(v0[0], v0[1]); w.y = cvt_pk_bf16(v0[2], v0[3]); w.z = cvt_pk_bf16(v1[0], v1[1]); w.w = cvt_pk_bf16(v1[2], v1[3]);
                    *(u32x4*)(tb + (size_t)(rl0 + ai * HALF + m * 16) * ld + bj * HALF) = w; }
        }
    }
};
struct SegOrder {
    int t0, ntl, nN, nloc, rank, nfull, seg;
    __device__ void init(int t0_, int t1_, int N, int nloc_, int rank_, int nfull_, int seg_) { t0 = t0_; ntl = t1_ - t0_; nN = N / BM; nloc = nloc_; rank = rank_; nfull = nfull_; seg = seg_; }
    __device__ bool next(int i, Unit& u) const { int L = i * nloc + rank; u.kh = 0;
        if (seg == 0) { if (L >= nfull) return false; }
        else { if (L >= 2 * (ntl * nN - nfull)) return false; u.kh = L & 1; L = nfull + (L >> 1); }
        u.pm = t0 + L % ntl; u.pn = L / ntl; return true; }
    __device__ __forceinline__ void a_ready(const Unit&) const {}
    __device__ __forceinline__ void done(const Unit&) const {}
};


struct AffOrder {
    int t0, ntl, nN, nloc, rank, split;
    __device__ void init(int t0_, int t1_, int N, int nloc_, int rank_, int split_ = 0) { t0 = t0_; ntl = t1_ - t0_; nN = N / BM; nloc = nloc_; rank = rank_; split = split_; }
    __device__ bool next(int i, Unit& u) const { int L = i * nloc + rank; const int nt_ = ntl * nN; if (L >= (split ? 2 * nt_ : nt_)) return false; u.kh = 0; if (L >= nt_) { L -= nt_; u.kh = 1; } u.pm = t0 + L % ntl; u.pn = L / ntl; return true; }
    __device__ __forceinline__ void a_ready(const Unit&) const {}
    __device__ __forceinline__ void done(const Unit&) const {}
};

template <class Epi, class Sched, bool ALIGN_EPI = false, bool SP2 = false>
__device__ __forceinline__ void gemm_phase(PG8_LAS unsigned char* lds, const Gemm g, const Sched& S, const Epi& E) {
    int tid_ = threadIdx.x; asm volatile("" : "+v"(tid_));
    const int tid = tid_, wid = __builtin_amdgcn_readfirstlane(tid >> 6), lane = tid & 63, wr = wid >> 2, wc = wid & 3, fr = lane & 15, fq = lane >> 4;
    const int K = g.K, nt = g.Kh / BK; const size_t khb = (size_t)g.Kh * 2;
    unsigned voffA[2], voffB[2];
#pragma unroll
    for (int i = 0; i < 2; ++i) { int R, C; stage_rc(tid * 16 + i * 8192, R, C); const int Rb = Epi::PERM ? ((R & ~31) + perm32(R & 31)) : R;
        voffA[i] = (unsigned)(R * g.lda + C) * 2u; voffB[i] = (unsigned)(Rb * K + C) * 2u; }
    const size_t kstep = (size_t)(BK * 2);
    const size_t hstep = (size_t)HALF * K * 2;
    const size_t tstep = 2 * hstep; const size_t hstepA = (size_t)HALF * g.lda * 2, tstepA = 2 * hstepA;
    const unsigned ldsw = (unsigned)wid * 1024u;
    const int aoff = lds_byte(wr * 64 + fr, fq * 8), boff = lds_byte(wc * 32 + fr, fq * 8);
#define PG8_SA(b, h) (((b) * 2 + (h)) * HTB)
#define PG8_SB(b, h) ((4 + (b) * 2 + (h)) * HTB)
#define PG8_STAGE(bufoff, gbase, voff) do { _Pragma("unroll") for (int _i = 0; _i < 2; ++_i) \
        __builtin_amdgcn_global_load_lds((const unsigned*)((const char*)(gbase) + (voff)[_i]), (PG8_LAS unsigned*)(lds + (bufoff) + ldsw + _i * 8192), 16, 0, 0); } while (0)
#define PG8_LDA(dst, b, h) do { _Pragma("unroll") for (int m = 0; m < 4; ++m) _Pragma("unroll") for (int k = 0; k < 2; ++k) dst[m][k] = *(const PG8_LAS bf16x8*)(lds + PG8_SA(b, h) + aoff + m * 2048 + k * 1024); } while (0)
#define PG8_LDB(dst, b, h) do { _Pragma("unroll") for (int n = 0; n < 2; ++n) _Pragma("unroll") for (int k = 0; k < 2; ++k) dst[n][k] = *(const PG8_LAS bf16x8*)(lds + PG8_SB(b, h) + boff + n * 2048 + k * 1024); } while (0)
#define PG8_MMA(ai, bj, At, Bt) do { __builtin_amdgcn_s_setprio(1); _Pragma("unroll") for (int m = 0; m < 4; ++m) _Pragma("unroll") for (int n = 0; n < 2; ++n) _Pragma("unroll") for (int k = 0; k < 2; ++k) \
        acc[ai][bj][m][n] = __builtin_amdgcn_mfma_f32_16x16x32_bf16(Bt[n][k], At[m][k], acc[ai][bj][m][n], 0, 0, 0); __builtin_amdgcn_s_setprio(0); } while (0)
#define PG8_WAIT_V(n) asm volatile("s_waitcnt vmcnt(" #n ")" ::: "memory")
#define PG8_WAIT_L(n) asm volatile("s_waitcnt lgkmcnt(" #n ")" ::: "memory")
#define PG8_BAR __builtin_amdgcn_s_barrier()
#define PG8_SCHED __builtin_amdgcn_sched_barrier(0)
    Unit cur, nxt; int ui = 0;
    if (!S.next(0, cur)) return;
    f32x4 acc[2][2][4][2];
#pragma unroll
    for (int a = 0; a < 2; ++a)
#pragma unroll
        for (int b = 0; b < 2; ++b)
#pragma unroll
            for (int m = 0; m < 4; ++m)
#pragma unroll
                for (int n = 0; n < 2; ++n) acc[a][b][m][n] = (f32x4){0.f, 0.f, 0.f, 0.f};
    bf16x8 At[4][2], B0[2][2], B1[2][2];
    const char* cA = (const char*)g.A + (size_t)cur.pm * tstepA + (size_t)cur.kh * khb; const char* cB = (const char*)g.Bt + (size_t)cur.pn * tstep + (size_t)cur.kh * khb;
    S.a_ready(cur);
    if constexpr (SP2) {
        PG8_STAGE(PG8_SB(0, 0), cB, voffB); PG8_STAGE(PG8_SB(0, 1), cB + hstep, voffB); PG8_STAGE(PG8_SA(0, 0), cA, voffA); PG8_STAGE(PG8_SA(0, 1), cA + hstepA, voffA);
        if (wr == 1) PG8_BAR;
        PG8_WAIT_V(2); PG8_BAR;
        PG8_STAGE(PG8_SB(1, 0), cB + kstep, voffB); PG8_STAGE(PG8_SA(1, 0), cA + kstep, voffA); PG8_STAGE(PG8_SB(1, 1), cB + hstep + kstep, voffB);
        PG8_WAIT_V(6); PG8_BAR;
    } else {
        PG8_STAGE(PG8_SB(0, 0), cB, voffB); PG8_STAGE(PG8_SA(0, 0), cA, voffA); PG8_STAGE(PG8_SB(0, 1), cB + hstep, voffB); PG8_STAGE(PG8_SA(0, 1), cA + hstepA, voffA);
        if (wr == 1) PG8_BAR;
        PG8_WAIT_V(4); PG8_BAR;
        PG8_STAGE(PG8_SB(1, 0), cB + kstep, voffB); PG8_STAGE(PG8_SA(1, 0), cA + kstep, voffA); PG8_STAGE(PG8_SB(1, 1), cB + hstep + kstep, voffB);
        PG8_WAIT_V(6); PG8_BAR;
    }
    for (;;) {
        const bool has_next = S.next(ui + 1, nxt);
        const char* nA = has_next ? (const char*)g.A + (size_t)nxt.pm * tstepA + (size_t)nxt.kh * khb : cA; const char* nB = has_next ? (const char*)g.Bt + (size_t)nxt.pn * tstep + (size_t)nxt.kh * khb : cB;
        for (int t = 0; t < nt; t += 2) {
            const bool last = (t == nt - 2);
            const char* a1 = cA + (size_t)(t + 1) * kstep;
            const char* a2 = last ? nA : cA + (size_t)(t + 2) * kstep; const char* b2 = last ? nB : cB + (size_t)(t + 2) * kstep;
            const char* a3 = a2 + kstep; const char* b3 = b2 + kstep;
            if (last && has_next) S.a_ready(nxt);
            if constexpr (SP2) {
            PG8_LDB(B0, 0, 0); PG8_LDB(B1, 0, 1); PG8_SCHED; PG8_LDA(At, 0, 0); PG8_STAGE(PG8_SA(1, 1), a1 + hstepA, voffA);
            PG8_WAIT_V(8); PG8_WAIT_L(0); PG8_BAR; PG8_MMA(0, 0, At, B0); PG8_MMA(0, 1, At, B1); PG8_BAR; PG8_SCHED;
            PG8_LDA(At, 0, 1); PG8_STAGE(PG8_SB(0, 0), b2, voffB); PG8_STAGE(PG8_SB(0, 1), b2 + hstep, voffB); PG8_STAGE(PG8_SA(0, 0), a2, voffA);
            PG8_WAIT_V(8); PG8_WAIT_L(0); PG8_BAR; PG8_MMA(1, 0, At, B0); PG8_MMA(1, 1, At, B1); PG8_BAR; PG8_SCHED;
            PG8_LDB(B0, 1, 0); PG8_LDB(B1, 1, 1); PG8_SCHED; PG8_LDA(At, 1, 0); PG8_STAGE(PG8_SA(0, 1), a2 + hstepA, voffA);
            PG8_WAIT_V(8); PG8_WAIT_L(0); PG8_BAR; PG8_MMA(0, 0, At, B0); PG8_MMA(0, 1, At, B1); PG8_BAR; PG8_SCHED;
            PG8_LDA(At, 1, 1); PG8_STAGE(PG8_SB(1, 0), b3, voffB); PG8_STAGE(PG8_SB(1, 1), b3 + hstep, voffB); PG8_STAGE(PG8_SA(1, 0), a3, voffA);
            PG8_WAIT_V(8); PG8_WAIT_L(0); PG8_BAR; PG8_MMA(1, 0, At, B0); PG8_MMA(1, 1, At, B1); PG8_BAR; PG8_SCHED;
            } else {
            PG8_LDB(B0, 0, 0); PG8_SCHED; PG8_LDA(At, 0, 0); PG8_STAGE(PG8_SA(1, 1), a1 + hstepA, voffA);
            PG8_WAIT_L(8); PG8_BAR; PG8_WAIT_L(0); PG8_MMA(0, 0, At, B0); PG8_BAR; PG8_SCHED;
            PG8_LDB(B1, 0, 1); PG8_STAGE(PG8_SB(0, 0), b2, voffB);
            PG8_BAR; PG8_WAIT_L(0); PG8_MMA(0, 1, At, B1); PG8_BAR;
            PG8_LDA(At, 0, 1); PG8_STAGE(PG8_SA(0, 0), a2, voffA);
            PG8_BAR; PG8_WAIT_L(0); PG8_MMA(1, 0, At, B0); PG8_BAR; PG8_SCHED;
            PG8_STAGE(PG8_SB(0, 1), b2 + hstep, voffB);
            PG8_WAIT_V(6); PG8_BAR; PG8_MMA(1, 1, At, B1); PG8_BAR;
            PG8_LDB(B0, 1, 0); PG8_SCHED; PG8_LDA(At, 1, 0); PG8_STAGE(PG8_SA(0, 1), a2 + hstepA, voffA);
            PG8_WAIT_L(8); PG8_BAR; PG8_WAIT_L(0); PG8_MMA(0, 0, At, B0); PG8_BAR; PG8_SCHED;
            PG8_LDB(B1, 1, 1); PG8_STAGE(PG8_SB(1, 0), b3, voffB);
            PG8_BAR; PG8_WAIT_L(0); PG8_MMA(0, 1, At, B1); PG8_BAR;
            PG8_LDA(At, 1, 1); PG8_STAGE(PG8_SA(1, 0), a3, voffA);
            PG8_BAR; PG8_WAIT_L(0); PG8_MMA(1, 0, At, B0); PG8_BAR; PG8_SCHED;
            PG8_STAGE(PG8_SB(1, 1), b3 + hstep, voffB);
            PG8_WAIT_V(6); PG8_BAR; PG8_MMA(1, 1, At, B1); PG8_BAR;
            }
        }
        if constexpr (ALIGN_EPI) { if (wr == 0) PG8_BAR; }
        if constexpr (!Epi::AFTER_DRAIN) { E(acc, cur, wr, wc, fr, fq); S.done(cur); }
        if (!has_next) break;
#pragma unroll
        for (int a = 0; a < 2; ++a)
#pragma unroll
            for (int b = 0; b < 2; ++b)
#pragma unroll
                for (int m = 0; m < 4; ++m)
#pragma unroll
                    for (int n = 0; n < 2; ++n) acc[a][b][m][n] = (f32x4){0.f, 0.f, 0.f, 0.f};
        cur = nxt; cA = nA; cB = nB; ++ui;
        if constexpr (ALIGN_EPI) { if (wr == 1) PG8_BAR; }
    }
    PG8_WAIT_V(0);
    if constexpr (!ALIGN_EPI) { if (wr == 0) PG8_BAR; }
    PG8_BAR;
    if constexpr (Epi::AFTER_DRAIN) { E.fused(acc, cur, wr, wc, fr, fq, lds, wid, lane); S.done(cur); }
#undef PG8_SA
#undef PG8_SB
#undef PG8_STAGE
#undef PG8_LDA
#undef PG8_LDB
#undef PG8_MMA
#undef PG8_WAIT_V
#undef PG8_WAIT_L
#undef PG8_BAR
#undef PG8_SCHED
}
}
#define GAS __attribute__((address_space(1)))
#define LAS __attribute__((address_space(3)))
typedef unsigned short bf16;
typedef unsigned v4u __attribute__((ext_vector_type(4)));
typedef float f32x4 __attribute__((ext_vector_type(4)));
typedef short bf16x8 __attribute__((ext_vector_type(8)));
typedef GAS unsigned gu32;
typedef GAS unsigned long long gu64;
#define RLX_AGENT __ATOMIC_RELAXED, __HIP_MEMORY_SCOPE_AGENT
#define LDS_WAIT() asm volatile("s_waitcnt lgkmcnt(0)" ::: "memory")
#define VM_WAIT() asm volatile("s_waitcnt vmcnt(0)" ::: "memory")
__device__ __forceinline__ unsigned long long rt() { return __builtin_amdgcn_s_memrealtime(); }
__device__ __forceinline__ unsigned f2bf(float f) { unsigned u = __builtin_bit_cast(unsigned, f); return (u + 0x7fffu + ((u >> 16) & 1u)) >> 16; }
__device__ __forceinline__ unsigned pk2(float lo, float hi) { return f2bf(lo) | (f2bf(hi) << 16); }

#define XB_TMO      128
#define XB_XCNT(j)  (256  + 64 * (j))
#define XB_XSUB(j)  (1280 + 64 * (j))
#define XB_XGEN(j)  (2304 + 64 * (j))
#define XB_TOP      3328
#define XB_TOPGEN   3392
#define XCD_BAR_WORDS 3456
#define XB_SPIN_CAP (1u << 18)

__device__ __forceinline__ unsigned xb_ld(unsigned* p)              { return __hip_atomic_load(p, __ATOMIC_RELAXED, __HIP_MEMORY_SCOPE_AGENT); }
__device__ __forceinline__ unsigned xb_add(unsigned* p, unsigned v) { return __hip_atomic_fetch_add(p, v, __ATOMIC_RELAXED, __HIP_MEMORY_SCOPE_AGENT); }
__device__ __forceinline__ unsigned xb_xcc_id() { return (unsigned)__builtin_amdgcn_s_getreg((3 << 11) | 20) & 0xFu; }
#define XB_SPIN(cond, bar) do { unsigned _sp = 0; while (cond) { __builtin_amdgcn_s_sleep(1); \
    if ((++_sp & 255u) == 0u) { if (xb_ld(&(bar)[XB_TMO])) break; if (_sp > XB_SPIN_CAP) { atomicAdd(&(bar)[XB_TMO], 1u); break; } } } } while (0)

struct XcdBarrier {
    unsigned* bar; unsigned x;
    volatile LAS unsigned* st;
};

__device__ __forceinline__ XcdBarrier xcd_barrier_post(unsigned* bar, volatile LAS unsigned* st) {
    XcdBarrier b; b.bar = bar; b.x = xb_xcc_id(); b.st = st;
    if (threadIdx.x == 0) (void)xb_add(&bar[XB_XCNT(b.x)], 1u);
    return b;
}
__device__ __forceinline__ void xcd_barrier_complete(unsigned* bar, unsigned x, unsigned& nloc, unsigned& nx) {
    const unsigned G = gridDim.x * gridDim.y * gridDim.z;
    unsigned sum, cnt, mine, sp = 0u;
    for (;;) {
        sum = 0u; cnt = 0u; mine = 0u;
#pragma unroll
        for (unsigned j = 0; j < 16; ++j) { const unsigned c = xb_ld(&bar[XB_XCNT(j)]); sum += c; cnt += (c > 0u) ? 1u : 0u; mine = (j == x) ? c : mine; }
        if (sum == G) break;
        __builtin_amdgcn_s_sleep(1);
        if ((++sp & 255u) == 0u) { if (xb_ld(&bar[XB_TMO])) break; if (sp > XB_SPIN_CAP) { atomicAdd(&bar[XB_TMO], 1u); break; } }
    }
    nloc = mine > 0u ? mine : 1u; nx = cnt > 0u ? cnt : 1u;
}

__device__ __forceinline__ void xcd_barrier(const XcdBarrier& b) {
    asm volatile("s_waitcnt vmcnt(0)" ::: "memory");
    __syncthreads();
    if (threadIdx.x == 0) {
        unsigned* bar = b.bar;
        __builtin_amdgcn_s_waitcnt(0);
        unsigned nloc = b.st[0], nx = b.st[1];
        if (nloc == 0u) { xcd_barrier_complete(bar, b.x, nloc, nx); b.st[0] = nloc; b.st[1] = nx; }
        const unsigned old = xb_add(&bar[XB_XSUB(b.x)], 1u);
        const unsigned gen = old / nloc;
        if (old + 1u == (gen + 1u) * nloc) {
            __builtin_amdgcn_fence(__ATOMIC_RELEASE, "agent");
            asm volatile("s_waitcnt vmcnt(0)" ::: "memory");
            const unsigned og = xb_add(&bar[XB_TOP], 1u);
            const unsigned tg = og / nx;
            if (og + 1u == (tg + 1u) * nx) xb_add(&bar[XB_TOPGEN], 1u);
            else XB_SPIN(xb_ld(&bar[XB_TOPGEN]) == tg, bar);
            __builtin_amdgcn_fence(__ATOMIC_ACQUIRE, "agent");
            xb_add(&bar[XB_XGEN(b.x)], 1u);
            asm volatile("s_waitcnt vmcnt(0)" ::: "memory");
        } else {
            XB_SPIN(xb_ld(&bar[XB_XGEN(b.x)]) == gen, bar);
            __builtin_amdgcn_fence(__ATOMIC_ACQUIRE, "agent");
            asm volatile("s_waitcnt vmcnt(0)" ::: "memory");
        }
    }
    __syncthreads();
}

constexpr int NWAVES = 8, NTHR = 512;
constexpr int D = 1024, MCTX = 8192, MLAT = 16384, M = MCTX + MLAT, FF = 2816, NUP = 2 * FF, NIN = 2560, NMOD = 9 * D;
constexpr int LDQ = FF;
constexpr int NITEM = (M / 128) * 4;
constexpr float EPS = 1e-6f;
constexpr size_t MiB = 1u << 20;
constexpr size_t WS_CTL = 0, CTL_ZERO_BYTES = 65536;
constexpr size_t WS_MODS = 65536, WS_ROTC = 262144, WS_ROTS = 262144 + 8192;
constexpr size_t WS_BIASQ = 288 * 1024, WS_BIAS3 = 352 * 1024, WS_RROW = 512 * 1024;
constexpr size_t WS_SSPA = 42 * MiB + 262144, WS_SSPB = 255 * MiB;
constexpr size_t WS_W13A = 1 * MiB, WS_W13B = 12 * MiB, WS_W2A = 23 * MiB, WS_W2B = 29 * MiB, WS_WIN = 35 * MiB, WS_WOUT = 40 * MiB, WS_POOLW = 42 * MiB;
constexpr size_t WS_ABUF = 43 * MiB;
constexpr size_t WS_HBUF = 91 * MiB;
constexpr size_t WS_SLAT = 223 * MiB;
constexpr size_t WS_END = 255 * MiB;
constexpr int CW_BAR = 4096, CW_RANK = 8192, CW_LBAR = 10240, CW_SPLIT = 12288;
constexpr int LDS_BYTES = 147456, MISC_OFF = LDS_BYTES - 256;
constexpr int OUT_SF = M * D, OUT_SB = M * D + 32 * 4 * 128 * 128;
constexpr int RS = 272;

__device__ __forceinline__ float wave_sum(float v) {
#pragma unroll
    for (int o = 1; o < 64; o <<= 1) v += __shfl_xor(v, o);
    return v;
}
__device__ __forceinline__ unsigned cvtpk(float lo, float hi) { return pg8::cvt_pk_bf16(lo, hi); }
__device__ __forceinline__ float bflo(unsigned w) { return __uint_as_float(w << 16); }
__device__ __forceinline__ float bfhi(unsigned w) { return __uint_as_float(w & 0xffff0000u); }
#define EX2(x) __builtin_amdgcn_exp2f(x)
__device__ __forceinline__ v4u ld16_sc1(const void* p) {
    const unsigned long long a = __hip_atomic_load((const unsigned long long*)p, __ATOMIC_RELAXED, __HIP_MEMORY_SCOPE_AGENT), b = __hip_atomic_load((const unsigned long long*)p + 1, __ATOMIC_RELAXED, __HIP_MEMORY_SCOPE_AGENT);
    return (v4u){(unsigned)a, (unsigned)(a >> 32), (unsigned)b, (unsigned)(b >> 32)};
}
#define MFMA16(x, y, c) __builtin_amdgcn_mfma_f32_16x16x32_bf16((x), (y), (c), 0, 0, 0)

#define LANE_VARS int tid_o_ = threadIdx.x; asm volatile("" : "+v"(tid_o_)); const int tid = tid_o_, lane = tid & 63, fr = lane & 15, fq = lane >> 4; (void)fr; (void)fq
struct Args { const float* in[25]; float* out; unsigned char* ws; };

__device__ __forceinline__ void p0_transpose_item(const float* W, int K, int N, bf16* WT, int dst_row0, LAS float* scr, int k0, int n0, int lane) {
#pragma unroll 8
    for (int i = 0; i < 32; ++i) { const int kk = 2 * i + (lane >> 5); scr[kk * 33 + (lane & 31)] = W[(size_t)(k0 + kk) * N + n0 + (lane & 31)]; }
    LDS_WAIT(); asm volatile("" ::: "memory");
    const int c = lane & 7;
#pragma unroll
    for (int j = 0; j < 4; ++j) { const int n = (lane >> 3) + 8 * j; const LAS float* s = scr + (8 * c) * 33 + n;
        v4u o; o.x = pk2(s[0 * 33], s[1 * 33]); o.y = pk2(s[2 * 33], s[3 * 33]); o.z = pk2(s[4 * 33], s[5 * 33]); o.w = pk2(s[6 * 33], s[7 * 33]);
        *(GAS v4u*)(WT + (size_t)(dst_row0 + n) * K + k0 + 8 * c) = o; }
    LDS_WAIT(); asm volatile("" ::: "memory");
}
__device__ __forceinline__ int map_in(int c) {
    if (c < 1024) { const int base = c < 512 ? 0 : 1024, cc = c & 511, h = cc >> 7, d = cc & 127; return base + 256 * (h >> 1) + 128 * (d >> 6) + 64 * (h & 1) + (d & 63); }
    if (c < 1536) return 1536 + (c - 1024);
    if (c < 2048) return 512 + (c - 1536);
    return c;
}

template <bool FINAL>
__device__ __forceinline__ void norm_rows(const float* src0, const float* src1, const float* gamma, const float* mods, int sh_off, int sc_off, bf16* A, float* outF, int row_lo, int row_hi, int lw, int NLW, int lane) {
    for (int row = row_lo + lw; row < row_hi; row += NLW) {
        const bool lat = row >= MCTX; const int grp = lat ? 1 + ((row - MCTX) >> 12) : 0;
        const f32x4* xr = (const f32x4*)((lat ? src1 + (size_t)(row - MCTX) * D : src0 + (size_t)row * D)) + lane;
        f32x4 v[4]; float s = 0.f;
#pragma unroll
        for (int j = 0; j < 4; ++j) { v[j] = xr[64 * j]; s += (v[j].x * v[j].x + v[j].y * v[j].y) + (v[j].z * v[j].z + v[j].w * v[j].w); }
        const float r = 1.0f / sqrtf(wave_sum(s) * (1.f / D) + EPS);
#pragma unroll
        for (int j = 0; j < 4; ++j) { const int col = 4 * (lane + 64 * j); const f32x4 g = *(const f32x4*)(gamma + col);
            if (FINAL) { *(f32x4*)(outF + (size_t)row * D + col) = v[j] * r * g; }
            else { const f32x4 sc = *(const f32x4*)(mods + (size_t)grp * NMOD + sc_off + col), sh = *(const f32x4*)(mods + (size_t)grp * NMOD + sh_off + col);
                const f32x4 a = (v[j] * r * g) * (sc + 1.0f) + sh;
                *(unsigned long long*)(A + (size_t)row * D + col) = (unsigned long long)cvtpk(a.x, a.y) | ((unsigned long long)cvtpk(a.z, a.w) << 32); } }
    }
}

__device__ __forceinline__ void final_rows(float* out, const bf16* d3, const bf16* slabs, int t0, int ntl, int nfull, int xi32, const float* gamma, int row_lo, int row_hi, int lw, int NLW, int lane) {
    for (int row = row_lo + lw; row < row_hi; row += NLW) {
        f32x4* xr = (f32x4*)(out + (size_t)row * D) + lane; const unsigned long long* hr = (const unsigned long long*)(out + (size_t)row * D) + lane;
        const unsigned long long* dr = (const unsigned long long*)(d3 + (size_t)row * D) + lane;
        const int pml = (row >> 8) - t0, rl = row & 255;
        f32x4 v[4]; unsigned long long dv[4], sv[4]; float s = 0.f;
#pragma unroll
        for (int j = 0; j < 4; ++j) { { const unsigned long long hw = hr[64 * j]; const unsigned lo = (unsigned)hw, hi = (unsigned)(hw >> 32); v[j] = (f32x4){bflo(lo), bfhi(lo), bflo(hi), bfhi(hi)}; } dv[j] = dr[64 * j]; const int L = j * ntl + pml; sv[j] = 0ull;
            if (L >= nfull) sv[j] = *((const unsigned long long*)(slabs + (size_t)(xi32 + L - nfull) * 65536 + rl * 256) + lane); }
#pragma unroll
        for (int j = 0; j < 4; ++j) { const unsigned lo = (unsigned)dv[j], hi = (unsigned)(dv[j] >> 32), lo2 = (unsigned)sv[j], hi2 = (unsigned)(sv[j] >> 32);
            v[j] = v[j] + ((f32x4){bflo(lo), bfhi(lo), bflo(hi), bfhi(hi)} + (f32x4){bflo(lo2), bfhi(lo2), bflo(hi2), bfhi(hi2)});
            s += (v[j].x * v[j].x + v[j].y * v[j].y) + (v[j].z * v[j].z + v[j].w * v[j].w); }
        const float r = 1.0f / sqrtf(wave_sum(s) * (1.f / D) + EPS);
#pragma unroll
        for (int j = 0; j < 4; ++j) { const f32x4 g = *(const f32x4*)(gamma + 4 * (lane + 64 * j)); xr[64 * j] = v[j] * r * g; }
    }
}

__device__ __forceinline__ void stage_nat(LAS unsigned char* dst, const bf16* src, int ld, int tid) {
#pragma unroll
    for (int i = 0; i < 4; ++i) { const int c = tid + NTHR * i, row = c >> 4, cc = c & 15; *(LAS v4u*)(dst + row * RS + cc * 16) = *(const v4u*)(src + (size_t)row * ld + cc * 8); }
}


__device__ __forceinline__ void stage_zero(LAS unsigned char* dst, int tid) {
#pragma unroll
    for (int i = 0; i < 4; ++i) { const int c = tid + NTHR * i, row = c >> 4, cc = c & 15; *(LAS v4u*)(dst + row * RS + cc * 16) = (v4u){0u, 0u, 0u, 0u}; }
}


__device__ __forceinline__ void xcc_barrier(unsigned* lw, unsigned nloc, unsigned* tmo) {
    asm volatile("s_waitcnt vmcnt(0)" ::: "memory");
    __syncthreads();
    if (threadIdx.x == 0) {
        const unsigned old = xb_add(lw, 1u), gen = old / nloc;
        if (old + 1u == (gen + 1u) * nloc) xb_add(lw + 64, 1u);
        else XB_SPIN(xb_ld(lw + 64) == gen, tmo);
        __builtin_amdgcn_fence(__ATOMIC_ACQUIRE, "agent");
        asm volatile("s_waitcnt vmcnt(0)" ::: "memory");
    }
    __syncthreads();
}

__global__ void __launch_bounds__(NTHR, 2) hyb_fwd(Args args) {
    extern __shared__ __attribute__((aligned(16))) unsigned char lds_raw[];
    LAS unsigned char* lds = (LAS unsigned char*)lds_raw;
    volatile LAS unsigned* MISC = (volatile LAS unsigned*)(lds + MISC_OFF);
    const int tid = threadIdx.x, lane = tid & 63, wave = __builtin_amdgcn_readfirstlane(tid >> 6), fr = lane & 15, fq = lane >> 4;
    const int G = gridDim.x, bx = blockIdx.x;
    const int gw = bx * NWAVES + wave, NGW = G * NWAVES;
    unsigned char* ws = args.ws;
    if (tid < 64) MISC[tid] = 0u;
    __syncthreads();
    XcdBarrier bar = xcd_barrier_post((unsigned*)(ws + WS_CTL) + CW_BAR, MISC + 8);
    if (tid == 0) MISC[16] = __hip_atomic_fetch_add((unsigned*)(ws + WS_CTL) + CW_RANK + 64 * bar.x, 1u, __ATOMIC_RELAXED, __HIP_MEMORY_SCOPE_AGENT);

    const float* x_ctx = args.in[0]; const float* x_lat = args.in[1];
    float* mods = (float*)(ws + WS_MODS); float* rotc = (float*)(ws + WS_ROTC); float* rots = (float*)(ws + WS_ROTS);
    bf16* W13A = (bf16*)(ws + WS_W13A); bf16* W13B = (bf16*)(ws + WS_W13B); bf16* W2A = (bf16*)(ws + WS_W2A); bf16* W2B = (bf16*)(ws + WS_W2B);
    bf16* WIN = (bf16*)(ws + WS_WIN); bf16* WOUT = (bf16*)(ws + WS_WOUT); bf16* POOLW = (bf16*)(ws + WS_POOLW);
    bf16* ABUF = (bf16*)(ws + WS_ABUF); bf16* HBUF = (bf16*)(ws + WS_HBUF); bf16* SBUF = ABUF; bf16* QKV = HBUF; bf16* SLAT = (bf16*)(ws + WS_SLAT);
    float* out = args.out;
    float* biasq = (float*)(ws + WS_BIASQ); float* bias3 = (float*)(ws + WS_BIAS3); float* rrow = (float*)(ws + WS_RROW); float* sspa = (float*)(ws + WS_SSPA); float* sspb = (float*)(ws + WS_SSPB);

    {
        LANE_VARS;
        LAS float* scr = (LAS float*)(lds + wave * 16384);
        constexpr int I_W1 = 16 * 88, I_W2 = 44 * 32, I_IN = 16 * 80, I_OUT = 16 * 32, I_POOL = 32;
        constexpr int NITEMS = 4 * I_W1 + 2 * I_W2 + I_IN + I_OUT + I_POOL;
        for (int it = gw; it < NITEMS; it += NGW) {
            int r = it;
            if (r < 4 * I_W1) { const int which = r / I_W1; r -= which * I_W1; const int kb = r / 88, nb = r % 88, n0 = 32 * nb;
                const float* src = args.in[which == 0 ? 9 : which == 1 ? 10 : which == 2 ? 21 : 22]; bf16* dst = which < 2 ? W13A : W13B;
                p0_transpose_item(src, D, FF, dst, 256 * (n0 >> 7) + 128 * (which & 1) + (n0 & 127), scr, 64 * kb, n0, lane); continue; }
            r -= 4 * I_W1;
            if (r < 2 * I_W2) { const int which = r / I_W2; r -= which * I_W2; const int kb = r / 32, nb = r % 32;
                p0_transpose_item(args.in[which ? 23 : 11], FF, D, which ? W2B : W2A, 32 * nb, scr, 64 * kb, 32 * nb, lane); continue; }
            r -= 2 * I_W2;
            if (r < I_IN) { const int kb = r / 80, nb = r % 80; p0_transpose_item(args.in[13], D, NIN, WIN, map_in(32 * nb), scr, 64 * kb, 32 * nb, lane); continue; }
            r -= I_IN;
            if (r < I_OUT) { const int kb = r / 32, nb = r % 32; p0_transpose_item(args.in[19], D, D, WOUT, 32 * nb, scr, 64 * kb, 32 * nb, lane); continue; }
            r -= I_OUT;
            { const int g = r >> 3, kb = (r >> 2) & 1, nb = r & 3; p0_transpose_item(args.in[17] + g * 16384, 128, 128, POOLW + g * 16384, 32 * nb, scr, 64 * kb, 32 * nb, lane); }
        }
        { const int gt = bx * NTHR + tid;
          if (gt < 2048) { const int pos = gt >> 5, f = gt & 31; double fr_ = 1.0; for (int i = 0; i < f; ++i) fr_ *= 0.7498942093324559;
              const double a = (double)pos * fr_; const double n = __builtin_rint(a * 0.15915494309189535); const double rr = a - n * 6.283185307179586; const double r2 = rr * rr;
              double cs = 1.0, sn = 1.0;
              for (int k = 13; k >= 1; --k) { cs = 1.0 - cs * r2 / (double)((2 * k - 1) * (2 * k)); sn = 1.0 - sn * r2 / (double)((2 * k) * (2 * k + 1)); }
              rotc[gt] = (float)cs; rots[gt] = (float)(sn * rr); } }
        __syncthreads();
        LAS float* scond = (LAS float*)lds;
        LAS float* red = (LAS float*)(lds + 5 * 1024 * 4);
        for (int i = tid; i < 5 * D; i += NTHR) { const int g = i >> 10, k = i & 1023; const float cv = g == 0 ? args.in[5][k] : args.in[4][(g - 1) * D + k]; scond[i] = cv / (1.0f + expf(-cv)); }
        __syncthreads();
        const float* ada_w = args.in[6]; const float* ada_b = args.in[7];
        for (int it = bx; it < NMOD / 32; it += G) {
            const int c0 = 32 * it, col = lane & 31, kp = lane >> 5; float a0 = 0.f, a1 = 0.f, a2 = 0.f, a3 = 0.f, a4 = 0.f;
#pragma unroll 8
            for (int i = 0; i < 64; ++i) { const int k = 128 * wave + 2 * i + kp; const float wv = ada_w[(size_t)k * NMOD + c0 + col];
                a0 += scond[k] * wv; a1 += scond[1024 + k] * wv; a2 += scond[2048 + k] * wv; a3 += scond[3072 + k] * wv; a4 += scond[4096 + k] * wv; }
            a0 += __shfl_xor(a0, 32); a1 += __shfl_xor(a1, 32); a2 += __shfl_xor(a2, 32); a3 += __shfl_xor(a3, 32); a4 += __shfl_xor(a4, 32);
            if (lane < 32) { LAS float* rp = red + wave * 160 + col; rp[0] = a0; rp[32] = a1; rp[64] = a2; rp[96] = a3; rp[128] = a4; }
            __syncthreads();
            if (tid < 160) { float s = 0.f;
#pragma unroll
                for (int w = 0; w < 8; ++w) s += red[w * 160 + tid];
                const int g = tid >> 5, cc = tid & 31; mods[(size_t)g * NMOD + c0 + cc] = s + ada_b[c0 + cc]; }
            __syncthreads();
        }
    }
    xcd_barrier(bar);

    if (threadIdx.x == 0) { unsigned xi_ = 0, nx_ = 0; unsigned* bw = (unsigned*)(ws + WS_CTL) + CW_BAR;
        for (unsigned j = 0; j < 16; ++j) { const unsigned c = xb_ld(&bw[XB_XCNT(j)]); if (c) { if (j < bar.x) ++xi_; ++nx_; } }
        MISC[17] = xi_; MISC[18] = nx_; MISC[19] = xb_ld(&bw[XB_XCNT(bar.x)]); }
    __syncthreads();
    const int rank = __builtin_amdgcn_readfirstlane((int)MISC[16]), xi = __builtin_amdgcn_readfirstlane((int)MISC[17]), nx = __builtin_amdgcn_readfirstlane((int)MISC[18]), nloc = __builtin_amdgcn_readfirstlane((int)MISC[19]);
    const int t0 = (96 * xi) / nx, t1 = (96 * (xi + 1)) / nx;
    const int lwv = rank * NWAVES + wave, NLW = nloc * NWAVES;
    unsigned* const lbw = (unsigned*)(ws + WS_CTL) + CW_LBAR + 128 * bar.x;
#define LOCAL_BAR() xcc_barrier(lbw, (unsigned)nloc, (unsigned*)(ws + WS_CTL) + CW_BAR)
    const int nitl = (t1 - t0) * 8;

    { LANE_VARS;
    for (int rw = gw; rw < NIN + NUP; rw += NGW) {
        const bool isq = rw < NIN; const int n = isq ? rw : rw - NIN; const bf16* wrow = (isq ? WIN : W13B) + (size_t)n * D + 16 * lane;
        const v4u w0 = *(const v4u*)wrow, w1 = *(const v4u*)(wrow + 8); float wv[16];
#pragma unroll
        for (int q = 0; q < 4; ++q) { wv[2 * q] = bflo(w0[q]); wv[2 * q + 1] = bfhi(w0[q]); wv[8 + 2 * q] = bflo(w1[q]); wv[8 + 2 * q + 1] = bfhi(w1[q]); }
        const float* shp = mods + (isq ? 3072 : 6144) + 16 * lane;
#pragma unroll
        for (int g = 0; g < 5; ++g) { float a = 0.f;
#pragma unroll
            for (int q = 0; q < 4; ++q) { const f32x4 sv = *(const f32x4*)(shp + (size_t)g * NMOD + 4 * q); a += (sv[0] * wv[4 * q] + sv[1] * wv[4 * q + 1]) + (sv[2] * wv[4 * q + 2] + sv[3] * wv[4 * q + 3]); }
            a = wave_sum(a); if (lane == 0) (isq ? biasq + g * NIN : bias3 + g * NUP)[n] = a; }
    }
    norm_rows<false>(x_ctx, x_lat, args.in[8], mods, 0, 1024, ABUF, nullptr, 256 * t0, 256 * t1, lwv, NLW, lane); }
    xcd_barrier(bar);

    { pg8::Gemm g{ABUF, W13A, M, NUP, D, D, D}; pg8::AffOrder S; S.init(t0, t1, NUP, nloc, rank); pg8::EpiSwiglu E{HBUF, FF, nullptr, nullptr};
      pg8::gemm_phase<pg8::EpiSwiglu, pg8::AffOrder, true, true>(lds, g, S, E); }
    LOCAL_BAR();
    { pg8::Gemm g{HBUF, W2A, M, D, FF, FF, FF}; pg8::AffOrder S; S.init(t0, t1, D, nloc, rank, 0); pg8::EpiResid E{x_ctx, x_lat, nullptr, (bf16*)out, mods + 2048, 1, ABUF, args.in[12], mods + 4096, sspa, sspb};
      pg8::gemm_phase<pg8::EpiResid, pg8::AffOrder, true, true>(lds, g, S, E); }
    LOCAL_BAR();
    { int tt_ = threadIdx.x; asm volatile("" : "+v"(tt_));
    for (int r = 256 * t0 + rank * NTHR + tt_; r < 256 * t1; r += nloc * NTHR) { const f32x4 a0 = *(const f32x4*)(sspa + (size_t)r * 8), a1 = *(const f32x4*)(sspa + (size_t)r * 8 + 4), b0 = *(const f32x4*)(sspb + (size_t)r * 8), b1 = *(const f32x4*)(sspb + (size_t)r * 8 + 4);
        const float ssq = (((a0[0] + a0[1]) + (a0[2] + a0[3])) + ((a1[0] + a1[1]) + (a1[2] + a1[3]))) + (((b0[0] + b0[1]) + (b0[2] + b0[3])) + ((b1[0] + b1[1]) + (b1[2] + b1[3])));
        rrow[r] = 1.0f / sqrtf(ssq * (1.f / D) + EPS); } }
    LOCAL_BAR();
    { pg8::Gemm g{ABUF, WIN, M, NIN, D, D, D}; pg8::AffOrder S; S.init(t0, t1, NIN, nloc, rank); pg8::EpiQKV E{QKV, LDQ, rotc, rots, rrow, biasq};
      pg8::gemm_phase<pg8::EpiQKV, pg8::AffOrder, true, true>(lds, g, S, E); }
    LOCAL_BAR();

    {
        LANE_VARS;
        LAS unsigned char* KT = lds; LAS unsigned char* VFT = lds + 128 * RS; LAS unsigned char* VBT = lds + 2 * 128 * RS;
        for (int li = rank; li < nitl; li += nloc) {
            const int item = 8 * t0 + li, cg = item >> 2, h = item & 3, row0 = cg * 128;
            const float l2f = -expf(args.in[14][h]) * 1.4426950408889634f, l2b = -expf(args.in[15][h]) * 1.4426950408889634f;
            const int jp = 16 * (wave & 3) + (lane & 15), j0 = 2 * jp;
            const float wf0 = EX2(l2f * (float)(127 - j0)), wf1 = EX2(l2f * (float)(126 - j0)), wb0 = EX2(l2b * (float)j0), wb1 = EX2(l2b * (float)(j0 + 1));
#pragma unroll
            for (int pass = 0; pass < 2; ++pass) {
                const int c0 = 8 * (4 * (wave >> 2) + (lane >> 4) + 8 * pass);
                const bf16* kr = QKV + (size_t)(row0 + j0) * LDQ + 1024 + h * 128 + c0; const bf16* vr = kr + 512;
                const v4u ka = *(const v4u*)kr, kb = *(const v4u*)(kr + LDQ), va = *(const v4u*)vr, vb = *(const v4u*)(vr + LDQ);
#pragma unroll
                for (int q = 0; q < 4; ++q) {
                    const unsigned a = ka[q], b = kb[q], c = va[q], d = vb[q];
                    const int r0 = (c0 + 2 * q) * RS + jp * 4, r1 = r0 + RS;
                    *(LAS unsigned*)(KT + r0) = (a & 0xffffu) | (b << 16); *(LAS unsigned*)(KT + r1) = (a >> 16) | (b & 0xffff0000u);
                    const float v00 = bflo(c), v01 = bfhi(c), v10 = bflo(d), v11 = bfhi(d);
                    *(LAS unsigned*)(VFT + r0) = cvtpk(v00 * wf0, v10 * wf1); *(LAS unsigned*)(VFT + r1) = cvtpk(v01 * wf0, v11 * wf1);
                    *(LAS unsigned*)(VBT + r0) = cvtpk(v00 * wb0, v10 * wb1); *(LAS unsigned*)(VBT + r1) = cvtpk(v01 * wb0, v11 * wb1);
                }
            }
            __syncthreads();
            f32x4 af[8], ab[8];
#pragma unroll
            for (int dt = 0; dt < 8; ++dt) { af[dt] = (f32x4){0.f, 0.f, 0.f, 0.f}; ab[dt] = (f32x4){0.f, 0.f, 0.f, 0.f}; }
#pragma unroll
            for (int kk = 0; kk < 4; ++kk) {
                const int ko = (32 * kk + 8 * fq) * 2;
                const bf16x8 yf = *(const LAS bf16x8*)(VFT + (16 * wave + fr) * RS + ko), yb = *(const LAS bf16x8*)(VBT + (16 * wave + fr) * RS + ko);
#pragma unroll
                for (int dt = 0; dt < 8; ++dt) { const bf16x8 xk = *(const LAS bf16x8*)(KT + (16 * dt + fr) * RS + ko); af[dt] = MFMA16(xk, yf, af[dt]); ab[dt] = MFMA16(xk, yb, ab[dt]); }
            }
            bf16* sf = SBUF + ((size_t)item * 2) * 16384 + (16 * wave + fr) * 128 + 4 * fq; bf16* sb = sf + 16384;
#pragma unroll
            for (int dt = 0; dt < 8; ++dt) {
                *(unsigned long long*)(sf + 16 * dt) = (unsigned long long)cvtpk(af[dt][0], af[dt][1]) | ((unsigned long long)cvtpk(af[dt][2], af[dt][3]) << 32);
                *(unsigned long long*)(sb + 16 * dt) = (unsigned long long)cvtpk(ab[dt][0], ab[dt][1]) | ((unsigned long long)cvtpk(ab[dt][2], ab[dt][3]) << 32);
            }
            __syncthreads();
        }
    }
    xcd_barrier(bar);

    {
        LANE_VARS;
        const int gt = bx * NTHR + tid, GT = G * NTHR;
        { LAS float* T = (LAS float*)lds;
          for (int tile = bx; tile < 256; tile += G) {
            const int b = tile >> 3, h = (tile >> 1) & 3, dir = tile & 1;
            const float gC = exp2f(-expf(args.in[dir ? 15 : 14][h]) * 1.4426950408889634f * 128.0f);
            const bf16* k0p = SBUF + (((size_t)(2 * b) * 4 + h) * 2 + dir) * 16384; const bf16* k1p = SBUF + (((size_t)(2 * b + 1) * 4 + h) * 2 + dir) * 16384;
#pragma unroll
            for (int i = 0; i < 4; ++i) { const int c = tid + NTHR * i, dv = c >> 4, dk0 = (c & 15) * 8; const v4u a = *(const v4u*)(k0p + c * 8), bb = *(const v4u*)(k1p + c * 8);
#pragma unroll
                for (int q = 0; q < 4; ++q) { const float a0 = bflo(a[q]), a1 = bfhi(a[q]), b0 = bflo(bb[q]), b1 = bfhi(bb[q]);
                    T[dv * 129 + dk0 + 2 * q] = dir ? b0 * gC + a0 : a0 * gC + b0; T[dv * 129 + dk0 + 2 * q + 1] = dir ? b1 * gC + a1 : a1 * gC + b1; } }
            __syncthreads();
            float* op = out + (dir ? OUT_SB : OUT_SF) + (size_t)(b * 4 + h) * 16384;
#pragma unroll
            for (int i = 0; i < 8; ++i) { const int c = tid + NTHR * i, dk = c >> 5, dv0 = (c & 31) * 4;
                *(f32x4*)(op + dk * 128 + dv0) = (f32x4){T[dv0 * 129 + dk], T[(dv0 + 1) * 129 + dk], T[(dv0 + 2) * 129 + dk], T[(dv0 + 3) * 129 + dk]}; }
            __syncthreads();
          } }
        for (int task = gt; task < 4 * 4 * 2 * 2048; task += GT) {
            const int e8 = task & 2047, dir = (task >> 11) & 1, h = (task >> 12) & 3, b = task >> 14;
            float carry[8];
            { const float* s0 = args.in[dir ? 3 : 2] + ((size_t)b * 4 + h) * 16384; const int dv = e8 >> 4, dk0 = (e8 & 15) * 8;
#pragma unroll
              for (int e = 0; e < 8; ++e) carry[e] = s0[(dk0 + e) * 128 + dv]; }
            const float gC = exp2f(-expf(args.in[dir ? 15 : 14][h]) * 1.4426950408889634f * 128.0f);
            for (int sb = 0; sb < 32; sb += 8) {
                v4u kv[8];
#pragma unroll
                for (int i = 0; i < 8; ++i) { const int n = dir ? 31 - (sb + i) : sb + i; kv[i] = *(const v4u*)(SBUF + (((size_t)(64 + 32 * b + n) * 4 + h) * 2 + dir) * 16384 + e8 * 8); }
#pragma unroll
                for (int i = 0; i < 8; ++i) { const int n = dir ? 31 - (sb + i) : sb + i;
                    v4u o; o.x = cvtpk(carry[0], carry[1]); o.y = cvtpk(carry[2], carry[3]); o.z = cvtpk(carry[4], carry[5]); o.w = cvtpk(carry[6], carry[7]);
                    *(v4u*)(SLAT + (((size_t)(32 * b + n) * 4 + h) * 2 + dir) * 16384 + e8 * 8) = o;
#pragma unroll
                    for (int q = 0; q < 4; ++q) { carry[2 * q] = carry[2 * q] * gC + bflo(kv[i][q]); carry[2 * q + 1] = carry[2 * q + 1] * gC + bfhi(kv[i][q]); } }
            }
        }
    }
    xcd_barrier(bar);

    {
        LANE_VARS;
        LAS unsigned char* KP = lds; LAS unsigned char* VT = lds + 128 * RS; LAS unsigned char* SFT = lds + 2 * 128 * RS; LAS unsigned char* SBT = lds + 3 * 128 * RS;
        LAS unsigned char* US = lds; LAS unsigned char* WT = lds + 2 * 128 * RS;
        for (int li = rank; li < nitl; li += nloc) {
            const int item = 8 * t0 + li, cg = item >> 2, h = item & 3, row0 = cg * 128;
            const bool lat = cg >= 64; const int n = lat ? (cg - 64) & 31 : cg & 1, L = lat ? 4096 : 256, seq_row0 = row0 - n * 128;
            const float l2f = -expf(args.in[14][h]) * 1.4426950408889634f, l2b = -expf(args.in[15][h]) * 1.4426950408889634f;
            stage_nat(KP, QKV + (size_t)row0 * LDQ + 1024 + h * 128, LDQ, tid);
            if (lat) { stage_nat(SFT, SLAT + ((size_t)(item - 256) * 2) * 16384, 128, tid); stage_nat(SBT, SLAT + ((size_t)(item - 256) * 2 + 1) * 16384, 128, tid); }
            else if (n == 0) { stage_zero(SFT, tid); stage_nat(SBT, SBUF + ((size_t)(item + 4) * 2 + 1) * 16384, 128, tid); }
            else { stage_nat(SFT, SBUF + ((size_t)(item - 4) * 2) * 16384, 128, tid); stage_zero(SBT, tid); }
            { const int jp = 16 * (wave & 3) + (lane & 15), j0 = 2 * jp;
#pragma unroll
              for (int pass = 0; pass < 2; ++pass) { const int c0 = 8 * (4 * (wave >> 2) + (lane >> 4) + 8 * pass);
                  const bf16* vr = QKV + (size_t)(row0 + j0) * LDQ + 1536 + h * 128 + c0; const v4u va = *(const v4u*)vr, vb = *(const v4u*)(vr + LDQ);
#pragma unroll
                  for (int q = 0; q < 4; ++q) { const unsigned a = va[q], b = vb[q]; const int r0 = (c0 + 2 * q) * RS + jp * 4;
                      *(LAS unsigned*)(VT + r0) = (a & 0xffffu) | (b << 16); *(LAS unsigned*)(VT + r0 + RS) = (a >> 16) | (b & 0xffff0000u); } } }
            const int il = 16 * wave + fr, row = row0 + il;
            bf16x8 yq[4];
#pragma unroll
            for (int kk = 0; kk < 4; ++kk) yq[kk] = *(const bf16x8*)(QKV + (size_t)row * LDQ + h * 128 + 32 * kk + 8 * fq);
            __syncthreads();
            f32x4 sc[8];
#pragma unroll
            for (int jt = 0; jt < 8; ++jt) { sc[jt] = (f32x4){0.f, 0.f, 0.f, 0.f};
#pragma unroll
                for (int kk = 0; kk < 4; ++kk) sc[jt] = MFMA16(*(const LAS bf16x8*)(KP + (16 * jt + fr) * RS + (32 * kk + 8 * fq) * 2), yq[kk], sc[jt]); }
#pragma unroll
            for (int jt = 0; jt < 8; ++jt)
#pragma unroll
                for (int i = 0; i < 4; ++i) { const int j = 16 * jt + 4 * fq + i, dl = il - j; const float w = dl > 0 ? EX2(l2f * (float)dl) : (dl < 0 ? EX2(l2b * (float)(-dl)) : 2.0f); sc[jt][i] *= w; }
            __syncthreads();
#pragma unroll
            for (int jt = 0; jt < 8; ++jt) *(LAS unsigned long long*)(KP + il * RS + (16 * jt + 4 * fq) * 2) = (unsigned long long)cvtpk(sc[jt][0], sc[jt][1]) | ((unsigned long long)cvtpk(sc[jt][2], sc[jt][3]) << 32);
            __syncthreads();
            f32x4 oi[8];
#pragma unroll
            for (int dt = 0; dt < 8; ++dt) oi[dt] = (f32x4){0.f, 0.f, 0.f, 0.f};
            const float cfw = EX2(l2f * (float)(il + 1)), cbw = EX2(l2b * (float)(128 - il));
#pragma unroll 1
            for (int kk = 0; kk < 4; ++kk) { const int ko = (32 * kk + 8 * fq) * 2; const bf16x8 yp = *(const LAS bf16x8*)(KP + il * RS + ko);
                const v4u qw = *(const v4u*)(QKV + (size_t)row * LDQ + h * 128 + 32 * kk + 8 * fq); v4u qf, qb;
#pragma unroll
                for (int q = 0; q < 4; ++q) { const float lo = bflo(qw[q]), hi = bfhi(qw[q]); qf[q] = cvtpk(lo * cfw, hi * cfw); qb[q] = cvtpk(lo * cbw, hi * cbw); }
                const bf16x8 yqf = __builtin_bit_cast(bf16x8, qf), yqb = __builtin_bit_cast(bf16x8, qb);
#pragma unroll
                for (int dt = 0; dt < 8; ++dt) { const int ro = (16 * dt + fr) * RS + ko;
                    oi[dt] = MFMA16(*(const LAS bf16x8*)(VT + ro), yp, oi[dt]); oi[dt] = MFMA16(*(const LAS bf16x8*)(SFT + ro), yqf, oi[dt]); oi[dt] = MFMA16(*(const LAS bf16x8*)(SBT + ro), yqb, oi[dt]); } }
            float ss = 0.f;
#pragma unroll
            for (int dt = 0; dt < 8; ++dt) ss += (oi[dt][0] * oi[dt][0] + oi[dt][1] * oi[dt][1]) + (oi[dt][2] * oi[dt][2] + oi[dt][3] * oi[dt][3]);
            ss += __shfl_xor(ss, 16); ss += __shfl_xor(ss, 32);
            const float rn = 1.0f / sqrtf(ss * (1.0f / 128.0f) + EPS);
            { bf16* qrow = QKV + (size_t)row * LDQ + h * 128 + 4 * fq; const bf16* grow = qrow + 512; const float* gn = args.in[16] + h * 128 + 4 * fq;
#pragma unroll
              for (int dt = 0; dt < 8; ++dt) { const unsigned long long gw_ = *(const unsigned long long*)(grow + 16 * dt); const f32x4 g4 = *(const f32x4*)(gn + 16 * dt);
                  const unsigned g01 = (unsigned)gw_, g23 = (unsigned)(gw_ >> 32);
                  const float r0 = oi[dt][0] * rn * g4[0] * pg8::silu_f(bflo(g01)), r1 = oi[dt][1] * rn * g4[1] * pg8::silu_f(bfhi(g01));
                  const float r2 = oi[dt][2] * rn * g4[2] * pg8::silu_f(bflo(g23)), r3 = oi[dt][3] * rn * g4[3] * pg8::silu_f(bfhi(g23));
                  *(unsigned long long*)(qrow + 16 * dt) = (unsigned long long)cvtpk(r0, r1) | ((unsigned long long)cvtpk(r2, r3) << 32); } }
            __syncthreads();
            { const int half = 1 << h;
              for (int c = tid; c < 144 * 16; c += NTHR) { const int lr = c >> 4, cc = c & 15, pos = n * 128 - 8 + lr; v4u v = (v4u){0u, 0u, 0u, 0u};
                  if (pos >= 0 && pos < L) v = *(const v4u*)(QKV + (size_t)(seq_row0 + pos) * LDQ + 2048 + h * 128 + cc * 8);
                  *(LAS v4u*)(US + lr * RS + cc * 16) = v; }
              stage_nat(WT, POOLW + h * 16384, 128, tid);
              __syncthreads();
              const int pos = n * 128 + il, lo = pos - half > 0 ? pos - half : 0, hi = pos + half < L ? pos + half : L; const float inv = 1.0f / (float)(hi - lo);
              bf16x8 yd[4];
#pragma unroll
              for (int kk = 0; kk < 4; ++kk) { const int co = (32 * kk + 8 * fq) * 2; float s[8];
#pragma unroll
                  for (int e = 0; e < 8; ++e) s[e] = 0.f;
                  for (int dd = -half; dd < half; ++dd) { const v4u v = *(const LAS v4u*)(US + (il + 8 + dd) * RS + co);
#pragma unroll
                      for (int q = 0; q < 4; ++q) { s[2 * q] += bflo(v[q]); s[2 * q + 1] += bfhi(v[q]); } }
                  const v4u cv = *(const LAS v4u*)(US + (il + 8) * RS + co); v4u dq;
#pragma unroll
                  for (int q = 0; q < 4; ++q) dq[q] = cvtpk(s[2 * q] * inv - bflo(cv[q]), s[2 * q + 1] * inv - bfhi(cv[q]));
                  yd[kk] = __builtin_bit_cast(bf16x8, dq); }
              f32x4 po[8];
#pragma unroll
              for (int dt = 0; dt < 8; ++dt) { po[dt] = (f32x4){0.f, 0.f, 0.f, 0.f};
#pragma unroll
                  for (int kk = 0; kk < 4; ++kk) po[dt] = MFMA16(*(const LAS bf16x8*)(WT + (16 * dt + fr) * RS + (32 * kk + 8 * fq) * 2), yd[kk], po[dt]); }
              bf16* prow = QKV + (size_t)row * LDQ + 512 + h * 128 + 4 * fq; const float* ps = args.in[18] + h * 128 + 4 * fq;
#pragma unroll
              for (int dt = 0; dt < 8; ++dt) { const f32x4 p4 = *(const f32x4*)(ps + 16 * dt);
                  *(unsigned long long*)(prow + 16 * dt) = (unsigned long long)cvtpk(po[dt][0] * p4[0], po[dt][1] * p4[1]) | ((unsigned long long)cvtpk(po[dt][2] * p4[2], po[dt][3] * p4[3]) << 32); }
            }
            __syncthreads();
        }
    }
    xcd_barrier(bar);

    { pg8::Gemm g{QKV, WOUT, M, D, D, LDQ, D}; pg8::AffOrder S; S.init(t0, t1, D, nloc, rank, 0); pg8::EpiResid E{nullptr, nullptr, (const bf16*)out, (bf16*)out, mods + 5120, 2, ABUF, args.in[20], mods + 7168, sspa, sspb};
      pg8::gemm_phase<pg8::EpiResid, pg8::AffOrder, true, true>(lds, g, S, E); }
    LOCAL_BAR();
    { int tt_ = threadIdx.x; asm volatile("" : "+v"(tt_));
    for (int r = 256 * t0 + rank * NTHR + tt_; r < 256 * t1; r += nloc * NTHR) { const f32x4 a0 = *(const f32x4*)(sspa + (size_t)r * 8), a1 = *(const f32x4*)(sspa + (size_t)r * 8 + 4), b0 = *(const f32x4*)(sspb + (size_t)r * 8), b1 = *(const f32x4*)(sspb + (size_t)r * 8 + 4);
        const float ssq = (((a0[0] + a0[1]) + (a0[2] + a0[3])) + ((a1[0] + a1[1]) + (a1[2] + a1[3]))) + (((b0[0] + b0[1]) + (b0[2] + b0[3])) + ((b1[0] + b1[1]) + (b1[2] + b1[3])));
        rrow[r] = 1.0f / sqrtf(ssq * (1.f / D) + EPS); } }
    LOCAL_BAR();
    { pg8::Gemm g{ABUF, W13B, M, NUP, D, D, D}; pg8::AffOrder S; S.init(t0, t1, NUP, nloc, rank); pg8::EpiSwiglu E{HBUF, FF, rrow, bias3};
      pg8::gemm_phase<pg8::EpiSwiglu, pg8::AffOrder, true, true>(lds, g, S, E); }
    LOCAL_BAR();
    { const int ntot = (t1 - t0) * (D / 256), tail_raw = ntot % nloc; const bool split_ok = tail_raw > 0 && tail_raw <= 32 && xi < 8;
      const int nfull = split_ok ? ntot - tail_raw : ntot, xi32 = xi * 32;
      pg8::EpiDelta E{ABUF, mods + 8192, SLAT, t0, t1 - t0, nfull, xi32};
      { pg8::Gemm g{HBUF, W2B, M, D, FF, FF, FF}; pg8::SegOrder S; S.init(t0, t1, D, nloc, rank, nfull, 0); pg8::gemm_phase<pg8::EpiDelta, pg8::SegOrder, true, true>(lds, g, S, E); }
      { pg8::Gemm g{HBUF, W2B, M, D, FF, FF, FF / 2}; pg8::SegOrder S; S.init(t0, t1, D, nloc, rank, nfull, 1); pg8::gemm_phase<pg8::EpiDelta, pg8::SegOrder, true, true>(lds, g, S, E); }
      LOCAL_BAR();
      final_rows(out, ABUF, SLAT, t0, t1 - t0, nfull, xi32, args.in[24], 256 * t0, 256 * t1, lwv, NLW, (int)(threadIdx.x & 63)); }
}

extern "C" void kernel_launch(void* const* d_in, const int* in_sizes, int n_in, void* d_out, int out_size, void* d_ws, size_t ws_size, hipStream_t stream) {
    static int grid = 0;
    if (grid == 0) {
        if (n_in != 25 || in_sizes[0] != MCTX * D || in_sizes[1] != MLAT * D || out_size != M * D + 2 * 32 * 4 * 128 * 128 || ws_size < 256 * MiB) {
            fprintf(stderr, "kernel_launch: unexpected shapes (n_in %d, out %d, ws %zu); nothing launched\n", n_in, out_size, ws_size); grid = -1; return; }
        int dev = 0, cus = 0, per_cu = 0;
        if (hipGetDevice(&dev) != hipSuccess || hipDeviceGetAttribute(&cus, hipDeviceAttributeMultiprocessorCount, dev) != hipSuccess) { grid = -1; return; }
        if (hipFuncSetAttribute((const void*)hyb_fwd, hipFuncAttributeMaxDynamicSharedMemorySize, LDS_BYTES) != hipSuccess) { fprintf(stderr, "kernel_launch: hipFuncSetAttribute failed\n"); grid = -1; return; }
        if (hipOccupancyMaxActiveBlocksPerMultiprocessor(&per_cu, (const void*)hyb_fwd, NTHR, LDS_BYTES) != hipSuccess || per_cu < 1) {
            fprintf(stderr, "kernel_launch: occupancy query reports %d workgroups per CU; nothing launched\n", per_cu); (void)hipGetLastError(); grid = -1; return; }
        grid = cus;
    }
    if (grid < 0) return;
    (void)hipMemsetAsync((char*)d_ws + WS_CTL, 0, CTL_ZERO_BYTES, stream);
    Args a{};
    for (int i = 0; i < 25; ++i) a.in[i] = (const float*)d_in[i];
    a.out = (float*)d_out; a.ws = (unsigned char*)d_ws;
    hipLaunchKernelGGL(hyb_fwd, dim3(grid), dim3(NTHR), LDS_BYTES, stream, a);
}
```
